# Optimizing an MI355X kernel written in HIP

```python
import math
import jax, jax.numpy as jnp
from jax import lax
import numpy as np

D_MODEL = 2048
BATCH = 4
SEQ = 4096
DEPTH = 2

HEAD_DIM = 64
WA_HEADS = 12
WA_KV_HEADS = 4
WA_WIDTH = WA_HEADS * HEAD_DIM
WA_KV_WIDTH = WA_KV_HEADS * HEAD_DIM
WINDOW = 128
WA_BLOCK = 128
T5_BUCKETS = 32
T5_MAX_DIST = 128
ML_HEADS = 4
ML_HEAD_DIM = 128
ML_WIDTH = ML_HEADS * ML_HEAD_DIM
ML_CHUNK = 64
NA_HEADS = 12
NA_WIDTH = NA_HEADS * HEAD_DIM
GRID_W = 64
NA_KH_MAX = 8
NA_KW = 16

MIX_WIDTH = WA_WIDTH + ML_WIDTH + NA_WIDTH
IN_SIZES = (
    WA_WIDTH, WA_KV_WIDTH, WA_KV_WIDTH, WA_WIDTH,
    ML_WIDTH, ML_WIDTH, ML_WIDTH, ML_WIDTH, ML_WIDTH, 4 * ML_HEADS,
    NA_WIDTH, NA_WIDTH, NA_WIDTH, NA_WIDTH,
)
IN_WIDTH = sum(IN_SIZES)
DEEPNORM_ALPHA = (2 * DEPTH) ** 0.25
DEEPNORM_BETA = (8 * DEPTH) ** -0.25
LN_EPS = 1e-5

kernel_name = "hybrid_bidir_wgqa_mlstm_natten_deepnorm"


def layer_norm(x, g, b):
    xf = x.astype(jnp.float32)
    mu = jnp.mean(xf, axis=-1, keepdims=True)
    var = jnp.mean(jnp.square(xf - mu), axis=-1, keepdims=True)
    y = (xf - mu) * lax.rsqrt(var + LN_EPS) * g.astype(jnp.float32) + b.astype(jnp.float32)
    return y.astype(x.dtype)


def split_columns(u):
    pts = []
    acc = 0
    for s in IN_SIZES[:-1]:
        acc += s
        pts.append(acc)
    return jnp.split(u, pts, axis=-1)


def t5_bucket(rel):
    half = T5_BUCKETS // 2
    max_exact = half // 2
    ret = jnp.where(rel > 0, half, 0)
    n = jnp.abs(rel)
    nf = jnp.maximum(n, 1).astype(jnp.float32)
    large = max_exact + (jnp.log(nf / max_exact) / math.log(T5_MAX_DIST / max_exact)
                         * (half - max_exact)).astype(jnp.int32)
    large = jnp.minimum(large, half - 1)
    return ret + jnp.where(n < max_exact, n, large)


def window_gqa(q, k, v, t5_table, sink):
    B, S = q.shape[0], q.shape[1]
    blk = WA_BLOCK
    nb = S // blk
    G = WA_HEADS // WA_KV_HEADS
    qb = q.reshape(B, nb, blk, WA_KV_HEADS, G, HEAD_DIM)
    pad = ((0, 0), (blk, blk), (0, 0), (0, 0))
    kp = jnp.pad(k, pad).reshape(B, nb + 2, blk, WA_KV_HEADS, HEAD_DIM)
    vp = jnp.pad(v, pad).reshape(B, nb + 2, blk, WA_KV_HEADS, HEAD_DIM)
    kb = jnp.concatenate([kp[:, :-2], kp[:, 1:-1], kp[:, 2:]], axis=2)
    vb = jnp.concatenate([vp[:, :-2], vp[:, 1:-1], vp[:, 2:]], axis=2)
    s = jnp.einsum('bnqhgd,bnkhd->bnhgqk', qb, kb,
                   preferred_element_type=jnp.float32) * (HEAD_DIM ** -0.5)
    qi = jnp.arange(blk)
    kj = jnp.arange(3 * blk)
    rel = (kj[None, :] - blk) - qi[:, None]
    bias = t5_table.astype(jnp.float32)[t5_bucket(rel)]
    bias = bias.transpose(2, 0, 1).reshape(WA_KV_HEADS, G, blk, 3 * blk)
    key_pos = (jnp.arange(nb)[:, None] - 1) * blk + kj[None, :]
    in_seq = (key_pos >= 0) & (key_pos < S)
    valid = (jnp.abs(rel) <= WINDOW)[None] & in_seq[:, None, :]
    s = jnp.where(valid[None, :, None, None], s + bias[None, None], -jnp.inf)
    sk = sink.astype(jnp.float32).reshape(1, 1, WA_KV_HEADS, G, 1, 1)
    m = jnp.maximum(jnp.max(s, axis=-1, keepdims=True), sk)
    p = jnp.exp(s - m)
    den = jnp.sum(p, axis=-1, keepdims=True) + jnp.exp(sk - m)
    o = jnp.einsum('bnhgqk,bnkhd->bnqhgd', p / den, vb.astype(jnp.float32))
    return o.reshape(B, S, WA_HEADS * HEAD_DIM)


def mlstm_direction(q, k, v, i_pre, f_pre):
    B, H, S, d = q.shape
    L = ML_CHUNK
    nc = S // L
    q = q.reshape(B, H, nc, L, d) * (d ** -0.5)
    k = k.reshape(B, H, nc, L, d)
    v = v.reshape(B, H, nc, L, d)
    ig = i_pre.reshape(B, H, nc, L)
    b = jnp.cumsum(jax.nn.log_sigmoid(f_pre).reshape(B, H, nc, L), axis=-1)
    g = b[..., -1]
    a = g[..., None] - b + ig
    m_loc = jnp.max(a, axis=-1)
    w = jnp.exp(a - m_loc[..., None])
    C_loc = jnp.einsum('bhcs,bhcsd,bhcse->bhcde', w, v, k)
    n_loc = jnp.einsum('bhcs,bhcsd->bhcd', w, k)

    def step(carry, xs):
        C, n, m = carry
        g_c, m_l, C_l, n_l = xs
        m_new = jnp.maximum(g_c + m, m_l)
        sp = jnp.exp(g_c + m - m_new)
        sl = jnp.exp(m_l - m_new)
        C_new = sp[..., None, None] * C + sl[..., None, None] * C_l
        n_new = sp[..., None] * n + sl[..., None] * n_l
        return (C_new, n_new, m_new), (C, n, m)

    init = (jnp.zeros((B, H, d, d), jnp.float32), jnp.zeros((B, H, d), jnp.float32),
            jnp.zeros((B, H), jnp.float32))
    xs = (jnp.moveaxis(g, 2, 0), jnp.moveaxis(m_loc, 2, 0),
          jnp.moveaxis(C_loc, 2, 0), jnp.moveaxis(n_loc, 2, 0))
    _, (C_prev, n_prev, m_prev) = lax.scan(step, init, xs)
    C_prev = jnp.moveaxis(C_prev, 0, 2)
    n_prev = jnp.moveaxis(n_prev, 0, 2)
    m_prev = jnp.moveaxis(m_prev, 0, 2)

    D = b[..., :, None] - b[..., None, :] + ig[..., None, :]
    lower = jnp.tril(jnp.ones((L, L), dtype=bool))
    D = jnp.where(lower, D, -jnp.inf)
    m_inter = b + m_prev[..., None]
    m_t = jnp.maximum(m_inter, jnp.max(D, axis=-1))
    qk = jnp.einsum('bhctd,bhcsd->bhcts', q, k) * jnp.exp(D - m_t[..., None])
    inter_w = jnp.exp(m_inter - m_t)
    num = (jnp.einsum('bhcts,bhcsd->bhctd', qk, v)
           + inter_w[..., None] * jnp.einsum('bhcde,bhcte->bhctd', C_prev, q))
    den = jnp.sum(qk, axis=-1) + inter_w * jnp.einsum('bhcd,bhctd->bhct', n_prev, q)
    h = num / jnp.maximum(jnp.abs(den), jnp.exp(-m_t))[..., None]
    return h.reshape(B, H, S, d)


def mlstm_mixer(q, k, v, o_pre, if_pre, f_bias, norm_g):
    B, S = q.shape[0], q.shape[1]

    def heads(t):
        return t.reshape(B, S, ML_HEADS, ML_HEAD_DIM).transpose(0, 2, 1, 3).astype(jnp.float32)

    qh, kh, vh = heads(q), heads(k), heads(v)
    gates = if_pre.astype(jnp.float32).reshape(B, S, 4, ML_HEADS).transpose(2, 0, 3, 1)
    fb = f_bias.astype(jnp.float32)
    i_f, f_f = gates[0], gates[1] + fb[0][:, None]
    i_b, f_b = gates[2], gates[3] + fb[1][:, None]

    def rev(t):
        return jnp.flip(t, axis=2)

    h_f = mlstm_direction(qh, kh, vh, i_f, f_f)
    h_b = rev(mlstm_direction(rev(qh), rev(kh), rev(vh), rev(i_b), rev(f_b)))
    h = (h_f + h_b).transpose(0, 2, 1, 3)
    h = jax.nn.sigmoid(o_pre.astype(jnp.float32)).reshape(B, S, ML_HEADS, ML_HEAD_DIM) * h
    mu = jnp.mean(h, axis=-1, keepdims=True)
    var = jnp.mean(jnp.square(h - mu), axis=-1, keepdims=True)
    h = (h - mu) * lax.rsqrt(var + LN_EPS)
    return h.reshape(B, S, ML_WIDTH) * norm_g.astype(jnp.float32)


def neighbourhood_attn(q, k, v, rpb):
    B, S, H, dh = q.shape
    rows = S // GRID_W
    kh = min(NA_KH_MAX, rows)
    kw = NA_KW
    r = jnp.arange(rows)
    c = jnp.arange(GRID_W)
    row_start = jnp.clip(r - kh // 2, 0, rows - kh)
    key_rows = row_start[:, None] + jnp.arange(kh)[None, :]
    col_start = jnp.clip(c - kw // 2, 0, GRID_W - kw)
    col_ok = (c[None, :] >= col_start[:, None]) & (c[None, :] < col_start[:, None] + kw)
    qg = q.reshape(B, rows, GRID_W, H, dh)
    kg = k.reshape(B, rows, GRID_W, H, dh)[:, key_rows]
    vg = v.reshape(B, rows, GRID_W, H, dh)[:, key_rows]
    s = jnp.einsum('brchd,brkxhd->bhrckx', qg, kg,
                   preferred_element_type=jnp.float32) * (dh ** -0.5)
    dr_idx = (key_rows - r[:, None]) + NA_KH_MAX - 1
    dc_idx = jnp.clip(c[None, :] - c[:, None], -(kw - 1), kw - 1) + kw - 1
    bias = rpb.astype(jnp.float32)[:, dr_idx[:, None, :, None], dc_idx[None, :, None, :]]
    s = jnp.where(col_ok[None, None, None, :, None, :], s + bias[None], -jnp.inf)
    p = jax.nn.softmax(s.reshape(B, H, rows, GRID_W, kh * GRID_W), axis=-1)
    p = p.reshape(B, H, rows, GRID_W, kh, GRID_W)
    o = jnp.einsum('bhrckx,brkxhd->brchd', p, vg.astype(jnp.float32))
    return o.reshape(B, S, H * dh)


def hybrid_layer(x, w_in, b_in, w_out, b_out, ln_g, ln_b, t5_table, sink, f_bias, ml_norm_g, rpb):
    B, S, _ = x.shape
    u = jnp.matmul(x, w_in) + b_in
    (wa_q, wa_k, wa_v, wa_z, ml_q, ml_k, ml_v, ml_o, ml_z, ml_if,
     na_q, na_k, na_v, na_z) = split_columns(u)
    ya = window_gqa(wa_q.reshape(B, S, WA_HEADS, HEAD_DIM),
                    wa_k.reshape(B, S, WA_KV_HEADS, HEAD_DIM),
                    wa_v.reshape(B, S, WA_KV_HEADS, HEAD_DIM), t5_table, sink)
    yb = mlstm_mixer(ml_q, ml_k, ml_v, ml_o, ml_if, f_bias, ml_norm_g)
    yc = neighbourhood_attn(na_q.reshape(B, S, NA_HEADS, HEAD_DIM),
                            na_k.reshape(B, S, NA_HEADS, HEAD_DIM),
                            na_v.reshape(B, S, NA_HEADS, HEAD_DIM), rpb)
    y = jnp.concatenate([ya * jax.nn.silu(wa_z.astype(jnp.float32)),
                         yb * jax.nn.silu(ml_z.astype(jnp.float32)),
                         yc * jax.nn.silu(na_z.astype(jnp.float32))], axis=-1).astype(x.dtype)
    out = jnp.matmul(y, w_out) + b_out
    return layer_norm(DEEPNORM_ALPHA * x + out, ln_g, ln_b)


def setup_inputs(seed: int = 0) -> dict:
    key = jax.random.key(seed)
    ks = jax.random.split(key, 14)
    nrm = jax.random.normal
    f32 = jnp.float32
    x = nrm(ks[0], (BATCH, SEQ, D_MODEL), f32)
    emb_ln_g = 1.0 + 0.02 * nrm(ks[1], (D_MODEL,), f32)
    emb_ln_b = 0.02 * nrm(ks[2], (D_MODEL,), f32)
    w_in = nrm(ks[3], (DEPTH, D_MODEL, IN_WIDTH), f32) * (D_MODEL ** -0.5)
    b_in = 0.02 * nrm(ks[4], (DEPTH, IN_WIDTH), f32)
    w_out = nrm(ks[5], (DEPTH, MIX_WIDTH, D_MODEL), f32) * (MIX_WIDTH ** -0.5) * DEEPNORM_BETA
    b_out = 0.02 * nrm(ks[6], (DEPTH, D_MODEL), f32)
    ln_g = 1.0 + 0.02 * nrm(ks[7], (DEPTH, D_MODEL), f32)
    ln_b = 0.02 * nrm(ks[8], (DEPTH, D_MODEL), f32)
    t5_bias = 0.1 * nrm(ks[9], (T5_BUCKETS, WA_HEADS), f32)
    sink = 0.5 * nrm(ks[10], (DEPTH, WA_HEADS), f32)
    ml_f_bias = (jnp.linspace(3.0, 6.0, ML_HEADS, dtype=f32)[None, None, :]
                 + 0.1 * nrm(ks[11], (DEPTH, 2, ML_HEADS), f32))
    ml_norm_g = 1.0 + 0.02 * nrm(ks[12], (DEPTH, ML_WIDTH), f32)
    na_rpb = 0.1 * nrm(ks[13], (DEPTH, NA_HEADS, 2 * NA_KH_MAX - 1, 2 * NA_KW - 1), f32)
    return {"x": x, "emb_ln_g": emb_ln_g, "emb_ln_b": emb_ln_b, "w_in": w_in, "b_in": b_in,
            "w_out": w_out, "b_out": b_out, "ln_g": ln_g, "ln_b": ln_b, "t5_bias": t5_bias,
            "sink": sink, "ml_f_bias": ml_f_bias, "ml_norm_g": ml_norm_g, "na_rpb": na_rpb}


def reference(x, emb_ln_g, emb_ln_b, w_in, b_in, w_out, b_out, ln_g, ln_b, t5_bias,
              sink, ml_f_bias, ml_norm_g, na_rpb):
    h = layer_norm(x, emb_ln_g, emb_ln_b)
    for l in range(DEPTH):
        h = hybrid_layer(h, w_in[l], b_in[l], w_out[l], b_out[l], ln_g[l], ln_b[l],
                         t5_bias, sink[l], ml_f_bias[l], ml_norm_g[l], na_rpb[l])
    return h
```

```cpp
#include <hip/hip_runtime.h>
#include <cstdio>
#include <cstdint>

#ifndef REP_P0
#define REP_P0 1
#endif
#ifndef REP_G1
#define REP_G1 1
#endif
#ifndef REP_M1
#define REP_M1 1
#endif
#ifndef REP_WA
#define REP_WA 1
#endif
#ifndef REP_NA
#define REP_NA 1
#endif
#ifndef REP_M3
#define REP_M3 1
#endif
#ifndef REP_GATES
#define REP_GATES 1
#endif
#ifndef REP_BAR
#define REP_BAR 1
#endif
#ifndef MK_PER_PHASE
#define MK_PER_PHASE 0
#endif

#define LAS __attribute__((address_space(3)))
#define GAS __attribute__((address_space(1)))
typedef unsigned short bf16;
typedef short bf16x8 __attribute__((ext_vector_type(8)));
typedef short s16x4 __attribute__((ext_vector_type(4)));
typedef float f32x4 __attribute__((ext_vector_type(4)));
typedef float f32x16 __attribute__((ext_vector_type(16)));
typedef unsigned u32x4 __attribute__((ext_vector_type(4)));
typedef unsigned u32x2 __attribute__((ext_vector_type(2)));
typedef GAS unsigned gu32;

constexpr int M = 16384, DM = 2048, SEQ = 4096, IN_W = 7696, NWAVES = 8, NTHR = 512;
constexpr int LDN = 6144;
constexpr int N_AQ = 0, N_AK = 768, N_AZ = 1024, N_BQ = 1792, N_BK = 2304, N_BO = 2816, N_BZ = 3328, N_CQ = 3840, N_CK = 4608, N_CZ = 5376;
constexpr int T_AV = 0, T_BK = 256, T_BV = 768, T_CV = 1280;
constexpr int WROWS = 8192 + 16;
constexpr float LN_EPS = 1e-5f, LOG2E = 1.4426950408889634f, ALPHA = 1.4142135623730951f;
constexpr float C2A = 0.125f * LOG2E;
constexpr float QS = 0.08838834764831845f;

constexpr size_t MiB = 1u << 20;
constexpr size_t WS_CTL = 0, CTL_BYTES = 1 * MiB;
constexpr size_t WS_WIN = 2 * MiB, WIN_STRIDE = 33 * MiB;
constexpr size_t WS_WOUT = 68 * MiB, WOUT_STRIDE = 8 * MiB;
constexpr size_t WS_BIAS = 84 * MiB;
constexpr size_t WS_GATE = 85 * MiB;
constexpr size_t WS_HBY = 86 * MiB;
constexpr size_t WS_UNAT = 150 * MiB;
constexpr size_t WS_UT = 342 * MiB;
constexpr size_t WS_CST = 406 * MiB;
constexpr size_t WS_NST = 470 * MiB;
constexpr size_t WS_SCAL = 471 * MiB;
constexpr size_t WS_T1B = 472 * MiB;
constexpr size_t WS_END = 504 * MiB;
constexpr int CW_BAR = 4096;

constexpr int LDS_BYTES = 163840, MISC_OFF = LDS_BYTES - 128;

__device__ __forceinline__ int opaque_int(int v) { asm volatile("" : "+s"(v)); return v; }
#define LDS_WAIT() asm volatile("s_waitcnt lgkmcnt(0)" ::: "memory")
#define LDS_BARRIER() do { asm volatile("s_waitcnt lgkmcnt(0)" ::: "memory"); __builtin_amdgcn_s_barrier(); asm volatile("" ::: "memory"); } while (0)
#define VM_WAIT() asm volatile("s_waitcnt vmcnt(0)" ::: "memory")
__device__ __forceinline__ float bf2f(unsigned v) { return __uint_as_float(v << 16); }
__device__ __forceinline__ float bflo(unsigned v) { return __uint_as_float(v << 16); }
__device__ __forceinline__ float bfhi(unsigned v) { return __uint_as_float(v & 0xffff0000u); }
typedef float f32x2_t __attribute__((ext_vector_type(2)));
typedef __bf16 bf16x2_t __attribute__((ext_vector_type(2)));
__device__ __forceinline__ unsigned cvt_pk_bf16(float lo, float hi) { const f32x2_t v = {lo, hi}; const bf16x2_t b = __builtin_convertvector(v, bf16x2_t); return __builtin_bit_cast(unsigned, b); }
__device__ __forceinline__ float ex2(float x) { return __builtin_amdgcn_exp2f(x); }
__device__ __forceinline__ float fexp(float x) { return __builtin_amdgcn_exp2f(x * LOG2E); }
__device__ __forceinline__ float frcp(float x) { return __builtin_amdgcn_rcpf(x); }
__device__ __forceinline__ float silu(float x) { return x * frcp(1.f + fexp(-x)); }
__device__ __forceinline__ float sigm(float x) { return frcp(1.f + fexp(-x)); }
__device__ __forceinline__ float logsigmoid(float x) { return fminf(x, 0.f) - log1pf(expf(-fabsf(x))); }
__device__ __forceinline__ int crow(int reg, int h) { return (reg & 3) + 8 * (reg >> 2) + 4 * h; }
__device__ __forceinline__ float shx(float v, int mask, int lane) { return __int_as_float(__builtin_amdgcn_ds_bpermute((lane ^ mask) << 2, __float_as_int(v))); }
__device__ __forceinline__ float shi(float v, int src) { return __int_as_float(__builtin_amdgcn_ds_bpermute(src << 2, __float_as_int(v))); }
__device__ __forceinline__ float wave_sum(float v, int lane) {
#pragma unroll
    for (int o = 1; o < 64; o <<= 1) v += shx(v, o, lane);
    return v;
}
__device__ __forceinline__ float wave_max(float v, int lane) {
#pragma unroll
    for (int o = 1; o < 64; o <<= 1) v = fmaxf(v, shx(v, o, lane));
    return v;
}
__device__ __forceinline__ float scan_sum_up(float v, int lane) {
#pragma unroll
    for (int o = 1; o < 64; o <<= 1) { const float t = shi(v, lane - o); if (lane >= o) v += t; }
    return v;
}
__device__ __forceinline__ float scan_sum_down(float v, int lane) {
#pragma unroll
    for (int o = 1; o < 64; o <<= 1) { const float t = shi(v, lane + o); if (lane + o < 64) v += t; }
    return v;
}
__device__ __forceinline__ float scan_max_up(float v, int lane) {
#pragma unroll
    for (int o = 1; o < 64; o <<= 1) { const float t = shi(v, lane - o); if (lane >= o) v = fmaxf(v, t); }
    return v;
}
__device__ __forceinline__ float scan_max_down(float v, int lane) {
#pragma unroll
    for (int o = 1; o < 64; o <<= 1) { const float t = shi(v, lane + o); if (lane + o < 64) v = fmaxf(v, t); }
    return v;
}
__device__ __forceinline__ int t5_bucket(int rel) {
    const int n = rel < 0 ? -rel : rel; const int ret = rel > 0 ? 16 : 0;
    const int large = 8 + (n >= 12) + (n >= 16) + (n >= 23) + (n >= 32) + (n >= 46) + (n >= 64) + (n >= 91);
    return ret + (n < 8 ? n : large);
}
#define PIN16(a) asm volatile("" : "+v"(a[0]), "+v"(a[1]), "+v"(a[2]), "+v"(a[3]), "+v"(a[4]), "+v"(a[5]), "+v"(a[6]), "+v"(a[7]), "+v"(a[8]), "+v"(a[9]), "+v"(a[10]), "+v"(a[11]), "+v"(a[12]), "+v"(a[13]), "+v"(a[14]), "+v"(a[15]))
#define MFMA32(a, b, c) __builtin_amdgcn_mfma_f32_32x32x16_bf16((a), (b), (c), 0, 0, 0)
__device__ __forceinline__ bf16x8 pack8(const f32x16& x, int s) {
    u32x4 p; p.x = cvt_pk_bf16(x[8 * s], x[8 * s + 1]); p.y = cvt_pk_bf16(x[8 * s + 2], x[8 * s + 3]); p.z = cvt_pk_bf16(x[8 * s + 4], x[8 * s + 5]); p.w = cvt_pk_bf16(x[8 * s + 6], x[8 * s + 7]);
    return __builtin_bit_cast(bf16x8, p);
}
__device__ __forceinline__ f32x16 zero16() { f32x16 z;
#pragma unroll
    for (int i = 0; i < 16; ++i) z[i] = 0.f; return z; }

namespace pg8 {
constexpr int BM = 256, BK = 64, HALF = 128, HTB = HALF * BK * 2, STAGE_BYTES = 8 * HTB, NXCD = 8, WGM = 4;
__device__ __forceinline__ int lds_byte(int r, int c) { const int st = (r >> 4) * 2 + (c >> 5), rr = r & 15, cc = c & 31, ob = rr * 64 + cc * 2; return st * 1024 + (ob ^ (((ob >> 9) & 1) << 5)); }
__device__ __forceinline__ void stage_rc(int b, int& R, int& C) { const int st = b / 1024, sb = b % 1024, swz = sb ^ (((sb >> 9) & 1) << 5); R = (st >> 1) * 16 + swz / 64; C = (st & 1) * 32 + (swz % 64) / 2; }
__device__ __forceinline__ int perm32(int rho) { const int n = rho >> 4, i = rho & 15; return 8 * (i >> 2) + 4 * n + (i & 3); }

struct Unit { const char* a; const char* b; int pm, pn, kind; };

__device__ __forceinline__ bool tile_of(int i, int G, int c, int nM, int nN, int& pm, int& pn) {
    const int nwg = nM * nN; const long L = (long)i * G + c; if (L >= nwg) return false;
    int wgid = (int)L; { const int q = nwg / NXCD, r = nwg % NXCD, xcd = wgid % NXCD, off = wgid / NXCD; wgid = (xcd < r ? xcd * (q + 1) : r * (q + 1) + (xcd - r) * q) + off; }
    const int nig = WGM * nN, gid = wgid / nig, fm = gid * WGM, gsz = (nM - fm) < WGM ? (nM - fm) : WGM;
    pm = fm + ((wgid % nig) % gsz); pn = (wgid % nig) / gsz; return true;
}
constexpr size_t TSTEP = (size_t)256 * 2048 * 2;
struct Sched1 {
    const char* X; const char* W; int G, c;
    __device__ __forceinline__ bool next(int i, Unit& u) const {
        int pm, pn;
        if (G == 256) {
            if (i >= 8) return false;
            const int x = c & 7, k = c >> 3, j = i;
            if (i == 7) { if (c >= 128) return false; pm = 8 * x + (k & 7); pn = 28 + (k >> 3); }
            else if (j < 4) { pm = 16 * j + 4 * (x & 3) + (k & 3); pn = 8 * (x >> 2) + (k >> 2); }
            else if (j < 6) { pm = 32 * (j - 4) + 8 * (x & 3) + (k & 7); pn = 16 + 4 * (x >> 2) + (k >> 3); }
            else { pm = 8 * x + (k & 7); pn = 24 + (k >> 3); }
            if (pn >= 25) pn += 2;
        } else if (!tile_of(i, G, c, 64, 32, pm, pn)) return false;
        u.pm = pm; u.pn = pn;
        if (pn < 24) { u.kind = 0; u.a = X + (size_t)pm * TSTEP; u.b = W + (size_t)pn * TSTEP; }
        else { u.kind = 1; u.a = W + (size_t)pn * TSTEP; u.b = X + (size_t)pm * TSTEP; }
        return true;
    }
};
struct Sched2 {
    const char* Y; const char* W; int G, c;
    __device__ __forceinline__ bool next(int i, Unit& u) const {
        int pm, pn; if (!tile_of(i, G, c, 64, 8, pm, pn)) return false;
        u.pm = pm; u.pn = pn; u.kind = 2; u.a = Y + (size_t)pm * TSTEP; u.b = W + (size_t)pn * TSTEP; return true;
    }
};

struct Epi1 {
    static constexpr bool PERM = true;
    bf16* Unat; bf16* Ut; const float* bias;
    __device__ __forceinline__ void operator()(const f32x4 (&acc)[2][2][4][2], const Unit& u, int wr, int wc, int fr, int fq) const {
        if (u.kind == 0) {
            const int row0 = u.pm * BM + wr * 64 + fr, col0 = u.pn * BM + wc * 32 + 8 * fq;
            f32x4 bv[2][2];
#pragma unroll
            for (int bj = 0; bj < 2; ++bj)
#pragma unroll
                for (int n = 0; n < 2; ++n) bv[bj][n] = *(const f32x4*)(bias + col0 + bj * HALF + 4 * n);
#pragma unroll
            for (int ai = 0; ai < 2; ++ai)
#pragma unroll
                for (int m = 0; m < 4; ++m) { bf16* rowp = Unat + (size_t)(row0 + ai * HALF + m * 16) * LDN + col0;
#pragma unroll
                    for (int bj = 0; bj < 2; ++bj) { const f32x4 v0 = acc[ai][bj][m][0] + bv[bj][0], v1 = acc[ai][bj][m][1] + bv[bj][1];
                        u32x4 w; w.x = cvt_pk_bf16(v0[0], v0[1]); w.y = cvt_pk_bf16(v0[2], v0[3]); w.z = cvt_pk_bf16(v1[0], v1[1]); w.w = cvt_pk_bf16(v1[2], v1[3]);
                        *(u32x4*)(rowp + bj * HALF) = w; } }
        } else {
            const int nrow0 = (u.pn - 24) * BM + wr * 64 + fr, tok0 = u.pm * BM + wc * 32 + 8 * fq;
#pragma unroll
            for (int ai = 0; ai < 2; ++ai)
#pragma unroll
                for (int m = 0; m < 4; ++m) { const int nr = nrow0 + ai * HALF + m * 16; const float bs = bias[6144 + nr]; bf16* rowp = Ut + (size_t)nr * M + tok0;
#pragma unroll
                    for (int bj = 0; bj < 2; ++bj) { const f32x4 v0 = acc[ai][bj][m][0] + bs, v1 = acc[ai][bj][m][1] + bs;
                        u32x4 w; w.x = cvt_pk_bf16(v0[0], v0[1]); w.y = cvt_pk_bf16(v0[2], v0[3]); w.z = cvt_pk_bf16(v1[0], v1[1]); w.w = cvt_pk_bf16(v1[2], v1[3]);
                        *(u32x4*)(rowp + bj * HALF) = w; } }
        }
    }
};
template <int L> struct Epi2 {
    static constexpr bool PERM = true;
    float* Tf; bf16* Tb; const float* bias; const float* srcf; const bf16* srcb; const float* stat; const float* gam; const float* bet; bf16* Tb_hi;
    __device__ __forceinline__ void operator()(const f32x4 (&acc)[2][2][4][2], const Unit& u, int wr, int wc, int fr, int fq) const {
        const int row0 = u.pm * BM + wr * 64 + fr, col0 = u.pn * BM + wc * 32 + 8 * fq;
        bf16* const Tbu = (Tb_hi && u.pm >= 32) ? Tb_hi - (size_t)8192 * DM : Tb;
        float mean[2][4], rs[2][4];
#pragma unroll
        for (int ai = 0; ai < 2; ++ai)
#pragma unroll
            for (int m = 0; m < 4; ++m) { mean[ai][m] = 0.f; rs[ai][m] = 0.f; }
#pragma unroll
        for (int bj = 0; bj < 2; ++bj) { const int c = col0 + bj * HALF;
            f32x4 g0 = {0.f, 0.f, 0.f, 0.f}, g1 = g0, b0 = *(const f32x4*)(bias + c), b1 = *(const f32x4*)(bias + c + 4);
#pragma unroll
            for (int ai = 0; ai < 2; ++ai)
#pragma unroll
                for (int m = 0; m < 4; ++m) { const size_t off = (size_t)(row0 + ai * HALF + m * 16) * DM + c;
                    f32x4 t0, t1;
                    if (L == 0) { const u32x4 hv = *(const u32x4*)(srcb + off);
                        const f32x4 o0 = {bflo(hv.x), bfhi(hv.x), bflo(hv.y), bfhi(hv.y)}, o1 = {bflo(hv.z), bfhi(hv.z), bflo(hv.w), bfhi(hv.w)};
                        t0 = o0 * ALPHA + b0 + acc[ai][bj][m][0]; t1 = o1 * ALPHA + b1 + acc[ai][bj][m][1]; }
                    else { t0 = acc[ai][bj][m][0] + b0; t1 = acc[ai][bj][m][1] + b1; }
                    u32x4 w; w.x = cvt_pk_bf16(t0[0], t0[1]); w.y = cvt_pk_bf16(t0[2], t0[3]); w.z = cvt_pk_bf16(t1[0], t1[1]); w.w = cvt_pk_bf16(t1[2], t1[3]); *(u32x4*)(Tbu + off) = w; } }
    }
};

template <class Epi, class Sched, bool ALIGN_EPI, bool SP2>
__device__ __forceinline__ void gemm_phase(LAS unsigned char* lds, const Sched& S, const Epi& E, const int tid) {
    const int wid = __builtin_amdgcn_readfirstlane(tid >> 6), lane = tid & 63, wr = wid >> 2, wc = wid & 3, fr = lane & 15, fq = lane >> 4;
    constexpr int K = 2048, nt = K / BK;
    unsigned voffA[2], voffB[2];
#pragma unroll
    for (int i = 0; i < 2; ++i) { int R, C; stage_rc(tid * 16 + i * 8192, R, C); const int Rb = Epi::PERM ? ((R & ~31) + perm32(R & 31)) : R;
        voffA[i] = (unsigned)(R * K + C) * 2u; voffB[i] = (unsigned)(Rb * K + C) * 2u; }
    const size_t kstep = (size_t)(BK * 2);
    const size_t hstep = (size_t)HALF * K * 2;
    const unsigned ldsw = (unsigned)wid * 1024u;
    const int aoff = lds_byte(wr * 64 + fr, fq * 8), boff = lds_byte(wc * 32 + fr, fq * 8);
#define PG8_SA(b, h) (((b) * 2 + (h)) * HTB)
#define PG8_SB(b, h) ((4 + (b) * 2 + (h)) * HTB)
#define PG8_STAGE(bufoff, gbase, voff) do { _Pragma("unroll") for (int _i = 0; _i < 2; ++_i) \
        __builtin_amdgcn_global_load_lds((const unsigned*)((const char*)(gbase) + (voff)[_i]), (LAS unsigned*)(lds + (bufoff) + ldsw + _i * 8192), 16, 0, 0); } while (0)
#define PG8_LDA(dst, b, h) do { _Pragma("unroll") for (int m = 0; m < 4; ++m) _Pragma("unroll") for (int k = 0; k < 2; ++k) dst[m][k] = *(const LAS bf16x8*)(lds + PG8_SA(b, h) + aoff + m * 2048 + k * 1024); } while (0)
#define PG8_LDB(dst, b, h) do { _Pragma("unroll") for (int n = 0; n < 2; ++n) _Pragma("unroll") for (int k = 0; k < 2; ++k) dst[n][k] = *(const LAS bf16x8*)(lds + PG8_SB(b, h) + boff + n * 2048 + k * 1024); } while (0)
#define PG8_MMA(ai, bj, At, Bt) do { __builtin_amdgcn_s_setprio(1); _Pragma("unroll") for (int m = 0; m < 4; ++m) _Pragma("unroll") for (int n = 0; n < 2; ++n) _Pragma("unroll") for (int k = 0; k < 2; ++k) \
        acc[ai][bj][m][n] = __builtin_amdgcn_mfma_f32_16x16x32_bf16(Bt[n][k], At[m][k], acc[ai][bj][m][n], 0, 0, 0); __builtin_amdgcn_s_setprio(0); } while (0)
#define PG8_WAIT_V(n) asm volatile("s_waitcnt vmcnt(" #n ")" ::: "memory")
#define PG8_WAIT_L(n) asm volatile("s_waitcnt lgkmcnt(" #n ")" ::: "memory")
#define PG8_BAR __builtin_amdgcn_s_barrier()
#define PG8_SCHED __builtin_amdgcn_sched_barrier(0)
    Unit cur, nxt; int ui = 0;
    if (!S.next(0, cur)) return;
    f32x4 acc[2][2][4][2];
#pragma unroll
    for (int a = 0; a < 2; ++a)
#pragma unroll
        for (int b = 0; b < 2; ++b)
#pragma unroll
            for (int m = 0; m < 4; ++m)
#pragma unroll
                for (int n = 0; n < 2; ++n) acc[a][b][m][n] = (f32x4){0.f, 0.f, 0.f, 0.f};
    bf16x8 At[4][2], B0[2][2], B1[2][2];
    const char* cA = cur.a; const char* cB = cur.b;
    if constexpr (SP2) {
        PG8_STAGE(PG8_SB(0, 0), cB, voffB); PG8_STAGE(PG8_SB(0, 1), cB + hstep, voffB); PG8_STAGE(PG8_SA(0, 0), cA, voffA); PG8_STAGE(PG8_SA(0, 1), cA + hstep, voffA);
        if (wr == 1) PG8_BAR;
        PG8_WAIT_V(2); PG8_BAR;
        PG8_STAGE(PG8_SB(1, 0), cB + kstep, voffB); PG8_STAGE(PG8_SA(1, 0), cA + kstep, voffA); PG8_STAGE(PG8_SB(1, 1), cB + hstep + kstep, voffB);
        PG8_WAIT_V(6); PG8_BAR;
    } else {
        PG8_STAGE(PG8_SB(0, 0), cB, voffB); PG8_STAGE(PG8_SA(0, 0), cA, voffA); PG8_STAGE(PG8_SB(0, 1), cB + hstep, voffB); PG8_STAGE(PG8_SA(0, 1), cA + hstep, voffA);
        if (wr == 1) PG8_BAR;
        PG8_WAIT_V(4); PG8_BAR;
        PG8_STAGE(PG8_SB(1, 0), cB + kstep, voffB); PG8_STAGE(PG8_SA(1, 0), cA + kstep, voffA); PG8_STAGE(PG8_SB(1, 1), cB + hstep + kstep, voffB);
        PG8_WAIT_V(6); PG8_BAR;
    }
    for (;;) {
        const bool has_next = S.next(ui + 1, nxt);
        const char* nA = has_next ? nxt.a : cA; const char* nB = has_next ? nxt.b : cB;
        for (int t = 0; t < nt; t += 2) {
            const bool last = (t == nt - 2);
            const char* a1 = cA + (size_t)(t + 1) * kstep;
            const char* a2 = last ? nA : cA + (size_t)(t + 2) * kstep; const char* b2 = last ? nB : cB + (size_t)(t + 2) * kstep;
            const char* a3 = a2 + kstep; const char* b3 = b2 + kstep;
            if constexpr (SP2) {
            PG8_LDB(B0, 0, 0); PG8_LDB(B1, 0, 1); PG8_SCHED; PG8_LDA(At, 0, 0); PG8_STAGE(PG8_SA(1, 1), a1 + hstep, voffA);
            PG8_WAIT_V(8); PG8_WAIT_L(0); PG8_BAR; PG8_MMA(0, 0, At, B0); PG8_MMA(0, 1, At, B1); PG8_BAR; PG8_SCHED;
            PG8_LDA(At, 0, 1); PG8_STAGE(PG8_SB(0, 0), b2, voffB); PG8_STAGE(PG8_SB(0, 1), b2 + hstep, voffB); PG8_STAGE(PG8_SA(0, 0), a2, voffA);
            PG8_WAIT_V(8); PG8_WAIT_L(0); PG8_BAR; PG8_MMA(1, 0, At, B0); PG8_MMA(1, 1, At, B1); PG8_BAR; PG8_SCHED;
            PG8_LDB(B0, 1, 0); PG8_LDB(B1, 1, 1); PG8_SCHED; PG8_LDA(At, 1, 0); PG8_STAGE(PG8_SA(0, 1), a2 + hstep, voffA);
            PG8_WAIT_V(8); PG8_WAIT_L(0); PG8_BAR; PG8_MMA(0, 0, At, B0); PG8_MMA(0, 1, At, B1); PG8_BAR; PG8_SCHED;
            PG8_LDA(At, 1, 1); PG8_STAGE(PG8_SB(1, 0), b3, voffB); PG8_STAGE(PG8_SB(1, 1), b3 + hstep, voffB); PG8_STAGE(PG8_SA(1, 0), a3, voffA);
            PG8_WAIT_V(8); PG8_WAIT_L(0); PG8_BAR; PG8_MMA(1, 0, At, B0); PG8_MMA(1, 1, At, B1); PG8_BAR; PG8_SCHED;
            } else {
            PG8_LDB(B0, 0, 0); PG8_SCHED; PG8_LDA(At, 0, 0); PG8_STAGE(PG8_SA(1, 1), a1 + hstep, voffA);
            PG8_WAIT_L(8); PG8_BAR; PG8_WAIT_L(0); PG8_MMA(0, 0, At, B0); PG8_BAR; PG8_SCHED;
            PG8_LDB(B1, 0, 1); PG8_STAGE(PG8_SB(0, 0), b2, voffB);
            PG8_BAR; PG8_WAIT_L(0); PG8_MMA(0, 1, At, B1); PG8_BAR;
            PG8_LDA(At, 0, 1); PG8_STAGE(PG8_SA(0, 0), a2, voffA);
            PG8_BAR; PG8_WAIT_L(0); PG8_MMA(1, 0, At, B0); PG8_BAR; PG8_SCHED;
            PG8_STAGE(PG8_SB(0, 1), b2 + hstep, voffB);
            PG8_WAIT_V(6); PG8_BAR; PG8_MMA(1, 1, At, B1); PG8_BAR;
            PG8_LDB(B0, 1, 0); PG8_SCHED; PG8_LDA(At, 1, 0); PG8_STAGE(PG8_SA(0, 1), a2 + hstep, voffA);
            PG8_WAIT_L(8); PG8_BAR; PG8_WAIT_L(0); PG8_MMA(0, 0, At, B0); PG8_BAR; PG8_SCHED;
            PG8_LDB(B1, 1, 1); PG8_STAGE(PG8_SB(1, 0), b3, voffB);
            PG8_BAR; PG8_WAIT_L(0); PG8_MMA(0, 1, At, B1); PG8_BAR;
            PG8_LDA(At, 1, 1); PG8_STAGE(PG8_SA(1, 0), a3, voffA);
            PG8_BAR; PG8_WAIT_L(0); PG8_MMA(1, 0, At, B0); PG8_BAR; PG8_SCHED;
            PG8_STAGE(PG8_SB(1, 1), b3 + hstep, voffB);
            PG8_WAIT_V(6); PG8_BAR; PG8_MMA(1, 1, At, B1); PG8_BAR;
            }
        }
        if constexpr (ALIGN_EPI) { if (wr == 0) PG8_BAR; }
        int fr_ = fr, fq_ = fq; asm volatile("" : "+v"(fr_), "+v"(fq_));
        E(acc, cur, wr, wc, fr_, fq_);
        if (!has_next) break;
#pragma unroll
        for (int a = 0; a < 2; ++a)
#pragma unroll
            for (int b = 0; b < 2; ++b)
#pragma unroll
                for (int m = 0; m < 4; ++m)
#pragma unroll
                    for (int n = 0; n < 2; ++n) acc[a][b][m][n] = (f32x4){0.f, 0.f, 0.f, 0.f};
        cur = nxt; cA = nA; cB = nB; ++ui;
        if constexpr (ALIGN_EPI) { if (wr == 1) PG8_BAR; }
    }
    PG8_WAIT_V(0);
    if constexpr (!ALIGN_EPI) { if (wr == 0) PG8_BAR; }
    PG8_BAR;
#undef PG8_SA
#undef PG8_SB
#undef PG8_STAGE
#undef PG8_LDA
#undef PG8_LDB
#undef PG8_MMA
#undef PG8_WAIT_V
#undef PG8_WAIT_L
#undef PG8_BAR
#undef PG8_SCHED
}
}

#define XB_TMO      128
#define XB_XCNT(j)  (256  + 64 * (j))
#define XB_XSUB(j)  (1280 + 64 * (j))
#define XB_XGEN(j)  (2304 + 64 * (j))
#define XB_TOP      3328
#define XB_TOPGEN   3392
#define XCD_BAR_WORDS 3456
static_assert(XCD_BAR_WORDS * 4 <= 16384, "barrier words fit the per-call memset");
#define XB_SPIN_CAP (1u << 22)
__device__ __forceinline__ unsigned xb_ld(unsigned* p)              { return __hip_atomic_load(p, __ATOMIC_RELAXED, __HIP_MEMORY_SCOPE_AGENT); }
__device__ __forceinline__ unsigned xb_add(unsigned* p, unsigned v) { return __hip_atomic_fetch_add(p, v, __ATOMIC_RELAXED, __HIP_MEMORY_SCOPE_AGENT); }
__device__ __forceinline__ unsigned xb_xcc_id() { return (unsigned)__builtin_amdgcn_s_getreg((3 << 11) | 20) & 0xFu; }
#define XB_SPIN(cond, bar) do { unsigned _sp = 0; while (cond) { __builtin_amdgcn_s_sleep(1); \
    if ((++_sp & 255u) == 0u) { if (xb_ld(&(bar)[XB_TMO])) break; if (_sp > XB_SPIN_CAP) { atomicAdd(&(bar)[XB_TMO], 1u); break; } } } } while (0)
struct XcdBarrier { unsigned* bar; unsigned x; volatile LAS unsigned* st; };
__device__ __forceinline__ XcdBarrier xcd_barrier_post(unsigned* bar, volatile LAS unsigned* st, int tid) {
    XcdBarrier b; b.bar = bar; b.x = xb_xcc_id(); b.st = st;
    if (tid == 0) (void)xb_add(&bar[XB_XCNT(b.x)], 1u);
    return b;
}
__device__ __forceinline__ void xcd_barrier_complete(unsigned* bar, unsigned x, unsigned& nloc, unsigned& nx) {
    const unsigned G = gridDim.x * gridDim.y * gridDim.z;
    unsigned sum, cnt, mine, sp = 0u;
    for (;;) {
        sum = 0u; cnt = 0u; mine = 0u;
#pragma unroll
        for (unsigned j = 0; j < 16; ++j) { const unsigned c = xb_ld(&bar[XB_XCNT(j)]); sum += c; cnt += (c > 0u) ? 1u : 0u; mine = (j == x) ? c : mine; }
        if (sum == G) break;
        __builtin_amdgcn_s_sleep(1);
        if ((++sp & 255u) == 0u) { if (xb_ld(&bar[XB_TMO])) break; if (sp > XB_SPIN_CAP) { atomicAdd(&bar[XB_TMO], 1u); break; } }
    }
    nloc = mine > 0u ? mine : 1u; nx = cnt > 0u ? cnt : 1u;
}
__device__ __forceinline__ void xcd_barrier(const XcdBarrier& b, int tid) {
    asm volatile("s_waitcnt vmcnt(0)" ::: "memory");
    __syncthreads();
    if (tid == 0) {
        unsigned* bar = b.bar; asm volatile("" : "+s"(bar));
        __builtin_amdgcn_s_waitcnt(0);
        unsigned nloc = b.st[0], nx = b.st[1];
        if (nloc == 0u) { xcd_barrier_complete(bar, b.x, nloc, nx); b.st[0] = nloc; b.st[1] = nx; }
        const unsigned old = xb_add(&bar[XB_XSUB(b.x)], 1u);
        const unsigned gen = old / nloc;
        if (old + 1u == (gen + 1u) * nloc) {
            __builtin_amdgcn_fence(__ATOMIC_RELEASE, "agent");
            asm volatile("s_waitcnt vmcnt(0)" ::: "memory");
            const unsigned og = xb_add(&bar[XB_TOP], 1u);
            const unsigned tg = og / nx;
            if (og + 1u == (tg + 1u) * nx) xb_add(&bar[XB_TOPGEN], 1u);
            else XB_SPIN(xb_ld(&bar[XB_TOPGEN]) == tg, bar);
            __builtin_amdgcn_fence(__ATOMIC_ACQUIRE, "agent");
            xb_add(&bar[XB_XGEN(b.x)], 1u);
            asm volatile("s_waitcnt vmcnt(0)" ::: "memory");
        } else {
            XB_SPIN(xb_ld(&bar[XB_XGEN(b.x)]) == gen, bar);
            __builtin_amdgcn_fence(__ATOMIC_ACQUIRE, "agent");
            asm volatile("s_waitcnt vmcnt(0)" ::: "memory");
        }
    }
    __syncthreads();
}

struct Args { const float* in[14]; float* out; unsigned char* ws; int ph_lo, ph_hi; };

struct Ctx {
    LAS unsigned char* lds; int tid, lane, wave, G, bid;
    const float *x, *emb_g, *emb_b, *w_in, *b_in, *w_out, *b_out, *ln_g, *ln_b, *t5, *sink, *fbias, *norm_g, *rpb;
    float* out; unsigned char* ws;
    bf16* hby; bf16* yb; bf16* unat; bf16* ut; bf16* cst; float* nst; float* gs; float* ml; float* mprev; float* gate; float* stat;
};

__device__ __forceinline__ int src_col_of_row(int r) {
    if (r < 768) return r;
    if (r < 1024) return r - 768 + 768;
    if (r < 1792) return r - 1024 + 1280;
    if (r < 2304) return r - 1792 + 2048;
    if (r < 2816) return r - 2304 + 2560;
    if (r < 3328) return r - 2816 + 3584;
    if (r < 3840) return r - 3328 + 4096;
    if (r < 4608) return r - 3840 + 4624;
    if (r < 5376) return r - 4608 + 5392;
    if (r < 6144) return r - 5376 + 6928;
    if (r < 6400) return r - 6144 + 1024;
    if (r < 6912) return r - 6400 + 2560;
    if (r < 7424) return r - 6912 + 3072;
    if (r < 8192) return r - 7424 + 6160;
    return r - 8192 + 4608;
}
__device__ __forceinline__ void ln_row(const float* xrow, float* orow, bf16* brow, float* stat, const float* g, const float* b, int lane) {
    f32x4 v[8]; float s = 0.f;
#pragma unroll
    for (int j = 0; j < 8; ++j) { v[j] = *(const f32x4*)(xrow + 4 * (lane + 64 * j)); s += (v[j][0] + v[j][1]) + (v[j][2] + v[j][3]); }
    const float mean = wave_sum(s, lane) * (1.f / DM); float q = 0.f;
#pragma unroll
    for (int j = 0; j < 8; ++j) { v[j] = v[j] - mean; q += (v[j][0] * v[j][0] + v[j][1] * v[j][1]) + (v[j][2] * v[j][2] + v[j][3] * v[j][3]); }
    const float rstd = 1.f / sqrtf(wave_sum(q, lane) * (1.f / DM) + LN_EPS);
    if (stat && lane == 0) { stat[0] = mean; stat[1] = rstd; }
#pragma unroll
    for (int j = 0; j < 8; ++j) { const int c = 4 * (lane + 64 * j); const f32x4 gg = *(const f32x4*)(g + c), bb = *(const f32x4*)(b + c);
        const f32x4 o = v[j] * rstd * gg + bb;
        if (orow) *(f32x4*)(orow + c) = o;
        if (brow) { u32x2 w; w.x = cvt_pk_bf16(o[0], o[1]); w.y = cvt_pk_bf16(o[2], o[3]); *(u32x2*)(brow + c) = w; } }
}

__device__ __forceinline__ void ln_row2(const float* x0, const float* x1, float* o0, float* o1, bf16* b0, bf16* b1, float* st0, float* st1, const float* g, const float* b, int lane) {
    f32x4 v[8], u[8]; float s = 0.f, s_ = 0.f;
#pragma unroll
    for (int j = 0; j < 8; ++j) { v[j] = *(const f32x4*)(x0 + 4 * (lane + 64 * j)); u[j] = *(const f32x4*)(x1 + 4 * (lane + 64 * j)); }
#pragma unroll
    for (int j = 0; j < 8; ++j) { s += (v[j][0] + v[j][1]) + (v[j][2] + v[j][3]); s_ += (u[j][0] + u[j][1]) + (u[j][2] + u[j][3]); }
#pragma unroll
    for (int o = 1; o < 64; o <<= 1) { s += shx(s, o, lane); s_ += shx(s_, o, lane); }
    const float mean = s * (1.f / DM), mean_ = s_ * (1.f / DM); float q = 0.f, q_ = 0.f;
#pragma unroll
    for (int j = 0; j < 8; ++j) { v[j] = v[j] - mean; u[j] = u[j] - mean_; q += (v[j][0] * v[j][0] + v[j][1] * v[j][1]) + (v[j][2] * v[j][2] + v[j][3] * v[j][3]); q_ += (u[j][0] * u[j][0] + u[j][1] * u[j][1]) + (u[j][2] * u[j][2] + u[j][3] * u[j][3]); }
#pragma unroll
    for (int o = 1; o < 64; o <<= 1) { q += shx(q, o, lane); q_ += shx(q_, o, lane); }
    const float rstd = 1.f / sqrtf(q * (1.f / DM) + LN_EPS), rstd_ = 1.f / sqrtf(q_ * (1.f / DM) + LN_EPS);
    if (st0 && lane == 0) { st0[0] = mean; st0[1] = rstd; st1[0] = mean_; st1[1] = rstd_; }
#pragma unroll
    for (int j = 0; j < 8; ++j) { const int c = 4 * (lane + 64 * j); const f32x4 gg = *(const f32x4*)(g + c), bb = *(const f32x4*)(b + c);
        const f32x4 o = v[j] * rstd * gg + bb, p = u[j] * rstd_ * gg + bb;
        if (o0) { *(f32x4*)(o0 + c) = o; *(f32x4*)(o1 + c) = p; }
        if (b0) { u32x2 w; w.x = cvt_pk_bf16(o[0], o[1]); w.y = cvt_pk_bf16(o[2], o[3]); *(u32x2*)(b0 + c) = w; u32x2 w2; w2.x = cvt_pk_bf16(p[0], p[1]); w2.y = cvt_pk_bf16(p[2], p[3]); *(u32x2*)(b1 + c) = w2; } }
}

__device__ __forceinline__ void ln_row2_b(const bf16* x0, const bf16* x1, bf16* b0, bf16* b1, float* st0, float* st1, const float* g, const float* b, int lane) {
    f32x4 v[8], u[8]; float s = 0.f, s_ = 0.f;
#pragma unroll
    for (int j = 0; j < 4; ++j) { const u32x4 p = *(const u32x4*)(x0 + 8 * (lane + 64 * j)), q = *(const u32x4*)(x1 + 8 * (lane + 64 * j));
        v[2 * j] = (f32x4){bflo(p.x), bfhi(p.x), bflo(p.y), bfhi(p.y)}; v[2 * j + 1] = (f32x4){bflo(p.z), bfhi(p.z), bflo(p.w), bfhi(p.w)};
        u[2 * j] = (f32x4){bflo(q.x), bfhi(q.x), bflo(q.y), bfhi(q.y)}; u[2 * j + 1] = (f32x4){bflo(q.z), bfhi(q.z), bflo(q.w), bfhi(q.w)}; }
#pragma unroll
    for (int j = 0; j < 8; ++j) { s += (v[j][0] + v[j][1]) + (v[j][2] + v[j][3]); s_ += (u[j][0] + u[j][1]) + (u[j][2] + u[j][3]); }
#pragma unroll
    for (int o = 1; o < 64; o <<= 1) { s += shx(s, o, lane); s_ += shx(s_, o, lane); }
    const float mean = s * (1.f / DM), mean_ = s_ * (1.f / DM); float q = 0.f, q_ = 0.f;
#pragma unroll
    for (int j = 0; j < 8; ++j) { v[j] = v[j] - mean; u[j] = u[j] - mean_; q += (v[j][0] * v[j][0] + v[j][1] * v[j][1]) + (v[j][2] * v[j][2] + v[j][3] * v[j][3]); q_ += (u[j][0] * u[j][0] + u[j][1] * u[j][1]) + (u[j][2] * u[j][2] + u[j][3] * u[j][3]); }
#pragma unroll
    for (int o = 1; o < 64; o <<= 1) { q += shx(q, o, lane); q_ += shx(q_, o, lane); }
    const float rstd = 1.f / sqrtf(q * (1.f / DM) + LN_EPS), rstd_ = 1.f / sqrtf(q_ * (1.f / DM) + LN_EPS);
    if (lane == 0) { st0[0] = mean; st0[1] = rstd; st1[0] = mean_; st1[1] = rstd_; }
#pragma unroll
    for (int j = 0; j < 4; ++j) { const int c = 8 * (lane + 64 * j);
        const f32x4 g0 = *(const f32x4*)(g + c), g1 = *(const f32x4*)(g + c + 4), bb0 = *(const f32x4*)(b + c), bb1 = *(const f32x4*)(b + c + 4);
        const f32x4 o0 = v[2 * j] * rstd * g0 + bb0, o1 = v[2 * j + 1] * rstd * g1 + bb1, p0 = u[2 * j] * rstd_ * g0 + bb0, p1 = u[2 * j + 1] * rstd_ * g1 + bb1;
        u32x4 w; w.x = cvt_pk_bf16(o0[0], o0[1]); w.y = cvt_pk_bf16(o0[2], o0[3]); w.z = cvt_pk_bf16(o1[0], o1[1]); w.w = cvt_pk_bf16(o1[2], o1[3]); *(u32x4*)(b0 + c) = w;
        u32x4 w2; w2.x = cvt_pk_bf16(p0[0], p0[1]); w2.y = cvt_pk_bf16(p0[2], p0[3]); w2.z = cvt_pk_bf16(p1[0], p1[1]); w2.w = cvt_pk_bf16(p1[2], p1[3]); *(u32x4*)(b1 + c) = w2; }
}

__device__ __forceinline__ void fin_row2(const bf16* t1, const bf16* o2, const float* st, const float* g0, const float* b0, const float* g1, const float* b1, float* out, int lane) {
    f32x4 v[8], u[8]; float s = 0.f, s_ = 0.f;
    const float mA = st[0], rA = st[1] * ALPHA, mB = st[2], rB = st[3] * ALPHA;
#pragma unroll
    for (int j = 0; j < 4; ++j) { const int c = 8 * (lane + 64 * j);
        const u32x4 p = *(const u32x4*)(t1 + c), q = *(const u32x4*)(t1 + DM + c), x = *(const u32x4*)(o2 + c), y = *(const u32x4*)(o2 + DM + c);
        const f32x4 ga = *(const f32x4*)(g0 + c), gb = *(const f32x4*)(g0 + c + 4), ba = *(const f32x4*)(b0 + c) * ALPHA, bb = *(const f32x4*)(b0 + c + 4) * ALPHA;
        v[2 * j] = ((f32x4){bflo(p.x), bfhi(p.x), bflo(p.y), bfhi(p.y)} - mA) * rA * ga + ba + (f32x4){bflo(x.x), bfhi(x.x), bflo(x.y), bfhi(x.y)};
        v[2 * j + 1] = ((f32x4){bflo(p.z), bfhi(p.z), bflo(p.w), bfhi(p.w)} - mA) * rA * gb + bb + (f32x4){bflo(x.z), bfhi(x.z), bflo(x.w), bfhi(x.w)};
        u[2 * j] = ((f32x4){bflo(q.x), bfhi(q.x), bflo(q.y), bfhi(q.y)} - mB) * rB * ga + ba + (f32x4){bflo(y.x), bfhi(y.x), bflo(y.y), bfhi(y.y)};
        u[2 * j + 1] = ((f32x4){bflo(q.z), bfhi(q.z), bflo(q.w), bfhi(q.w)} - mB) * rB * gb + bb + (f32x4){bflo(y.z), bfhi(y.z), bflo(y.w), bfhi(y.w)}; }
#pragma unroll
    for (int j = 0; j < 8; ++j) { s += (v[j][0] + v[j][1]) + (v[j][2] + v[j][3]); s_ += (u[j][0] + u[j][1]) + (u[j][2] + u[j][3]); }
#pragma unroll
    for (int o = 1; o < 64; o <<= 1) { s += shx(s, o, lane); s_ += shx(s_, o, lane); }
    const float mean = s * (1.f / DM), mean_ = s_ * (1.f / DM); float q2 = 0.f, q2_ = 0.f;
#pragma unroll
    for (int j = 0; j < 8; ++j) { v[j] = v[j] - mean; u[j] = u[j] - mean_; q2 += (v[j][0] * v[j][0] + v[j][1] * v[j][1]) + (v[j][2] * v[j][2] + v[j][3] * v[j][3]); q2_ += (u[j][0] * u[j][0] + u[j][1] * u[j][1]) + (u[j][2] * u[j][2] + u[j][3] * u[j][3]); }
#pragma unroll
    for (int o = 1; o < 64; o <<= 1) { q2 += shx(q2, o, lane); q2_ += shx(q2_, o, lane); }
    const float rstd = 1.f / sqrtf(q2 * (1.f / DM) + LN_EPS), rstd_ = 1.f / sqrtf(q2_ * (1.f / DM) + LN_EPS);
#pragma unroll
    for (int j = 0; j < 4; ++j) { const int c = 8 * (lane + 64 * j);
        const f32x4 ga = *(const f32x4*)(g1 + c), gb = *(const f32x4*)(g1 + c + 4), ba = *(const f32x4*)(b1 + c), bb = *(const f32x4*)(b1 + c + 4);
        *(f32x4*)(out + c) = v[2 * j] * rstd * ga + ba; *(f32x4*)(out + c + 4) = v[2 * j + 1] * rstd * gb + bb;
        *(f32x4*)(out + DM + c) = u[2 * j] * rstd_ * ga + ba; *(f32x4*)(out + DM + c + 4) = u[2 * j + 1] * rstd_ * gb + bb; }
}

__device__ __forceinline__ bf16* t1_row(unsigned char* ws, int m) { return m < 8192 ? (bf16*)(ws + WS_WIN) + (size_t)m * DM : (bf16*)(ws + WS_T1B) + (size_t)(m - 8192) * DM; }
struct TrItem { const float* src; bf16* dst; int ldw, nvalid; };
__device__ __forceinline__ void tr_load(const TrItem& t, float (&wv)[32], int lane) {
#pragma unroll
    for (int i = 0; i < 8; ++i) { const int kk = 8 * i + (lane >> 3); const f32x4 v = *(const f32x4*)(t.src + (size_t)kk * t.ldw + 4 * (lane & 7));
        wv[4 * i] = v[0]; wv[4 * i + 1] = v[1]; wv[4 * i + 2] = v[2]; wv[4 * i + 3] = v[3]; }
}
__device__ __forceinline__ void tr_store(const TrItem& t, const float (&wv)[32], LAS float* scr, int lane) {
#pragma unroll
    for (int i = 0; i < 8; ++i) { const int kk = 8 * i + (lane >> 3); LAS float* d = scr + kk * 33 + 4 * (lane & 7); d[0] = wv[4 * i]; d[1] = wv[4 * i + 1]; d[2] = wv[4 * i + 2]; d[3] = wv[4 * i + 3]; }
    LDS_WAIT();
    const int c = lane & 7;
#pragma unroll
    for (int j = 0; j < 4; ++j) { const int n = (lane >> 3) + 8 * j; const LAS float* sp = scr + (8 * c) * 33 + n;
        u32x4 o; o.x = cvt_pk_bf16(sp[0 * 33], sp[1 * 33]); o.y = cvt_pk_bf16(sp[2 * 33], sp[3 * 33]); o.z = cvt_pk_bf16(sp[4 * 33], sp[5 * 33]); o.w = cvt_pk_bf16(sp[6 * 33], sp[7 * 33]);
        if (n < t.nvalid) *(u32x4*)(t.dst + (size_t)n * 2048 + 8 * c) = o; }
    LDS_WAIT();
}
__device__ __forceinline__ bool tr_item(const Ctx& F, int l, int it, TrItem& t) {
    constexpr int I_IN = 241 * 32, I_OUT = 64 * 32;
    if (it >= I_IN + I_OUT) return false;
    if (it < I_IN) { int rb = it >> 5; const int kb = it & 31; rb = rb < 200 ? rb : rb + 16;
        t.ldw = IN_W; t.nvalid = rb == 256 ? 16 : 32; t.src = F.w_in + (size_t)l * DM * IN_W + (size_t)(kb * 64) * IN_W + src_col_of_row(rb * 32);
        t.dst = (bf16*)(F.ws + WS_WIN + l * WIN_STRIDE) + (size_t)rb * 32 * 2048 + kb * 64; }
    else { const int r = it - I_IN, rb = r >> 5, kb = r & 31;
        t.ldw = DM; t.nvalid = 32; t.src = F.w_out + (size_t)l * DM * DM + (size_t)(kb * 64) * DM + rb * 32;
        t.dst = (bf16*)(F.ws + WS_WOUT + l * WOUT_STRIDE) + (size_t)rb * 32 * 2048 + kb * 64; }
    return true;
}
__device__ __forceinline__ void weights_job(Ctx& F, int l, int gw, int ngw) {
    LAS float* scr = (LAS float*)(F.lds + F.wave * 16384);
    TrItem ta, tb; float wa[32], wb[32];
    int it = gw; bool ha = tr_item(F, l, it, ta), hb;
    if (ha) tr_load(ta, wa, F.lane);
    while (ha) {
        it += ngw; hb = tr_item(F, l, it, tb); if (hb) tr_load(tb, wb, F.lane);
        tr_store(ta, wa, scr, F.lane);
        if (!hb) break;
        it += ngw; ha = tr_item(F, l, it, ta); if (ha) tr_load(ta, wa, F.lane);
        tr_store(tb, wb, scr, F.lane);
    }
}
__device__ __forceinline__ void helper_of(const Ctx& F, int l, bool& is_h, int& hid, int& nh) { (void)l; if (F.G == 256) { is_h = F.bid >= 128; hid = F.bid - 128; nh = 128; } else { is_h = true; hid = F.bid; nh = F.G; } }
__device__ __forceinline__ void phase_prologue(Ctx& F) {
    const int gw = F.bid * NWAVES + F.wave, NGW = F.G * NWAVES;
    weights_job(F, 0, gw, NGW);
    for (int i = F.bid * NTHR + F.tid; i < 2 * WROWS; i += F.G * NTHR) { const int l = i / WROWS, r = i % WROWS; ((float*)(F.ws + WS_BIAS))[i] = F.b_in[l * IN_W + src_col_of_row(r)]; }
    for (int m = 2 * gw; m < M; m += 2 * NGW) ln_row2(F.x + (size_t)m * DM, F.x + (size_t)(m + 1) * DM, (float*)nullptr, (float*)nullptr, F.hby + (size_t)m * DM, F.hby + (size_t)(m + 1) * DM, F.stat + (size_t)m * 2, F.stat + (size_t)(m + 1) * 2, F.emb_g, F.emb_b, F.lane);
}

__device__ __forceinline__ void gates_job(Ctx& F, int l) {
    const bf16* Wg = (const bf16*)(F.ws + WS_WIN + l * WIN_STRIDE) + (size_t)8192 * 2048;
    const float* bg = (const float*)(F.ws + WS_BIAS) + l * WROWS + 8192;
    LAS f32x4* red = (LAS f32x4*)F.lds;
    const int w = F.wave, fr = F.lane & 15, fq = F.lane >> 4;
    bool is_h; int hid, nh; helper_of(F, l, is_h, hid, nh); if (!is_h) return;
    for (int rb = hid; rb < M / 64; rb += nh) {
        const bf16* bp = Wg + (size_t)fr * 2048 + w * 256 + 8 * fq;
        f32x4 acc[4];
#pragma unroll
        for (int tt = 0; tt < 4; ++tt) acc[tt] = (f32x4){0.f, 0.f, 0.f, 0.f};
        bf16x8 bfr[8], afr[4][8];
#pragma unroll
        for (int i = 0; i < 8; ++i) bfr[i] = *(const bf16x8*)(bp + 32 * i);
#pragma unroll
        for (int tt = 0; tt < 4; ++tt)
#pragma unroll
            for (int i = 0; i < 8; ++i) afr[tt][i] = *(const bf16x8*)(F.hby + (size_t)(rb * 64 + tt * 16 + fr) * DM + w * 256 + 8 * fq + 32 * i);
#pragma unroll
        for (int i = 0; i < 8; ++i)
#pragma unroll
            for (int tt = 0; tt < 4; ++tt) acc[tt] = __builtin_amdgcn_mfma_f32_16x16x32_bf16(afr[tt][i], bfr[i], acc[tt], 0, 0, 0);
#pragma unroll
        for (int tt = 0; tt < 4; ++tt) red[(w * 4 + tt) * 64 + F.lane] = acc[tt];
        __syncthreads();
        if (w < 4) { f32x4 o = red[w * 64 + F.lane];
#pragma unroll
            for (int ww = 1; ww < 8; ++ww) o = o + red[(ww * 4 + w) * 64 + F.lane];
            const float bb = bg[fr];
#pragma unroll
            for (int j = 0; j < 4; ++j) F.gate[(size_t)(rb * 64 + w * 16 + 4 * fq + j) * 16 + fr] = o[j] + bb; }
        __syncthreads();
    }
}

constexpr int WA_K = 0, WA_V = 65536, WA_VSTR = 1032, WA_TB = WA_V + 64 * WA_VSTR  , WA_TBS = 320, WA_END = WA_TB + 3 * WA_TBS * 4;
static_assert(WA_END <= MISC_OFF, "WA LDS map");
__device__ __forceinline__ void wattn_item(Ctx& F, int item, int l) {
    const int b = item >> 6, kvh = (item >> 4) & 3, p = item & 15;
    const int tokb = b * SEQ, kpos0 = 256 * p - 128;
    LAS unsigned char* lds = F.lds;
    {
        u32x4 kr[8], vr[8];
        const int kc0 = F.tid >> 3, c = F.tid & 7;
#pragma unroll
        for (int j = 0; j < 8; ++j) { const int kk = kc0 + 64 * j; int pos = kpos0 + kk; pos = pos < 0 ? 0 : (pos > SEQ - 1 ? SEQ - 1 : pos);
            kr[j] = *(const u32x4*)(F.unat + (size_t)(tokb + pos) * LDN + N_AK + kvh * 64 + c * 8); }
        const int d0 = F.tid >> 6, cc = F.tid & 63;
        int vpos = kpos0 + cc * 8; vpos = vpos < 0 ? 0 : (vpos > SEQ - 8 ? SEQ - 8 : vpos);
#pragma unroll
        for (int j = 0; j < 8; ++j) vr[j] = *(const u32x4*)(F.ut + (size_t)(T_AV + kvh * 64 + d0 + 8 * j) * M + tokb + vpos);
#pragma unroll
        for (int j = 0; j < 8; ++j) { const int kk = kc0 + 64 * j; *(LAS u32x4*)(lds + WA_K + kk * 128 + ((c ^ ((kk >> 1) & 7)) << 4)) = kr[j]; }
#pragma unroll
        for (int j = 0; j < 8; ++j) { LAS unsigned char* dst = lds + WA_V + (d0 + 8 * j) * WA_VSTR + cc * 16;
            *(LAS u32x2*)dst = (u32x2){vr[j].x, vr[j].y}; *(LAS u32x2*)(dst + 8) = (u32x2){vr[j].z, vr[j].w}; }
    }
    LAS float* tbw = (LAS float*)(lds + WA_TB);
    for (int i = F.tid; i < 3 * WA_TBS; i += NTHR) { const int g = i / WA_TBS, idx = i % WA_TBS - 31; tbw[i] = (idx >= 0 && idx <= 256) ? F.t5[t5_bucket(idx - 128) * 12 + kvh * 3 + g] * LOG2E : -INFINITY; }
    const int qt = F.wave, r = F.lane & 31, h = F.lane >> 5, ql = 32 * qt + r;
    const int tokq = tokb + 256 * p + ql;
    unsigned bad[16];
#pragma unroll
    for (int i = 0; i < 16; ++i) bad[i] = (unsigned)(WA_TB + (crow(i, h) - r + 31) * 4);
    bf16x8 qf[4];
#pragma unroll
    for (int s = 0; s < 4; ++s) qf[s] = *(const bf16x8*)(F.unat + (size_t)tokq * LDN + N_AQ + (kvh * 3) * 64 + 16 * s + 8 * h);
    __syncthreads();
    const int dlo = (p == 0) ? ((4 - qt) > 0 ? (4 - qt) : 0) : 0;
    const int dhi = (p == 15) ? ((12 - qt) < 9 ? (12 - qt) : 9) : 9;
#pragma unroll 1
    for (int g = 0; g < 3; ++g) {
        const int head = kvh * 3 + g;
        bf16x8 qn[4];
        if (g < 2) {
#pragma unroll
            for (int s = 0; s < 4; ++s) qn[s] = *(const bf16x8*)(F.unat + (size_t)tokq * LDN + N_AQ + (head + 1) * 64 + 16 * s + 8 * h);
        } else {
#pragma unroll
            for (int s = 0; s < 4; ++s) qn[s] = qf[s];
        }
        const bf16* zp = F.unat + (size_t)tokq * LDN + N_AZ + head * 64 + 4 * h;
        u32x2 zz[8];
#pragma unroll
        for (int i = 0; i < 8; ++i) zz[i] = *(const u32x2*)(zp + 8 * i);
        float m = F.sink[l * 12 + head] * LOG2E, lsum = h ? 0.f : 1.f;
        f32x16 O0 = zero16(), O1 = zero16();
        const unsigned goff = (unsigned)(g * WA_TBS * 4);
#pragma unroll
        for (int dt_ = 0; dt_ < 9; ++dt_) {
            if (dt_ >= dlo && dt_ < dhi) {
                const int kt = qt + dt_;
                f32x16 S = zero16();
                const int krow_ = kt * 32 + r;
#pragma unroll
                for (int s = 0; s < 4; ++s) { const bf16x8 kf = *(const LAS bf16x8*)(lds + WA_K + krow_ * 128 + (((2 * s + h) ^ ((krow_ >> 1) & 7)) << 4)); S = MFMA32(kf, qf[s], S); }
                float bs[16];
#pragma unroll
                for (int i = 0; i < 16; ++i) bs[i] = *(const LAS float*)(lds + (bad[i] + goff) + dt_ * 128);
                float mx = -INFINITY;
#pragma unroll
                for (int i = 0; i < 16; ++i) { const float sv = fmaf(S[i], C2A, bs[i]); S[i] = sv; mx = fmaxf(mx, sv); }
                if (__builtin_amdgcn_ballot_w64(mx > m + 6.f) != 0ull) {
                    mx = fmaxf(mx, shx(mx, 32, F.lane));
                    const float mn = fmaxf(m, mx), al = ex2(m - mn); m = mn; lsum *= al;
#pragma unroll
                    for (int i = 0; i < 16; ++i) { O0[i] *= al; O1[i] *= al; }
                }
#pragma unroll
                for (int i = 0; i < 16; ++i) { const float pv = ex2(S[i] - m); S[i] = pv; lsum += pv; }
                const bf16x8 pb0 = pack8(S, 0), pb1 = pack8(S, 1);
#pragma unroll
                for (int s2 = 0; s2 < 2; ++s2) {
                    const int kof = (kt * 32 + 16 * s2 + 4 * h) * 2;
                    const s16x4 a0 = *(const LAS s16x4*)(lds + WA_V + r * WA_VSTR + kof), a1 = *(const LAS s16x4*)(lds + WA_V + r * WA_VSTR + kof + 16);
                    const s16x4 c0 = *(const LAS s16x4*)(lds + WA_V + (32 + r) * WA_VSTR + kof), c1 = *(const LAS s16x4*)(lds + WA_V + (32 + r) * WA_VSTR + kof + 16);
                    const bf16x8 v0 = __builtin_shufflevector(a0, a1, 0, 1, 2, 3, 4, 5, 6, 7), v1 = __builtin_shufflevector(c0, c1, 0, 1, 2, 3, 4, 5, 6, 7);
                    O0 = MFMA32(v0, s2 ? pb1 : pb0, O0); O1 = MFMA32(v1, s2 ? pb1 : pb0, O1);
                }
            }
        }
        lsum += shx(lsum, 32, F.lane);
        const float inv = frcp(lsum);
        bf16* yp = F.yb + (size_t)tokq * DM + head * 64 + 4 * h;
#pragma unroll
        for (int dt = 0; dt < 2; ++dt)
#pragma unroll
            for (int g4 = 0; g4 < 4; ++g4) { const u32x2 z2 = zz[dt * 4 + g4];
                const f32x16& O = dt ? O1 : O0;
                const float y0 = O[4 * g4] * inv * silu(bflo(z2.x)), y1 = O[4 * g4 + 1] * inv * silu(bfhi(z2.x)), y2 = O[4 * g4 + 2] * inv * silu(bflo(z2.y)), y3 = O[4 * g4 + 3] * inv * silu(bfhi(z2.y));
                u32x2 w; w.x = cvt_pk_bf16(y0, y1); w.y = cvt_pk_bf16(y2, y3); *(u32x2*)(yp + 32 * dt + 8 * g4) = w; }
#pragma unroll
        for (int s = 0; s < 4; ++s) qf[s] = qn[s];
    }
    __syncthreads();
}

constexpr int NA_K = 0, NA_V = 73728, NA_VSTR = 1160, NA_TB = NA_V + 64 * NA_VSTR  , NA_TI = NA_TB + 480 * 4  , NA_X = NA_TI + 2048, NA_XQ = 2560, NA_END = NA_X + 4 * NA_XQ;
static_assert(NA_END <= MISC_OFF, "NA LDS map");
struct NaRegs { u32x4 k[9]; u32x4 v[9]; };
__device__ __forceinline__ void na_decode(int item, int& b, int& head, int& r0, int& rs0) { b = item / 384; head = (item / 32) % 12; r0 = 2 * (item & 31); int t = r0 - 4; rs0 = t < 0 ? 0 : (t > 56 ? 56 : t); }
__device__ __forceinline__ void na_row_issue(Ctx& F, int b, int head, int gr, u32x4& kreg, u32x4& vreg) {
    const int kc = F.tid >> 3, c = F.tid & 7;
    kreg = *(const u32x4*)(F.unat + (size_t)(b * SEQ + gr * 64 + kc) * LDN + N_CK + head * 64 + c * 8);
    vreg = *(const u32x4*)(F.ut + (size_t)(T_CV + head * 64 + kc) * M + b * SEQ + gr * 64 + c * 8);
}
__device__ __forceinline__ void na_row_commit(Ctx& F, int gr, const u32x4& kreg, const u32x4& vreg) {
    const int kc = F.tid >> 3, c = F.tid & 7, slot = gr % 9, kk = slot * 64 + kc;
    *(LAS u32x4*)(F.lds + NA_K + kk * 128 + ((c ^ ((kk >> 1) & 7)) << 4)) = kreg;
    LAS unsigned char* dst = F.lds + NA_V + kc * NA_VSTR + (slot * 64 + c * 8) * 2;
    *(LAS u32x2*)dst = (u32x2){vreg.x, vreg.y}; *(LAS u32x2*)(dst + 8) = (u32x2){vreg.z, vreg.w};
}
#define SCHED_FENCE() __builtin_amdgcn_sched_barrier(0)
template <int CH>
__device__ __forceinline__ void na_tiles(LAS unsigned char* lds, const bf16x8 (&qf)[4], const unsigned (&badf)[16], const unsigned (&badc)[4], int rsj, int khalf, int r, int h,
                                         float& m, float& lsum, f32x16& O0, f32x16& O1) {
    bf16x8 kc[4];
    { const int kb0 = ((rsj + 4 * khalf) % 9) * 64, krow_ = kb0 + r;
#pragma unroll
      for (int s = 0; s < 4; ++s) kc[s] = *(const LAS bf16x8*)(lds + NA_K + krow_ * 128 + (((2 * s + h) ^ ((krow_ >> 1) & 7)) << 4)); }
#pragma unroll
    for (int it = 0; it < 8; ++it) {
        const int kri = it >> 1, kct = it & 1;
        const bool full = (kct == CH);
        const int kbase = ((rsj + 4 * khalf + kri) % 9) * 64 + kct * 32;
        s16x4 va[2][2], vc[2][2]; float bs[16];
#pragma unroll
        for (int s2 = 0; s2 < 2; ++s2) if (full || s2 == (kct ? 0 : 1)) {
            const int kof = (kbase + 16 * s2 + 4 * h) * 2;
            va[s2][0] = *(const LAS s16x4*)(lds + NA_V + r * NA_VSTR + kof); va[s2][1] = *(const LAS s16x4*)(lds + NA_V + r * NA_VSTR + kof + 16);
            vc[s2][0] = *(const LAS s16x4*)(lds + NA_V + (32 + r) * NA_VSTR + kof); vc[s2][1] = *(const LAS s16x4*)(lds + NA_V + (32 + r) * NA_VSTR + kof + 16);
        }
        if (full) {
#pragma unroll
            for (int i = 0; i < 16; ++i) bs[i] = *(const LAS float*)(lds + badf[i] + kri * 128);
        } else {
#pragma unroll
            for (int i = 0; i < 4; ++i) bs[i] = *(const LAS float*)(lds + badc[i] + kri * 128);
        }
        SCHED_FENCE();
        f32x16 S = zero16();
#pragma unroll
        for (int s = 0; s < 4; ++s) S = MFMA32(kc[s], qf[s], S);
        if (it < 7) { const int nb = ((rsj + 4 * khalf + ((it + 1) >> 1)) % 9) * 64 + ((it + 1) & 1) * 32, krow_ = nb + r;
#pragma unroll
            for (int s = 0; s < 4; ++s) kc[s] = *(const LAS bf16x8*)(lds + NA_K + krow_ * 128 + (((2 * s + h) ^ ((krow_ >> 1) & 7)) << 4)); }
        SCHED_FENCE();
        constexpr int NV = 16;
        const int i0 = full ? 0 : (kct ? 0 : 12), nv = full ? NV : 4;
        float mx = -INFINITY;
#pragma unroll
        for (int i = 0; i < NV; ++i) if (i < nv) { const float sv = fmaf(S[i0 + i], C2A, bs[i]); bs[i] = sv; mx = fmaxf(mx, sv); }
        { const auto sw = __builtin_amdgcn_permlane32_swap(__float_as_uint(mx), __float_as_uint(mx), false, false); mx = fmaxf(__uint_as_float(sw[0]), __uint_as_float(sw[1])); }
        const float mn = fmaxf(m, mx), al = ex2(m - mn); m = mn; lsum *= al;
#pragma unroll
        for (int i = 0; i < 16; ++i) { O0[i] *= al; O1[i] *= al; }
#pragma unroll
        for (int i = 0; i < NV; ++i) if (i < nv) { const float pv = ex2(bs[i] - mn); bs[i] = pv; lsum += pv; }
        if (full) {
            u32x4 p0, p1;
            p0.x = cvt_pk_bf16(bs[0], bs[1]); p0.y = cvt_pk_bf16(bs[2], bs[3]); p0.z = cvt_pk_bf16(bs[4], bs[5]); p0.w = cvt_pk_bf16(bs[6], bs[7]);
            p1.x = cvt_pk_bf16(bs[8], bs[9]); p1.y = cvt_pk_bf16(bs[10], bs[11]); p1.z = cvt_pk_bf16(bs[12], bs[13]); p1.w = cvt_pk_bf16(bs[14], bs[15]);
            const bf16x8 pb0 = __builtin_bit_cast(bf16x8, p0), pb1 = __builtin_bit_cast(bf16x8, p1);
            O0 = MFMA32(__builtin_shufflevector(va[0][0], va[0][1], 0, 1, 2, 3, 4, 5, 6, 7), pb0, O0); O1 = MFMA32(__builtin_shufflevector(vc[0][0], vc[0][1], 0, 1, 2, 3, 4, 5, 6, 7), pb0, O1);
            O0 = MFMA32(__builtin_shufflevector(va[1][0], va[1][1], 0, 1, 2, 3, 4, 5, 6, 7), pb1, O0); O1 = MFMA32(__builtin_shufflevector(vc[1][0], vc[1][1], 0, 1, 2, 3, 4, 5, 6, 7), pb1, O1);
        } else {
            u32x4 pw; const unsigned p01 = cvt_pk_bf16(bs[0], bs[1]), p23 = cvt_pk_bf16(bs[2], bs[3]);
            if (kct) { pw.x = p01; pw.y = p23; pw.z = 0u; pw.w = 0u; } else { pw.x = 0u; pw.y = 0u; pw.z = p01; pw.w = p23; }
            const bf16x8 pbx = __builtin_bit_cast(bf16x8, pw);
            const int s2 = kct ? 0 : 1;
            O0 = MFMA32(__builtin_shufflevector(va[s2][0], va[s2][1], 0, 1, 2, 3, 4, 5, 6, 7), pbx, O0); O1 = MFMA32(__builtin_shufflevector(vc[s2][0], vc[s2][1], 0, 1, 2, 3, 4, 5, 6, 7), pbx, O1);
        }
    }
}

__device__ __forceinline__ void nattn_all(Ctx& F, int l) {
    LAS unsigned char* lds = F.lds;
    const int vb = (F.G == 256) ? ((F.bid & 7) * 32 + (F.bid >> 3)) : F.bid;
    const int per = (1536 + F.G - 1) / F.G, it0 = vb * per, it1 = (it0 + per) < 1536 ? (it0 + per) : 1536;
    if (F.wave >= 4) __builtin_amdgcn_s_setprio(1);
    const int qt = F.wave & 3, khalf = F.wave >> 2, j = qt >> 1, ch = qt & 1, r = F.lane & 31, h = F.lane >> 5;
    const int qc = 32 * ch + r; int cs = qc - 8; cs = cs < 0 ? 0 : (cs > 48 ? 48 : cs);
    unsigned badf[16], badc[4];
#pragma unroll
    for (int i = 0; i < 16; ++i) { const int kc = ch * 32 + crow(i, h); const bool ok = (kc >= cs) && (kc < cs + 16); int dc = kc - qc; dc = dc < -15 ? -15 : (dc > 15 ? 15 : dc);
        badf[i] = (unsigned)(NA_TI + ((j * 8 + khalf * 4) * 32 + (ok ? dc + 15 : 31)) * 4); }
#pragma unroll
    for (int i = 0; i < 4; ++i) { const int kct = 1 - ch, ii = (kct ? 0 : 12) + i; const int kc = kct * 32 + crow(ii, h); const bool ok = (kc >= cs) && (kc < cs + 16); int dc = kc - qc; dc = dc < -15 ? -15 : (dc > 15 ? 15 : dc);
        badc[i] = (unsigned)(NA_TI + ((j * 8 + khalf * 4) * 32 + (ok ? dc + 15 : 31)) * 4); }
    int have_bh = -1, have_hi = -1, pf_lo = 0, pf_n = 0, tb_bh = -1;
    u32x4 pk0, pv0, pk1, pv1; bf16x8 qn[4]; bool have_qn = false;
    pk0 = pv0 = pk1 = pv1 = (u32x4){0u, 0u, 0u, 0u};
#pragma unroll
    for (int s = 0; s < 4; ++s) qn[s] = (bf16x8){0, 0, 0, 0, 0, 0, 0, 0};
#pragma unroll 1
    for (int item = it0; item < it1; ++item) {
        int b, head, r0, rs0; na_decode(item, b, head, r0, rs0);
        const int bh = b * 12 + head, need_hi = (rs0 + 8) < 63 ? (rs0 + 8) : 63, tokb = b * SEQ;
        if (bh != have_bh) {
            NaRegs R;
#pragma unroll
            for (int jj = 0; jj < 9; ++jj) { const int gr = (rs0 + jj) < 63 ? (rs0 + jj) : 63; na_row_issue(F, b, head, gr, R.k[jj], R.v[jj]); }
#pragma unroll
            for (int jj = 0; jj < 9; ++jj) { if (rs0 + jj <= 63) na_row_commit(F, rs0 + jj, R.k[jj], R.v[jj]); }
            LAS float* tbw = (LAS float*)(lds + NA_TB);
            for (int i = F.tid; i < 465; i += NTHR) tbw[i] = F.rpb[(size_t)(l * 12 + head) * 465 + i] * LOG2E;
            have_bh = bh;
        } else {
            if (pf_n > 0) na_row_commit(F, pf_lo, pk0, pv0);
            if (pf_n > 1) na_row_commit(F, pf_lo + 1, pk1, pv1);
        }
        have_hi = need_hi;
        if (bh != tb_bh) { LDS_BARRIER(); tb_bh = bh; }
        { const LAS float* tb = (const LAS float*)(lds + NA_TB); const int jj = F.tid >> 8, kidx = (F.tid >> 5) & 7, dci = F.tid & 31;
          int rsq = r0 + jj - 4; rsq = rsq < 0 ? 0 : (rsq > 56 ? 56 : rsq); const int dr = rsq + kidx - (r0 + jj) + 7;
          ((LAS float*)(lds + NA_TI))[F.tid] = dci < 31 ? tb[dr * 31 + dci] : -INFINITY; }
        const int qrow = r0 + j; int rsj = qrow - 4; rsj = rsj < 0 ? 0 : (rsj > 56 ? 56 : rsj);
        const int tokq = tokb + qrow * 64 + qc;
        bf16x8 qf[4];
        if (have_qn) {
#pragma unroll
            for (int s = 0; s < 4; ++s) qf[s] = qn[s];
        } else {
#pragma unroll
            for (int s = 0; s < 4; ++s) qf[s] = *(const bf16x8*)(F.unat + (size_t)tokq * LDN + N_CQ + head * 64 + 16 * s + 8 * h);
        }
        const bf16* zp = F.unat + (size_t)tokq * LDN + N_CZ + head * 64 + 32 * khalf + 4 * h;
        u32x2 zz[4];
#pragma unroll
        for (int g4 = 0; g4 < 4; ++g4) zz[g4] = *(const u32x2*)(zp + 8 * g4);
        LDS_BARRIER();
        pf_n = 0; have_qn = false;
        if (item + 1 < it1) {
            int nb, nhead, nr0, nrs0; na_decode(item + 1, nb, nhead, nr0, nrs0);
            if (nb * 12 + nhead == bh) {
                const int nhi = (nrs0 + 8) < 63 ? (nrs0 + 8) : 63;
                pf_lo = have_hi + 1; pf_n = nhi - have_hi;
                if (pf_n > 0) na_row_issue(F, b, head, pf_lo, pk0, pv0);
                if (pf_n > 1) na_row_issue(F, b, head, pf_lo + 1, pk1, pv1);
            }
            const int ntokq = nb * SEQ + (nr0 + j) * 64 + qc;
#pragma unroll
            for (int s = 0; s < 4; ++s) qn[s] = *(const bf16x8*)(F.unat + (size_t)ntokq * LDN + N_CQ + nhead * 64 + 16 * s + 8 * h);
            have_qn = true;
        }
        float m = -1e30f, lsum = 0.f;
        f32x16 O0 = zero16(), O1 = zero16();
        if (ch == 0) na_tiles<0>(lds, qf, badf, badc, rsj, khalf, r, h, m, lsum, O0, O1); else na_tiles<1>(lds, qf, badf, badc, rsj, khalf, r, h, m, lsum, O0, O1);
        lsum += shx(lsum, 32, F.lane);
        LAS unsigned* xq = (LAS unsigned*)(lds + NA_X + qt * NA_XQ);
        LAS float* xf = (LAS float*)(lds + NA_X + qt * NA_XQ + 2048);
        bf16* yp = F.yb + (size_t)tokq * DM + 1280 + head * 64 + 32 * khalf + 4 * h;
        if (khalf == 1) {
#pragma unroll
            for (int i = 0; i < 8; ++i) xq[i * 64 + F.lane] = cvt_pk_bf16(O0[2 * i], O0[2 * i + 1]);
            xf[F.lane] = m; xf[64 + F.lane] = lsum;
        }
        LDS_BARRIER();
        float m2 = 0.f, l2 = 0.f; unsigned ox[8];
        if (khalf == 0) {
            m2 = xf[F.lane]; l2 = xf[64 + F.lane];
#pragma unroll
            for (int i = 0; i < 8; ++i) ox[i] = xq[i * 64 + F.lane];
        }
        LDS_BARRIER();
        if (khalf == 0) {
#pragma unroll
            for (int i = 0; i < 8; ++i) xq[i * 64 + F.lane] = cvt_pk_bf16(O1[2 * i], O1[2 * i + 1]);
            xf[F.lane] = m; xf[64 + F.lane] = lsum;
        }
        LDS_BARRIER();
        if (khalf == 1) {
            m2 = xf[F.lane]; l2 = xf[64 + F.lane];
#pragma unroll
            for (int i = 0; i < 8; ++i) ox[i] = xq[i * 64 + F.lane];
        }
        {
            const float mn = fmaxf(m, m2), a1 = ex2(m - mn), a2 = ex2(m2 - mn);
            const float inv = frcp(lsum * a1 + l2 * a2);
#pragma unroll
            for (int g4 = 0; g4 < 4; ++g4) {
                float o[4];
#pragma unroll
                for (int e = 0; e < 4; ++e) { const float mine = khalf ? O1[4 * g4 + e] : O0[4 * g4 + e]; const unsigned pw = ox[2 * g4 + (e >> 1)]; const float oth = (e & 1) ? bfhi(pw) : bflo(pw);
                    o[e] = (mine * a1 + oth * a2) * inv; }
                const u32x2 z2 = zz[g4];
                const float y0 = o[0] * silu(bflo(z2.x)), y1 = o[1] * silu(bfhi(z2.x)), y2 = o[2] * silu(bflo(z2.y)), y3 = o[3] * silu(bfhi(z2.y));
                u32x2 w; w.x = cvt_pk_bf16(y0, y1); w.y = cvt_pk_bf16(y2, y3); *(u32x2*)(yp + 8 * g4) = w; }
        }
    }
    __builtin_amdgcn_s_setprio(0);
    LDS_BARRIER();
}

__device__ __forceinline__ size_t cst_off(int cid, int c, int d) { return ((size_t)((cid * 8 + (d >> 4)) * 64 + c)) * 2048 + (size_t)(d & 15) * 128; }
__device__ __forceinline__ void m1_wave(Ctx& F, int wi, int l) {
    const int b = wi >> 9, head = (wi >> 7) & 3, c = (wi >> 1) & 63, dir = wi & 1;
    const int tok0 = b * SEQ + c * 64;
    const int lane = F.lane, r = lane & 31, h = lane >> 5;
    LAS float* wtab = (LAS float*)(F.lds + F.wave * 256);
    const float ig = F.gate[(size_t)(tok0 + lane) * 16 + (2 * dir) * 4 + head];
    const float fg = F.gate[(size_t)(tok0 + lane) * 16 + (2 * dir + 1) * 4 + head] + F.fbias[l * 8 + dir * 4 + head];
    const float lf = logsigmoid(fg);
    const float cs = dir == 0 ? scan_sum_up(lf, lane) : scan_sum_down(lf, lane);
    const float g = shi(cs, dir == 0 ? 63 : 0);
    const float a = g - cs + ig;
    const float mloc = wave_max(a, lane);
    const float w = fexp(a - mloc);
    wtab[lane] = w;
    LDS_WAIT();
    const int cid = dir * 16 + b * 4 + head;
    if (lane == 0) { F.gs[cid * 64 + c] = g; F.ml[cid * 64 + c] = mloc; }
    f32x4 wv[8];
#pragma unroll
    for (int s = 0; s < 4; ++s) { wv[2 * s] = *(const LAS f32x4*)(wtab + 16 * s + 4 * h); wv[2 * s + 1] = *(const LAS f32x4*)(wtab + 16 * s + 8 + 4 * h); }
    bf16x8 af[4][4];
    {
        bf16x8 kn[2][8];
#pragma unroll
        for (int T = 0; T < 2; ++T)
#pragma unroll
            for (int j = 0; j < 8; ++j) kn[T][j] = *(const bf16x8*)(F.unat + (size_t)(tok0 + 32 * T + r) * LDN + N_BK + head * 128 + 16 * j + 8 * h);
        u32x4 i0, i1;
        { const unsigned one_lo = 0x3F80u, one_hi = 0x3F800000u; const int d0 = r - 8 * h, d1 = r - 16 - 8 * h;
          i0.x = d0 == 0 ? one_lo : d0 == 1 ? one_hi : 0u; i0.y = d0 == 2 ? one_lo : d0 == 3 ? one_hi : 0u; i0.z = d0 == 4 ? one_lo : d0 == 5 ? one_hi : 0u; i0.w = d0 == 6 ? one_lo : d0 == 7 ? one_hi : 0u;
          i1.x = d1 == 0 ? one_lo : d1 == 1 ? one_hi : 0u; i1.y = d1 == 2 ? one_lo : d1 == 3 ? one_hi : 0u; i1.z = d1 == 4 ? one_lo : d1 == 5 ? one_hi : 0u; i1.w = d1 == 6 ? one_lo : d1 == 7 ? one_hi : 0u; }
        const bf16x8 I0 = __builtin_bit_cast(bf16x8, i0), I1 = __builtin_bit_cast(bf16x8, i1);
#pragma unroll
        for (int et = 0; et < 4; ++et)
#pragma unroll
            for (int T = 0; T < 2; ++T) {
                f32x16 d = zero16();
                d = MFMA32(kn[T][2 * et], I0, d); d = MFMA32(kn[T][2 * et + 1], I1, d);
                af[et][2 * T] = pack8(d, 0); af[et][2 * T + 1] = pack8(d, 1);
            }
    }
#pragma unroll
    for (int et = 0; et < 4; ++et) { float ns = 0.f;
#pragma unroll
        for (int s = 0; s < 4; ++s) { const u32x4 raw = __builtin_bit_cast(u32x4, af[et][s]); const f32x4 w0 = wv[2 * s], w1 = wv[2 * s + 1];
            ns += bflo(raw.x) * w0[0] + bfhi(raw.x) * w0[1] + bflo(raw.y) * w0[2] + bfhi(raw.y) * w0[3] + bflo(raw.z) * w1[0] + bfhi(raw.z) * w1[1] + bflo(raw.w) * w1[2] + bfhi(raw.w) * w1[3]; }
        ns += shx(ns, 32, lane);
        if (h == 0) F.nst[(size_t)(cid * 64 + c) * 128 + 32 * et + r] = ns; }
#pragma unroll 1
    for (int dt = 0; dt < 4; ++dt) {
        bf16x8 bfr[4];
#pragma unroll
        for (int s = 0; s < 4; ++s) {
            const bf16* vp = F.ut + (size_t)(T_BV + head * 128 + 32 * dt + r) * M + tok0 + 16 * s + 4 * h;
            const u32x2 rlo = *(const u32x2*)vp, rhi = *(const u32x2*)(vp + 8); u32x4 raw; raw.x = rlo.x; raw.y = rlo.y; raw.z = rhi.x; raw.w = rhi.y;
            const f32x4 w0 = wv[2 * s], w1 = wv[2 * s + 1];
            u32x4 o; o.x = cvt_pk_bf16(bflo(raw.x) * w0[0], bfhi(raw.x) * w0[1]); o.y = cvt_pk_bf16(bflo(raw.y) * w0[2], bfhi(raw.y) * w0[3]);
            o.z = cvt_pk_bf16(bflo(raw.z) * w1[0], bfhi(raw.z) * w1[1]); o.w = cvt_pk_bf16(bflo(raw.w) * w1[2], bfhi(raw.w) * w1[3]);
            bfr[s] = __builtin_bit_cast(bf16x8, o);
        }
        bf16* cdst = F.cst + cst_off(cid, c, 32 * dt + r);
#pragma unroll
        for (int et = 0; et < 4; ++et) {
            f32x16 acc = zero16();
#pragma unroll
            for (int s = 0; s < 4; ++s) acc = MFMA32(af[et][s], bfr[s], acc);
#pragma unroll
            for (int g4 = 0; g4 < 4; ++g4) { u32x2 o; o.x = cvt_pk_bf16(acc[4 * g4], acc[4 * g4 + 1]); o.y = cvt_pk_bf16(acc[4 * g4 + 2], acc[4 * g4 + 3]); *(u32x2*)(cdst + 32 * et + 8 * g4 + 4 * h) = o; }
        }
    }
    LDS_WAIT();
}

__device__ __forceinline__ void m2_scan(Ctx& F) {
    LAS float* sps = (LAS float*)F.lds; LAS float* sls = sps + 64;
    for (int blk = F.bid; blk < 256; blk += F.G) {
        const int cid = blk >> 3, dir = cid >> 4, e4 = (blk & 7) * 512 + F.tid;
        if (F.wave == 0) {
            const int sidx = F.lane, c = dir ? 63 - sidx : sidx;
            const float g = F.gs[cid * 64 + c], mloc = F.ml[cid * 64 + c];
            const float Gs = scan_sum_up(g, sidx);
            const float ma = Gs + fmaxf(0.f, scan_max_up(mloc - Gs, sidx));
            const float mb0 = shi(ma, sidx - 1); const float mb = sidx == 0 ? 0.f : mb0;
            sps[sidx] = fexp(g + mb - ma); sls[sidx] = fexp(mloc - ma); F.mprev[cid * 64 + c] = mb;
        }
        __syncthreads();
        float C0 = 0.f, C1 = 0.f, C2 = 0.f, C3 = 0.f;
        f32x4 nn = {0.f, 0.f, 0.f, 0.f};
        const bool do_n = e4 < 32;
        bf16* cb = F.cst + (size_t)(cid * 8 + (blk & 7)) * 64 * 2048 + F.tid * 4;
        float* nb = F.nst + (size_t)cid * 64 * 128 + (e4 & 31) * 4;
#pragma unroll 1
        for (int s0 = 0; s0 < 64; s0 += 16) {
            u32x2 cl[16]; f32x4 nl[16];
#pragma unroll
            for (int j = 0; j < 16; ++j) { const int c = dir ? 63 - (s0 + j) : (s0 + j); cl[j] = *(const u32x2*)(cb + (size_t)c * 2048); }
            if (do_n) {
#pragma unroll
                for (int j = 0; j < 16; ++j) { const int c = dir ? 63 - (s0 + j) : (s0 + j); nl[j] = *(const f32x4*)(nb + (size_t)c * 128); }
            }
#pragma unroll
            for (int j = 0; j < 16; ++j) {
                const int c = dir ? 63 - (s0 + j) : (s0 + j);
                u32x2 o; o.x = cvt_pk_bf16(C0, C1); o.y = cvt_pk_bf16(C2, C3); *(u32x2*)(cb + (size_t)c * 2048) = o;
                const float sp = sps[s0 + j], sl = sls[s0 + j];
                C0 = sp * C0 + sl * bflo(cl[j].x); C1 = sp * C1 + sl * bfhi(cl[j].x); C2 = sp * C2 + sl * bflo(cl[j].y); C3 = sp * C3 + sl * bfhi(cl[j].y);
                if (do_n) { *(f32x4*)(nb + (size_t)c * 128) = nn; nn = nn * sp + nl[j] * sl; }
            }
        }
        __syncthreads();
    }
}

constexpr int M3_TABW = 2560, M3_HB = 8 * M3_TABW  , M3_HW = 16384;
static_assert(M3_HB + 8 * M3_HW <= MISC_OFF, "M3 LDS map");
__device__ __forceinline__ void m3_wave(Ctx& F, int wi, int l) {
    const int b = wi >> 9, head = (wi >> 7) & 3, c = (wi >> 1) & 63, tt = wi & 1;
    const int tok0 = b * SEQ + c * 64;
    int lane_ = 0; asm volatile("" : "+v"(lane_)); lane_ = (int)__builtin_amdgcn_mbcnt_hi(~0u, __builtin_amdgcn_mbcnt_lo(~0u, (unsigned)lane_));
    const int lane = lane_, r = lane & 31, h = lane >> 5;
    LAS float* tab = (LAS float*)(F.lds + F.wave * M3_TABW);
    LAS float* hb = (LAS float*)(F.lds + M3_HB + F.wave * M3_HW);
    const int cidf = b * 4 + head, cidb = 16 + b * 4 + head;
    const int t = 32 * tt + r;
    const float* gp = F.gate + (size_t)(tok0 + lane) * 16;
    const float g_if = gp[head], g_ff = gp[4 + head], g_ib = gp[8 + head], g_fb = gp[12 + head];
    const float mpf = F.mprev[cidf * 64 + c], mpb = F.mprev[cidb * 64 + c];
    const float* nf = F.nst + (size_t)(cidf * 64 + c) * 128; const float* nbw = F.nst + (size_t)(cidb * 64 + c) * 128;
    const float n0_ = nf[lane], n1_ = nf[64 + lane], n2_ = nbw[lane], n3_ = nbw[64 + lane];
    bf16x8 qf[8], kf0[8];
#pragma unroll
    for (int s = 0; s < 8; ++s) qf[s] = *(const bf16x8*)(F.unat + (size_t)(tok0 + t) * LDN + N_BQ + head * 128 + 16 * s + 8 * h);
#pragma unroll
    for (int s = 0; s < 8; ++s) kf0[s] = *(const bf16x8*)(F.unat + (size_t)(tok0 + r) * LDN + N_BK + head * 128 + 16 * s + 8 * h);
    SCHED_FENCE();
    {
        const float f_f = g_ff + F.fbias[l * 8 + head], f_b = g_fb + F.fbias[l * 8 + 4 + head];
        const float bf_ = scan_sum_up(logsigmoid(f_f), lane), bb_ = scan_sum_down(logsigmoid(f_b), lane);
        const float uf = g_if - bf_, ub = g_ib - bb_;
        const float MF = fmaxf(mpf, scan_max_up(uf, lane)), MB = fmaxf(mpb, scan_max_down(ub, lane));
        tab[lane] = uf; tab[64 + lane] = ub; tab[128 + lane] = MF; tab[192 + lane] = MB; tab[256 + lane] = bf_; tab[320 + lane] = bb_;
        tab[384 + lane] = n0_; tab[448 + lane] = n1_; tab[512 + lane] = n2_; tab[576 + lane] = n3_;
        LDS_WAIT();
    }
    f32x16 S0 = zero16(), S1 = zero16();
    {
        bf16x8 kf1[8];
#pragma unroll
        for (int s = 0; s < 8; ++s) kf1[s] = *(const bf16x8*)(F.unat + (size_t)(tok0 + 32 + r) * LDN + N_BK + head * 128 + 16 * s + 8 * h);
        SCHED_FENCE();
#pragma unroll
        for (int s = 0; s < 8; ++s) S0 = MFMA32(kf0[s], qf[s], S0);
#pragma unroll
        for (int s = 0; s < 8; ++s) S1 = MFMA32(kf1[s], qf[s], S1);
    }
    bf16x8 pb[2][4]; float interw[2], inv[2];
#pragma unroll
    for (int dir = 0; dir < 2; ++dir) {
        const LAS float* U = tab + dir * 64;
        const float Mt = tab[128 + dir * 64 + t], Bt = tab[256 + dir * 64 + t], mp = dir ? mpb : mpf;
        const LAS float* np = tab + 384 + dir * 128 + 8 * h;
        float nq = 0.f;
#pragma unroll
        for (int s = 0; s < 8; ++s) { const f32x4 n0 = *(const LAS f32x4*)(np + 16 * s), n1 = *(const LAS f32x4*)(np + 16 * s + 4); const u32x4 qq = __builtin_bit_cast(u32x4, qf[s]);
            nq += n0[0] * bflo(qq.x) + n0[1] * bfhi(qq.x) + n0[2] * bflo(qq.y) + n0[3] * bfhi(qq.y) + n1[0] * bflo(qq.z) + n1[1] * bfhi(qq.z) + n1[2] * bflo(qq.w) + n1[3] * bfhi(qq.w); }
        nq += shx(nq, 32, lane);
        interw[dir] = fexp(mp - Mt) * QS;
        float den = 0.f;
#pragma unroll
        for (int st = 0; st < 2; ++st) {
            f32x16 P;
#pragma unroll
            for (int g4 = 0; g4 < 4; ++g4) { const f32x4 uu = *(const LAS f32x4*)(U + 32 * st + 8 * g4 + 4 * h);
#pragma unroll
                for (int e = 0; e < 4; ++e) { const int sp = 32 * st + 8 * g4 + 4 * h + e; const bool ok = dir ? (sp >= t) : (sp <= t);
                    const float wgt = ok ? fexp(uu[e] - Mt) : 0.f; const float pv = (st ? S1[4 * g4 + e] : S0[4 * g4 + e]) * QS * wgt; P[4 * g4 + e] = pv; den += pv; } }
            pb[dir][2 * st] = pack8(P, 0); pb[dir][2 * st + 1] = pack8(P, 1);
        }
        den += shx(den, 32, lane);
        den += nq * interw[dir];
        inv[dir] = frcp(fmaxf(fabsf(den), fexp(-(Bt + Mt))));
    }
    bf16x8 cfa[8], cfb[8]; s16x4 vv[8]; u32x2 og[4];
    int ro = r, ho = h; asm volatile("" : "+v"(ro), "+v"(ho));
    const int to = 32 * tt + ro;
#define M3_LOADC(dst, dir, dt) do { SCHED_FENCE(); { const bf16* cp = F.cst + cst_off((dir ? cidb : cidf), c, 32 * (dt) + ro) + 8 * ho; \
        _Pragma("unroll") for (int s = 0; s < 8; ++s) dst[s] = *(const bf16x8*)(cp + 16 * s); } SCHED_FENCE(); } while (0)
#define M3_LOADV(dt) do { SCHED_FENCE(); { const bf16* vp = F.ut + (size_t)(T_BV + head * 128 + 32 * (dt) + ro) * M + tok0 + 4 * ho; \
        _Pragma("unroll") for (int ks = 0; ks < 4; ++ks) { vv[2 * ks] = *(const s16x4*)(vp + 16 * ks); vv[2 * ks + 1] = *(const s16x4*)(vp + 16 * ks + 8); } } \
        { const bf16* op = F.unat + (size_t)(tok0 + to) * LDN + N_BO + head * 128 + 32 * (dt) + 4 * ho; \
        _Pragma("unroll") for (int g4 = 0; g4 < 4; ++g4) og[g4] = *(const u32x2*)(op + 8 * g4); } SCHED_FENCE(); } while (0)
    M3_LOADC(cfa, 0, 0); M3_LOADV(0);
    float s1 = 0.f, s2 = 0.f;
#pragma unroll 1
    for (int dt = 0; dt < 4; ++dt) {
        f32x16 H;
        {
            f32x16 X = zero16();
#pragma unroll
            for (int s = 0; s < 8; ++s) X = MFMA32(cfa[s], qf[s], X);
            M3_LOADC(cfb, 1, dt);
            const float iw = interw[0];
#pragma unroll
            for (int i = 0; i < 16; ++i) X[i] *= iw;
#pragma unroll
            for (int ks = 0; ks < 4; ++ks) X = MFMA32(__builtin_shufflevector(vv[2 * ks], vv[2 * ks + 1], 0, 1, 2, 3, 4, 5, 6, 7), pb[0][ks], X);
            const float iv = inv[0];
#pragma unroll
            for (int i = 0; i < 16; ++i) H[i] = X[i] * iv;
        }
        {
            f32x16 X = zero16();
#pragma unroll
            for (int s = 0; s < 8; ++s) X = MFMA32(cfb[s], qf[s], X);
            if (dt < 3) M3_LOADC(cfa, 0, dt + 1);
            const float iw = interw[1];
#pragma unroll
            for (int i = 0; i < 16; ++i) X[i] *= iw;
#pragma unroll
            for (int ks = 0; ks < 4; ++ks) X = MFMA32(__builtin_shufflevector(vv[2 * ks], vv[2 * ks + 1], 0, 1, 2, 3, 4, 5, 6, 7), pb[1][ks], X);
            const float iv = inv[1];
#pragma unroll
            for (int i = 0; i < 16; ++i) H[i] += X[i] * iv;
        }
#pragma unroll
        for (int g4 = 0; g4 < 4; ++g4) { const u32x2 oo = og[g4];
            H[4 * g4] *= sigm(bflo(oo.x)); H[4 * g4 + 1] *= sigm(bfhi(oo.x)); H[4 * g4 + 2] *= sigm(bflo(oo.y)); H[4 * g4 + 3] *= sigm(bfhi(oo.y)); }
        if (dt < 3) M3_LOADV(dt + 1);
#pragma unroll
        for (int i = 0; i < 16; ++i) { s1 += H[i]; s2 += H[i] * H[i]; hb[(dt * 16 + i) * 64 + lane] = H[i]; }
    }
#undef M3_LOADC
#undef M3_LOADV
    s1 += shx(s1, 32, lane); s2 += shx(s2, 32, lane);
    const float mean = s1 * (1.f / 128.f), var = fmaxf(s2 * (1.f / 128.f) - mean * mean, 0.f), rstd = __builtin_amdgcn_rsqf(var + LN_EPS);
    LDS_WAIT();
    int rz = r, hz = h; asm volatile("" : "+v"(rz), "+v"(hz)); const int tz = 32 * tt + rz;
    bf16* yp = F.yb + (size_t)(tok0 + tz) * DM + 768 + head * 128 + 4 * hz;
    const bf16* zp = F.unat + (size_t)(tok0 + tz) * LDN + N_BZ + head * 128 + 4 * hz; const float* ng = F.norm_g + l * 512 + head * 128 + 4 * hz;
#pragma unroll 1
    for (int half = 0; half < 2; ++half) {
        u32x2 zz[8]; f32x4 gn[8];
#pragma unroll
        for (int i = 0; i < 8; ++i) { zz[i] = *(const u32x2*)(zp + 8 * (8 * half + i)); gn[i] = *(const f32x4*)(ng + 8 * (8 * half + i)); }
#pragma unroll
        for (int i = 0; i < 8; ++i) { const int ii = 8 * half + i;
            const float h0 = hb[(4 * ii) * 64 + lane], h1 = hb[(4 * ii + 1) * 64 + lane], h2 = hb[(4 * ii + 2) * 64 + lane], h3 = hb[(4 * ii + 3) * 64 + lane];
            const float y0 = (h0 - mean) * rstd * gn[i][0] * silu(bflo(zz[i].x)), y1 = (h1 - mean) * rstd * gn[i][1] * silu(bfhi(zz[i].x));
            const float y2 = (h2 - mean) * rstd * gn[i][2] * silu(bflo(zz[i].y)), y3 = (h3 - mean) * rstd * gn[i][3] * silu(bfhi(zz[i].y));
            u32x2 w; w.x = cvt_pk_bf16(y0, y1); w.y = cvt_pk_bf16(y2, y3); *(u32x2*)(yp + 8 * ii) = w; }
    }
    LDS_WAIT();
}

__global__ void __launch_bounds__(NTHR, 2) mega(Args args) {
    extern __shared__ __attribute__((aligned(16))) unsigned char lds_raw[];
    LAS unsigned char* const ldsb = (LAS unsigned char*)lds_raw;
    const int wave_s = __builtin_amdgcn_readfirstlane((int)threadIdx.x >> 6);
#define TID_NOW() ([&]() { unsigned z_ = 0u; asm volatile("" : "+v"(z_)); return wave_s * 64 + (int)__builtin_amdgcn_mbcnt_hi(~0u, __builtin_amdgcn_mbcnt_lo(~0u, z_)); }())
#define MAKE_CTX() MAKE_CTX_L(1)
#define MAKE_CTX_L(lyr) Ctx F; { const int l_ = (lyr); auto kp_ = __builtin_amdgcn_kernarg_segment_ptr(); asm volatile("" : "+s"(kp_)); \
    const __attribute__((address_space(4))) Args* ap_ = (const __attribute__((address_space(4))) Args*)kp_; \
    F.lds = ldsb; { int tid_ = TID_NOW(); asm volatile("" : "+v"(tid_)); F.tid = tid_; } F.lane = F.tid & 63; F.wave = wave_s; F.G = gridDim.x; F.bid = blockIdx.x; \
    F.x = ap_->in[0]; F.emb_g = ap_->in[1]; F.emb_b = ap_->in[2]; F.w_in = ap_->in[3]; F.b_in = ap_->in[4]; F.w_out = ap_->in[5]; F.b_out = ap_->in[6]; \
    F.ln_g = ap_->in[7]; F.ln_b = ap_->in[8]; F.t5 = ap_->in[9]; F.sink = ap_->in[10]; F.fbias = ap_->in[11]; F.norm_g = ap_->in[12]; F.rpb = ap_->in[13]; \
    F.out = ap_->out; F.ws = ap_->ws; \
    F.hby = (bf16*)(F.ws + WS_HBY); F.yb = l_ == 0 ? (bf16*)F.out : F.hby; F.unat = (bf16*)(F.ws + WS_UNAT); F.ut = (bf16*)(F.ws + WS_UT); F.cst = (bf16*)(F.ws + WS_CST); F.nst = (float*)(F.ws + WS_NST); \
    F.gs = (float*)(F.ws + WS_SCAL); F.ml = F.gs + 2048; F.mprev = F.gs + 4096; F.gate = (float*)(F.ws + WS_GATE); F.stat = (float*)(F.ws + WS_SCAL + 65536); }
    volatile LAS unsigned* MISC = (volatile LAS unsigned*)(ldsb + MISC_OFF);
    if (threadIdx.x < 32) MISC[threadIdx.x] = 0u;
    __syncthreads();
    XcdBarrier bar; bar.bar = (unsigned*)(args.ws + WS_CTL) + CW_BAR; bar.x = 0; bar.st = nullptr;
    if (!MK_PER_PHASE) bar = xcd_barrier_post((unsigned*)(args.ws + WS_CTL) + CW_BAR, MISC + 8, (int)threadIdx.x);
    const int lo = args.ph_lo, hi = args.ph_hi;
#define IN(k) (lo <= (k) && (k) < hi)
#define SEAM(k) do { if (IN(k) && IN((k) + 1)) { for (int rb_ = 0; rb_ < REP_BAR; ++rb_) xcd_barrier(bar, TID_NOW()); } } while (0)
    #ifndef NO_P0
    if (IN(0)) { MAKE_CTX(); for (int rep_ = 0, nrep_ = opaque_int(REP_P0); rep_ < nrep_; ++rep_) phase_prologue(F); }
#endif
    SEAM(0);
#pragma unroll 1
    for (int l = 0; l < 2; ++l) {
        const int pb = 1 + 6 * l;
        if (IN(pb)) {
#ifndef NO_G1
            {   MAKE_CTX_L(l);
                pg8::Sched1 S{(const char*)F.hby, (const char*)(F.ws + WS_WIN + l * WIN_STRIDE), F.G, F.bid};
                pg8::Epi1 E{F.unat, F.ut, (const float*)(F.ws + WS_BIAS) + l * WROWS};
                pg8::gemm_phase<pg8::Epi1, pg8::Sched1, true, true>(F.lds, S, E, F.tid); }
#endif
#ifndef NO_GATES
            {   MAKE_CTX_L(l);
                if (l == 0) { bool is_h; int hid, nh; helper_of(F, 0, is_h, hid, nh); if (is_h) { weights_job(F, 1, hid * NWAVES + F.wave, nh * NWAVES); } __syncthreads(); }
                gates_job(F, l); }
#endif
        }
        SEAM(pb);
        if (IN(pb + 1)) {
            MAKE_CTX_L(l);
#ifndef NO_M1
            for (int rep_ = 0, nrep_ = opaque_int(REP_M1); rep_ < nrep_; ++rep_) for (int wi = F.bid * NWAVES + F.wave; wi < 2048; wi += F.G * NWAVES) m1_wave(F, wi, l);
#endif
            __syncthreads();
#ifndef NO_WA
            for (int rep_ = 0, nrep_ = opaque_int(REP_WA); rep_ < nrep_; ++rep_) for (int it0 = F.bid; it0 < 256; it0 += F.G) wattn_item(F, (F.G == 256) ? ((it0 & 7) * 32 + (it0 >> 3)) : it0, l);
#endif
        }
        SEAM(pb + 1);
        if (IN(pb + 2)) {
            MAKE_CTX_L(l);
#ifndef NO_M2
            m2_scan(F);
#endif
#ifndef NO_NA
            for (int rep_ = 0, nrep_ = opaque_int(REP_NA); rep_ < nrep_; ++rep_) nattn_all(F, l);
#endif
        }
        SEAM(pb + 2);
        if (IN(pb + 3)) {
            MAKE_CTX_L(l);
#ifndef NO_M3
            for (int rep_ = 0, nrep_ = opaque_int(REP_M3); rep_ < nrep_; ++rep_) for (int wi = F.bid * NWAVES + F.wave; wi < 2048; wi += F.G * NWAVES) m3_wave(F, wi, l);
#endif
        }
        SEAM(pb + 3);
        if (IN(pb + 4)) {
            MAKE_CTX_L(l);
            pg8::Sched2 S{(const char*)F.yb, (const char*)(F.ws + WS_WOUT + l * WOUT_STRIDE), F.G, F.bid};
#ifndef NO_G2
            if (l == 0) { pg8::Epi2<0> E{(float*)nullptr, (bf16*)(F.ws + WS_WIN), F.b_out, F.x, (const bf16*)F.hby, F.stat, F.emb_g, F.emb_b, (bf16*)(F.ws + WS_T1B)};
                pg8::gemm_phase<pg8::Epi2<0>, pg8::Sched2, true, true>(F.lds, S, E, F.tid); }
            else { pg8::Epi2<1> E{(float*)nullptr, (bf16*)(F.ws + WS_UNAT), F.b_out + DM, (const float*)nullptr, (const bf16*)nullptr, (const float*)nullptr, (const float*)nullptr, (const float*)nullptr, (bf16*)nullptr};
                pg8::gemm_phase<pg8::Epi2<1>, pg8::Sched2, true, true>(F.lds, S, E, F.tid); }
#endif
        }
        SEAM(pb + 4);
        if (IN(pb + 5)) {
            MAKE_CTX_L(l);
            const int gw = F.bid * NWAVES + F.wave, NGW = F.G * NWAVES;
            if (l == 0) { for (int m = 2 * gw; m < M; m += 2 * NGW) ln_row2_b(t1_row(F.ws, m), t1_row(F.ws, m + 1), F.hby + (size_t)m * DM, F.hby + (size_t)(m + 1) * DM, F.stat + (size_t)(M + m) * 2, F.stat + (size_t)(M + m + 1) * 2, F.ln_g, F.ln_b, F.lane); }
            else { const bf16* O2 = (const bf16*)(F.ws + WS_UNAT);
                   for (int m = 2 * gw; m < M; m += 2 * NGW) fin_row2(t1_row(F.ws, m), O2 + (size_t)m * DM, F.stat + (size_t)(M + m) * 2, F.ln_g, F.ln_b, F.ln_g + DM, F.ln_b + DM, F.out + (size_t)m * DM, F.lane); }
        }
        if (l == 0) SEAM(pb + 5);
    }
#undef IN
#undef SEAM
}

extern "C" void kernel_launch(void* const* d_in, const int* in_sizes, int n_in, void* d_out, int out_size, void* d_ws, size_t ws_size, hipStream_t stream) {
    static int grid = 0;
    if (grid == 0) {
        if (n_in != 14 || out_size != M * DM || ws_size < WS_END) { fprintf(stderr, "kernel_launch: unexpected shapes (n_in %d out %d ws %zu)\n", n_in, out_size, ws_size); grid = -1; return; }
        int dev = 0, cus = 0, per_cu = 0;
        if (hipGetDevice(&dev) != hipSuccess || hipDeviceGetAttribute(&cus, hipDeviceAttributeMultiprocessorCount, dev) != hipSuccess) { grid = -1; return; }
        if (hipFuncSetAttribute((const void*)mega, hipFuncAttributeMaxDynamicSharedMemorySize, LDS_BYTES) != hipSuccess) { fprintf(stderr, "kernel_launch: hipFuncSetAttribute failed\n"); grid = -1; return; }
        if (hipOccupancyMaxActiveBlocksPerMultiprocessor(&per_cu, (const void*)mega, NTHR, LDS_BYTES) != hipSuccess || per_cu < 1) fprintf(stderr, "kernel_launch: occupancy query says %d\n", per_cu);
        (void)hipGetLastError();
        grid = cus;
    }
    if (grid < 0) return;
    (void)hipMemsetAsync((char*)d_ws + WS_CTL + (size_t)CW_BAR * 4, 0, 16384, stream);
    Args a{};
    for (int i = 0; i < 14; ++i) a.in[i] = (const float*)d_in[i];
    a.out = (float*)d_out; a.ws = (unsigned char*)d_ws;
#if MK_PER_PHASE
    for (int p = 0; p < 13; ++p) { a.ph_lo = p; a.ph_hi = p + 1; hipLaunchKernelGGL(mega, dim3(grid), dim3(NTHR), LDS_BYTES, stream, a); }
#else
    a.ph_lo = 0; a.ph_hi = 13;
    hipLaunchKernelGGL(mega, dim3(grid), dim3(NTHR), LDS_BYTES, stream, a);
#endif
}
```

```cpp
#include <hip/hip_runtime.h>
#include <cstdio>
#include <cstdint>

#ifndef REP_P0
#define REP_P0 1
#endif
#ifndef REP_G1
#define REP_G1 1
#endif
#ifndef REP_M1
#define REP_M1 1
#endif
#ifndef REP_WA
#define REP_WA 1
#endif
#ifndef REP_NA
#define REP_NA 1
#endif
#ifndef REP_M3
#define REP_M3 1
#endif
#ifndef REP_GATES
#define REP_GATES 1
#endif
#ifndef REP_BAR
#define REP_BAR 1
#endif
#ifndef MK_PER_PHASE
#define MK_PER_PHASE 0
#endif

#define LAS __attribute__((address_space(3)))
#define GAS __attribute__((address_space(1)))
typedef unsigned short bf16;
typedef short bf16x8 __attribute__((ext_vector_type(8)));
typedef short s16x4 __attribute__((ext_vector_type(4)));
typedef float f32x4 __attribute__((ext_vector_type(4)));
typedef float f32x16 __attribute__((ext_vector_type(16)));
typedef unsigned u32x4 __attribute__((ext_vector_type(4)));
typedef unsigned u32x2 __attribute__((ext_vector_type(2)));
typedef GAS unsigned gu32;

constexpr int M = 16384, DM = 2048, SEQ = 4096, IN_W = 7696, NWAVES = 8, NTHR = 512;
constexpr int LDN = 6144;
constexpr int N_AQ = 0, N_AK = 768, N_AZ = 1024, N_BQ = 1792, N_BK = 2304, N_BO = 2816, N_BZ = 3328, N_CQ = 3840, N_CK = 4608, N_CZ = 5376;
constexpr int T_AV = 0, T_BK = 256, T_BV = 768, T_CV = 1280;
constexpr int WROWS = 8192 + 16;
constexpr float LN_EPS = 1e-5f, LOG2E = 1.4426950408889634f, ALPHA = 1.4142135623730951f;
constexpr float C2A = 0.125f * LOG2E;
constexpr float QS = 0.08838834764831845f;

constexpr size_t MiB = 1u << 20;
constexpr size_t WS_CTL = 0, CTL_BYTES = 1 * MiB;
constexpr size_t WS_WIN = 2 * MiB, WIN_STRIDE = 33 * MiB;
constexpr size_t WS_WOUT = 68 * MiB, WOUT_STRIDE = 8 * MiB;
constexpr size_t WS_BIAS = 84 * MiB;
constexpr size_t WS_GATE = 85 * MiB;
constexpr size_t WS_HBY = 86 * MiB;
constexpr size_t WS_UNAT = 150 * MiB;
constexpr size_t WS_UT = 342 * MiB;
constexpr size_t WS_CST = 406 * MiB;
constexpr size_t WS_NST = 470 * MiB;
constexpr size_t WS_SCAL = 471 * MiB;
constexpr size_t WS_T1B = 472 * MiB;
constexpr size_t WS_END = 504 * MiB;
constexpr int CW_BAR = 4096;

constexpr int LDS_BYTES = 163840, MISC_OFF = LDS_BYTES - 128;

__device__ __forceinline__ int opaque_int(int v) { asm volatile("" : "+s"(v)); return v; }
#define LDS_WAIT() asm volatile("s_waitcnt lgkmcnt(0)" ::: "memory")
#define LDS_BARRIER() do { asm volatile("s_waitcnt lgkmcnt(0)" ::: "memory"); __builtin_amdgcn_s_barrier(); asm volatile("" ::: "memory"); } while (0)
#define VM_WAIT() asm volatile("s_waitcnt vmcnt(0)" ::: "memory")
__device__ __forceinline__ float bf2f(unsigned v) { return __uint_as_float(v << 16); }
__device__ __forceinline__ float bflo(unsigned v) { return __uint_as_float(v << 16); }
__device__ __forceinline__ float bfhi(unsigned v) { return __uint_as_float(v & 0xffff0000u); }
typedef float f32x2_t __attribute__((ext_vector_type(2)));
typedef __bf16 bf16x2_t __attribute__((ext_vector_type(2)));
__device__ __forceinline__ unsigned cvt_pk_bf16(float lo, float hi) { const f32x2_t v = {lo, hi}; const bf16x2_t b = __builtin_convertvector(v, bf16x2_t); return __builtin_bit_cast(unsigned, b); }
__device__ __forceinline__ float ex2(float x) { return __builtin_amdgcn_exp2f(x); }
__device__ __forceinline__ float fexp(float x) { return __builtin_amdgcn_exp2f(x * LOG2E); }
__device__ __forceinline__ float frcp(float x) { return __builtin_amdgcn_rcpf(x); }
__device__ __forceinline__ float silu(float x) { return x * frcp(1.f + fexp(-x)); }
__device__ __forceinline__ float sigm(float x) { return frcp(1.f + fexp(-x)); }
__device__ __forceinline__ float logsigmoid(float x) { return fminf(x, 0.f) - log1pf(expf(-fabsf(x))); }
__device__ __forceinline__ int crow(int reg, int h) { return (reg & 3) + 8 * (reg >> 2) + 4 * h; }
__device__ __forceinline__ float shx(float v, int mask, int lane) { return __int_as_float(__builtin_amdgcn_ds_bpermute((lane ^ mask) << 2, __float_as_int(v))); }
__device__ __forceinline__ float shi(float v, int src) { return __int_as_float(__builtin_amdgcn_ds_bpermute(src << 2, __float_as_int(v))); }
__device__ __forceinline__ float wave_sum(float v, int lane) {
#pragma unroll
    for (int o = 1; o < 64; o <<= 1) v += shx(v, o, lane);
    return v;
}
__device__ __forceinline__ float wave_max(float v, int lane) {
#pragma unroll
    for (int o = 1; o < 64; o <<= 1) v = fmaxf(v, shx(v, o, lane));
    return v;
}
__device__ __forceinline__ float scan_sum_up(float v, int lane) {
#pragma unroll
    for (int o = 1; o < 64; o <<= 1) { const float t = shi(v, lane - o); if (lane >= o) v += t; }
    return v;
}
__device__ __forceinline__ float scan_sum_down(float v, int lane) {
#pragma unroll
    for (int o = 1; o < 64; o <<= 1) { const float t = shi(v, lane + o); if (lane + o < 64) v += t; }
    return v;
}
__device__ __forceinline__ float scan_max_up(float v, int lane) {
#pragma unroll
    for (int o = 1; o < 64; o <<= 1) { const float t = shi(v, lane - o); if (lane >= o) v = fmaxf(v, t); }
    return v;
}
__device__ __forceinline__ float scan_max_down(float v, int lane) {
#pragma unroll
    for (int o = 1; o < 64; o <<= 1) { const float t = shi(v, lane + o); if (lane + o < 64) v = fmaxf(v, t); }
    return v;
}
__device__ __forceinline__ int t5_bucket(int rel) {
    const int n = rel < 0 ? -rel : rel; const int ret = rel > 0 ? 16 : 0;
    const int large = 8 + (n >= 12) + (n >= 16) + (n >= 23) + (n >= 32) + (n >= 46) + (n >= 64) + (n >= 91);
    return ret + (n < 8 ? n : large);
}
#define PIN16(a) asm volatile("" : "+v"(a[0]), "+v"(a[1]), "+v"(a[2]), "+v"(a[3]), "+v"(a[4]), "+v"(a[5]), "+v"(a[6]), "+v"(a[7]), "+v"(a[8]), "+v"(a[9]), "+v"(a[10]), "+v"(a[11]), "+v"(a[12]), "+v"(a[13]), "+v"(a[14]), "+v"(a[15]))
#define MFMA32(a, b, c) __builtin_amdgcn_mfma_f32_32x32x16_bf16((a), (b), (c), 0, 0, 0)
__device__ __forceinline__ bf16x8 pack8(const f32x16& x, int s) {
    u32x4 p; p.x = cvt_pk_bf16(x[8 * s], x[8 * s + 1]); p.y = cvt_pk_bf16(x[8 * s + 2], x[8 * s + 3]); p.z = cvt_pk_bf16(x[8 * s + 4], x[8 * s + 5]); p.w = cvt_pk_bf16(x[8 * s + 6], x[8 * s + 7]);
    return __builtin_bit_cast(bf16x8, p);
}
__device__ __forceinline__ f32x16 zero16() { f32x16 z;
#pragma unroll
    for (int i = 0; i < 16; ++i) z[i] = 0.f; return z; }

namespace pg8 {
constexpr int BM = 256, BK = 64, HALF = 128, HTB = HALF * BK * 2, STAGE_BYTES = 8 * HTB, NXCD = 8, WGM = 4;
__device__ __forceinline__ int lds_byte(int r, int c) { const int st = (r >> 4) * 2 + (c >> 5), rr = r & 15, cc = c & 31, ob = rr * 64 + cc * 2; return st * 1024 + (ob ^ (((ob >> 9) & 1) << 5)); }
__device__ __forceinline__ void stage_rc(int b, int& R, int& C) { const int st = b / 1024, sb = b % 1024, swz = sb ^ (((sb >> 9) & 1) << 5); R = (st >> 1) * 16 + swz / 64; C = (st & 1) * 32 + (swz % 64) / 2; }
__device__ __forceinline__ int perm32(int rho) { const int n = rho >> 4, i = rho & 15; return 8 * (i >> 2) + 4 * n + (i & 3); }

struct Unit { const char* a; const char* b; int pm, pn, kind; };

__device__ __forceinline__ bool tile_of(int i, int G, int c, int nM, int nN, int& pm, int& pn) {
    const int nwg = nM * nN; const long L = (long)i * G + c; if (L >= nwg) return false;
    int wgid = (int)L; { const int q = nwg / NXCD, r = nwg % NXCD, xcd = wgid % NXCD, off = wgid / NXCD; wgid = (xcd < r ? xcd * (q + 1) : r * (q + 1) + (xcd - r) * q) + off; }
    const int nig = WGM * nN, gid = wgid / nig, fm = gid * WGM, gsz = (nM - fm) < WGM ? (nM - fm) : WGM;
    pm = fm + ((wgid % nig) % gsz); pn = (wgid % nig) / gsz; return true;
}
constexpr size_t TSTEP = (size_t)256 * 2048 * 2;
struct Sched1 {
    const char* X; const char* W; int G, c;
    __device__ __forceinline__ bool next(int i, Unit& u) const {
        int pm, pn;
        if (G == 256) {
            if (i >= 8) return false;
            const int x = c & 7, k = c >> 3, j = i;
            if (i == 7) { if (c >= 128) return false; pm = 8 * x + (k & 7); pn = 28 + (k >> 3); }
            else if (j < 4) { pm = 16 * j + 4 * (x & 3) + (k & 3); pn = 8 * (x >> 2) + (k >> 2); }
            else if (j < 6) { pm = 32 * (j - 4) + 8 * (x & 3) + (k & 7); pn = 16 + 4 * (x >> 2) + (k >> 3); }
            else { pm = 8 * x + (k & 7); pn = 24 + (k >> 3); }
            if (pn >= 25) pn += 2;
        } else if (!tile_of(i, G, c, 64, 32, pm, pn)) return false;
        u.pm = pm; u.pn = pn;
        if (pn < 24) { u.kind = 0; u.a = X + (size_t)pm * TSTEP; u.b = W + (size_t)pn * TSTEP; }
        else { u.kind = 1; u.a = W + (size_t)pn * TSTEP; u.b = X + (size_t)pm * TSTEP; }
        return true;
    }
};
struct Sched2 {
    const char* Y; const char* W; int G, c;
    __device__ __forceinline__ bool next(int i, Unit& u) const {
        int pm, pn; if (!tile_of(i, G, c, 64, 8, pm, pn)) return false;
        u.pm = pm; u.pn = pn; u.kind = 2; u.a = Y + (size_t)pm * TSTEP; u.b = W + (size_t)pn * TSTEP; return true;
    }
};

struct Epi1 {
    static constexpr bool PERM = true;
    bf16* Unat; bf16* Ut; const float* bias;
    __device__ __forceinline__ void operator()(const f32x4 (&acc)[2][2][4][2], const Unit& u, int wr, int wc, int fr, int fq) const {
        if (u.kind == 0) {
            const int row0 = u.pm * BM + wr * 64 + fr, col0 = u.pn * BM + wc * 32 + 8 * fq;
            f32x4 bv[2][2];
#pragma unroll
            for (int bj = 0; bj < 2; ++bj)
#pragma unroll
                for (int n = 0; n < 2; ++n) bv[bj][n] = *(const f32x4*)(bias + col0 + bj * HALF + 4 * n);
#pragma unroll
            for (int ai = 0; ai < 2; ++ai)
#pragma unroll
                for (int m = 0; m < 4; ++m) { bf16* rowp = Unat + (size_t)(row0 + ai * HALF + m * 16) * LDN + col0;
#pragma unroll
                    for (int bj = 0; bj < 2; ++bj) { const f32x4 v0 = acc[ai][bj][m][0] + bv[bj][0], v1 = acc[ai][bj][m][1] + bv[bj][1];
                        u32x4 w; w.x = cvt_pk_bf16(v0[0], v0[1]); w.y = cvt_pk_bf16(v0[2], v0[3]); w.z = cvt_pk_bf16(v1[0], v1[1]); w.w = cvt_pk_bf16(v1[2], v1[3]);
                        *(u32x4*)(rowp + bj * HALF) = w; } }
        } else {
            const int nrow0 = (u.pn - 24) * BM + wr * 64 + fr, tok0 = u.pm * BM + wc * 32 + 8 * fq;
#pragma unroll
            for (int ai = 0; ai < 2; ++ai)
#pragma unroll
                for (int m = 0; m < 4; ++m) { const int nr = nrow0 + ai * HALF + m * 16; const float bs = bias[6144 + nr]; bf16* rowp = Ut + (size_t)nr * M + tok0;
#pragma unroll
                    for (int bj = 0; bj < 2; ++bj) { const f32x4 v0 = acc[ai][bj][m][0] + bs, v1 = acc[ai][bj][m][1] + bs;
                        u32x4 w; w.x = cvt_pk_bf16(v0[0], v0[1]); w.y = cvt_pk_bf16(v0[2], v0[3]); w.z = cvt_pk_bf16(v1[0], v1[1]); w.w = cvt_pk_bf16(v1[2], v1[3]);
                        *(u32x4*)(rowp + bj * HALF) = w; } }
        }
    }
};
template <int L> struct Epi2 {
    static constexpr bool PERM = true;
    float* Tf; bf16* Tb; const float* bias; const float* srcf; const bf16* srcb; const float* stat; const float* gam; const float* bet; bf16* Tb_hi;
    __device__ __forceinline__ void operator()(const f32x4 (&acc)[2][2][4][2], const Unit& u, int wr, int wc, int fr, int fq) const {
        const int row0 = u.pm * BM + wr * 64 + fr, col0 = u.pn * BM + wc * 32 + 8 * fq;
        bf16* const Tbu = (Tb_hi && u.pm >= 32) ? Tb_hi - (size_t)8192 * DM : Tb;
        float mean[2][4], rs[2][4];
#pragma unroll
        for (int ai = 0; ai < 2; ++ai)
#pragma unroll
            for (int m = 0; m < 4; ++m) { mean[ai][m] = 0.f; rs[ai][m] = 0.f; }
#pragma unroll
        for (int bj = 0; bj < 2; ++bj) { const int c = col0 + bj * HALF;
            f32x4 g0 = {0.f, 0.f, 0.f, 0.f}, g1 = g0, b0 = *(const f32x4*)(bias + c), b1 = *(const f32x4*)(bias + c + 4);
#pragma unroll
            for (int ai = 0; ai < 2; ++ai)
#pragma unroll
                for (int m = 0; m < 4; ++m) { const size_t off = (size_t)(row0 + ai * HALF + m * 16) * DM + c;
                    f32x4 t0, t1;
                    if (L == 0) { const u32x4 hv = *(const u32x4*)(srcb + off);
                        const f32x4 o0 = {bflo(hv.x), bfhi(hv.x), bflo(hv.y), bfhi(hv.y)}, o1 = {bflo(hv.z), bfhi(hv.z), bflo(hv.w), bfhi(hv.w)};
                        t0 = o0 * ALPHA + b0 + acc[ai][bj][m][0]; t1 = o1 * ALPHA + b1 + acc[ai][bj][m][1]; }
                    else { t0 = acc[ai][bj][m][0] + b0; t1 = acc[ai][bj][m][1] + b1; }
                    u32x4 w; w.x = cvt_pk_bf16(t0[0], t0[1]); w.y = cvt_pk_bf16(t0[2], t0[3]); w.z = cvt_pk_bf16(t1[0], t1[1]); w.w = cvt_pk_bf16(t1[2], t1[3]); *(u32x4*)(Tbu + off) = w; } }
    }
};

template <class Epi, class Sched, bool ALIGN_EPI, bool SP2>
__device__ __forceinline__ void gemm_phase(LAS unsigned char* lds, const Sched& S, const Epi& E, const int tid) {
    const int wid = __builtin_amdgcn_readfirstlane(tid >> 6), lane = tid & 63, wr = wid >> 2, wc = wid & 3, fr = lane & 15, fq = lane >> 4;
    constexpr int K = 2048, nt = K / BK;
    unsigned voffA[2], voffB[2];
#pragma unroll
    for (int i = 0; i < 2; ++i) { int R, C; stage_rc(tid * 16 + i * 8192, R, C); const int Rb = Epi::PERM ? ((R & ~31) + perm32(R & 31)) : R;
        voffA[i] = (unsigned)(R * K + C) * 2u; voffB[i] = (unsigned)(Rb * K + C) * 2u; }
    const size_t kstep = (size_t)(BK * 2);
    const size_t hstep = (size_t)HALF * K * 2;
    const unsigned ldsw = (unsigned)wid * 1024u;
    const int aoff = lds_byte(wr * 64 + fr, fq * 8), boff = lds_byte(wc * 32 + fr, fq * 8);
#define PG8_SA(b, h) (((b) * 2 + (h)) * HTB)
#define PG8_SB(b, h) ((4 + (b) * 2 + (h)) * HTB)
#define PG8_STAGE(bufoff, gbase, voff) do { _Pragma("unroll") for (int _i = 0; _i < 2; ++_i) \
        __builtin_amdgcn_global_load_lds((const unsigned*)((const char*)(gbase) + (voff)[_i]), (LAS unsigned*)(lds + (bufoff) + ldsw + _i * 8192), 16, 0, 0); } while (0)
#define PG8_LDA(dst, b, h) do { _Pragma("unroll") for (int m = 0; m < 4; ++m) _Pragma("unroll") for (int k = 0; k < 2; ++k) dst[m][k] = *(const LAS bf16x8*)(lds + PG8_SA(b, h) + aoff + m * 2048 + k * 1024); } while (0)
#define PG8_LDB(dst, b, h) do { _Pragma("unroll") for (int n = 0; n < 2; ++n) _Pragma("unroll") for (int k = 0; k < 2; ++k) dst[n][k] = *(const LAS bf16x8*)(lds + PG8_SB(b, h) + boff + n * 2048 + k * 1024); } while (0)
#define PG8_MMA(ai, bj, At, Bt) do { __builtin_amdgcn_s_setprio(1); _Pragma("unroll") for (int m = 0; m < 4; ++m) _Pragma("unroll") for (int n = 0; n < 2; ++n) _Pragma("unroll") for (int k = 0; k < 2; ++k) \
        acc[ai][bj][m][n] = __builtin_amdgcn_mfma_f32_16x16x32_bf16(Bt[n][k], At[m][k], acc[ai][bj][m][n], 0, 0, 0); __builtin_amdgcn_s_setprio(0); } while (0)
#define PG8_WAIT_V(n) asm volatile("s_waitcnt vmcnt(" #n ")" ::: "memory")
#define PG8_WAIT_L(n) asm volatile("s_waitcnt lgkmcnt(" #n ")" ::: "memory")
#define PG8_BAR __builtin_amdgcn_s_barrier()
#define PG8_SCHED __builtin_amdgcn_sched_barrier(0)
    Unit cur, nxt; int ui = 0;
    if (!S.next(0, cur)) return;
    f32x4 acc[2][2][4][2];
#pragma unroll
    for (int a = 0; a < 2; ++a)
#pragma unroll
        for (int b = 0; b < 2; ++b)
#pragma unroll
            for (int m = 0; m < 4; ++m)
#pragma unroll
                for (int n = 0; n < 2; ++n) acc[a][b][m][n] = (f32x4){0.f, 0.f, 0.f, 0.f};
    bf16x8 At[4][2], B0[2][2], B1[2][2];
    const char* cA = cur.a; const char* cB = cur.b;
    if constexpr (SP2) {
        PG8_STAGE(PG8_SB(0, 0), cB, voffB); PG8_STAGE(PG8_SB(0, 1), cB + hstep, voffB); PG8_STAGE(PG8_SA(0, 0), cA, voffA); PG8_STAGE(PG8_SA(0, 1), cA + hstep, voffA);
        if (wr == 1) PG8_BAR;
        PG8_WAIT_V(2); PG8_BAR;
        PG8_STAGE(PG8_SB(1, 0), cB + kstep, voffB); PG8_STAGE(PG8_SA(1, 0), cA + kstep, voffA); PG8_STAGE(PG8_SB(1, 1), cB + hstep + kstep, voffB);
        PG8_WAIT_V(6); PG8_BAR;
    } else {
        PG8_STAGE(PG8_SB(0, 0), cB, voffB); PG8_STAGE(PG8_SA(0, 0), cA, voffA); PG8_STAGE(PG8_SB(0, 1), cB + hstep, voffB); PG8_STAGE(PG8_SA(0, 1), cA + hstep, voffA);
        if (wr == 1) PG8_BAR;
        PG8_WAIT_V(4); PG8_BAR;
        PG8_STAGE(PG8_SB(1, 0), cB + kstep, voffB); PG8_STAGE(PG8_SA(1, 0), cA + kstep, voffA); PG8_STAGE(PG8_SB(1, 1), cB + hstep + kstep, voffB);
        PG8_WAIT_V(6); PG8_BAR;
    }
    for (;;) {
        const bool has_next = S.next(ui + 1, nxt);
        const char* nA = has_next ? nxt.a : cA; const char* nB = has_next ? nxt.b : cB;
        for (int t = 0; t < nt; t += 2) {
            const bool last = (t == nt - 2);
            const char* a1 = cA + (size_t)(t + 1) * kstep;
            const char* a2 = last ? nA : cA + (size_t)(t + 2) * kstep; const char* b2 = last ? nB : cB + (size_t)(t + 2) * kstep;
            const char* a3 = a2 + kstep; const char* b3 = b2 + kstep;
            if constexpr (SP2) {
            PG8_LDB(B0, 0, 0); PG8_LDB(B1, 0, 1); PG8_SCHED; PG8_LDA(At, 0, 0); PG8_STAGE(PG8_SA(1, 1), a1 + hstep, voffA);
            PG8_WAIT_V(8); PG8_WAIT_L(0); PG8_BAR; PG8_MMA(0, 0, At, B0); PG8_MMA(0, 1, At, B1); PG8_BAR; PG8_SCHED;
            PG8_LDA(At, 0, 1); PG8_STAGE(PG8_SB(0, 0), b2, voffB); PG8_STAGE(PG8_SB(0, 1), b2 + hstep, voffB); PG8_STAGE(PG8_SA(0, 0), a2, voffA);
            PG8_WAIT_V(8); PG8_WAIT_L(0); PG8_BAR; PG8_MMA(1, 0, At, B0); PG8_MMA(1, 1, At, B1); PG8_BAR; PG8_SCHED;
            PG8_LDB(B0, 1, 0); PG8_LDB(B1, 1, 1); PG8_SCHED; PG8_LDA(At, 1, 0); PG8_STAGE(PG8_SA(0, 1), a2 + hstep, voffA);
            PG8_WAIT_V(8); PG8_WAIT_L(0); PG8_BAR; PG8_MMA(0, 0, At, B0); PG8_MMA(0, 1, At, B1); PG8_BAR; PG8_SCHED;
            PG8_LDA(At, 1, 1); PG8_STAGE(PG8_SB(1, 0), b3, voffB); PG8_STAGE(PG8_SB(1, 1), b3 + hstep, voffB); PG8_STAGE(PG8_SA(1, 0), a3, voffA);
            PG8_WAIT_V(8); PG8_WAIT_L(0); PG8_BAR; PG8_MMA(1, 0, At, B0); PG8_MMA(1, 1, At, B1); PG8_BAR; PG8_SCHED;
            } else {
            PG8_LDB(B0, 0, 0); PG8_SCHED; PG8_LDA(At, 0, 0); PG8_STAGE(PG8_SA(1, 1), a1 + hstep, voffA);
            PG8_WAIT_L(8); PG8_BAR; PG8_WAIT_L(0); PG8_MMA(0, 0, At, B0); PG8_BAR; PG8_SCHED;
            PG8_LDB(B1, 0, 1); PG8_STAGE(PG8_SB(0, 0), b2, voffB);
            PG8_BAR; PG8_WAIT_L(0); PG8_MMA(0, 1, At, B1); PG8_BAR;
            PG8_LDA(At, 0, 1); PG8_STAGE(PG8_SA(0, 0), a2, voffA);
            PG8_BAR; PG8_WAIT_L(0); PG8_MMA(1, 0, At, B0); PG8_BAR; PG8_SCHED;
            PG8_STAGE(PG8_SB(0, 1), b2 + hstep, voffB);
            PG8_WAIT_V(6); PG8_BAR; PG8_MMA(1, 1, At, B1); PG8_BAR;
            PG8_LDB(B0, 1, 0); PG8_SCHED; PG8_LDA(At, 1, 0); PG8_STAGE(PG8_SA(0, 1), a2 + hstep, voffA);
            PG8_WAIT_L(8); PG8_BAR; PG8_WAIT_L(0); PG8_MMA(0, 0, At, B0); PG8_BAR; PG8_SCHED;
            PG8_LDB(B1, 1, 1); PG8_STAGE(PG8_SB(1, 0), b3, voffB);
            PG8_BAR; PG8_WAIT_L(0); PG8_MMA(0, 1, At, B1); PG8_BAR;
            PG8_LDA(At, 1, 1); PG8_STAGE(PG8_SA(1, 0), a3, voffA);
            PG8_BAR; PG8_WAIT_L(0); PG8_MMA(1, 0, At, B0); PG8_BAR; PG8_SCHED;
            PG8_STAGE(PG8_SB(1, 1), b3 + hstep, voffB);
            PG8_WAIT_V(6); PG8_BAR; PG8_MMA(1, 1, At, B1); PG8_BAR;
            }
        }
        if constexpr (ALIGN_EPI) { if (wr == 0) PG8_BAR; }
        int fr_ = fr, fq_ = fq; asm volatile("" : "+v"(fr_), "+v"(fq_));
        E(acc, cur, wr, wc, fr_, fq_);
        if (!has_next) break;
#pragma unroll
        for (int a = 0; a < 2; ++a)
#pragma unroll
            for (int b = 0; b < 2; ++b)
#pragma unroll
                for (int m = 0; m < 4; ++m)
#pragma unroll
                    for (int n = 0; n < 2; ++n) acc[a][b][m][n] = (f32x4){0.f, 0.f, 0.f, 0.f};
        cur = nxt; cA = nA; cB = nB; ++ui;
        if constexpr (ALIGN_EPI) { if (wr == 1) PG8_BAR; }
    }
    PG8_WAIT_V(0);
    if constexpr (!ALIGN_EPI) { if (wr == 0) PG8_BAR; }
    PG8_BAR;
#undef PG8_SA
#undef PG8_SB
#undef PG8_STAGE
#undef PG8_LDA
#undef PG8_LDB
#undef PG8_MMA
#undef PG8_WAIT_V
#undef PG8_WAIT_L
#undef PG8_BAR
#undef PG8_SCHED
}
}

#define XB_TMO      128
#define XB_XCNT(j)  (256  + 64 * (j))
#define XB_XSUB(j)  (1280 + 64 * (j))
#define XB_XGEN(j)  (2304 + 64 * (j))
#define XB_TOP      3328
#define XB_TOPGEN   3392
#define XCD_BAR_WORDS 3456
#define XB_SPIN_CAP (1u << 22)
__device__ __forceinline__ unsigned xb_ld(unsigned* p)              { return __hip_atomic_load(p, __ATOMIC_RELAXED, __HIP_MEMORY_SCOPE_AGENT); }
__device__ __forceinline__ unsigned xb_add(unsigned* p, unsigned v) { return __hip_atomic_fetch_add(p, v, __ATOMIC_RELAXED, __HIP_MEMORY_SCOPE_AGENT); }
__device__ __forceinline__ unsigned xb_xcc_id() { return (unsigned)__builtin_amdgcn_s_getreg((3 << 11) | 20) & 0xFu; }
#define XB_SPIN(cond, bar) do { unsigned _sp = 0; while (cond) { __builtin_amdgcn_s_sleep(1); \
    if ((++_sp & 255u) == 0u) { if (xb_ld(&(bar)[XB_TMO])) break; if (_sp > XB_SPIN_CAP) { atomicAdd(&(bar)[XB_TMO], 1u); break; } } } } while (0)
struct XcdBarrier { unsigned* bar; unsigned x; volatile LAS unsigned* st; };
__device__ __forceinline__ XcdBarrier xcd_barrier_post(unsigned* bar, volatile LAS unsigned* st, int tid) {
    XcdBarrier b; b.bar = bar; b.x = xb_xcc_id(); b.st = st;
    if (tid == 0) (void)xb_add(&bar[XB_XCNT(b.x)], 1u);
    return b;
}
__device__ __forceinline__ void xcd_barrier_complete(unsigned* bar, unsigned x, unsigned& nloc, unsigned& nx) {
    const unsigned G = gridDim.x * gridDim.y * gridDim.z;
    unsigned sum, cnt, mine, sp = 0u;
    for (;;) {
        sum = 0u; cnt = 0u; mine = 0u;
#pragma unroll
        for (unsigned j = 0; j < 16; ++j) { const unsigned c = xb_ld(&bar[XB_XCNT(j)]); sum += c; cnt += (c > 0u) ? 1u : 0u; mine = (j == x) ? c : mine; }
        if (sum == G) break;
        __builtin_amdgcn_s_sleep(1);
        if ((++sp & 255u) == 0u) { if (xb_ld(&bar[XB_TMO])) break; if (sp > XB_SPIN_CAP) { atomicAdd(&bar[XB_TMO], 1u); break; } }
    }
    nloc = mine > 0u ? mine : 1u; nx = cnt > 0u ? cnt : 1u;
}
__device__ __forceinline__ void xcd_barrier(const XcdBarrier& b, int tid) {
    asm volatile("s_waitcnt vmcnt(0)" ::: "memory");
    __syncthreads();
    if (tid == 0) {
        unsigned* bar = b.bar; asm volatile("" : "+s"(bar));
        __builtin_amdgcn_s_waitcnt(0);
        unsigned nloc = b.st[0], nx = b.st[1];
        if (nloc == 0u) { xcd_barrier_complete(bar, b.x, nloc, nx); b.st[0] = nloc; b.st[1] = nx; }
        const unsigned old = xb_add(&bar[XB_XSUB(b.x)], 1u);
        const unsigned gen = old / nloc;
        if (old + 1u == (gen + 1u) * nloc) {
            __builtin_amdgcn_fence(__ATOMIC_RELEASE, "agent");
            asm volatile("s_waitcnt vmcnt(0)" ::: "memory");
            const unsigned og = xb_add(&bar[XB_TOP], 1u);
            const unsigned tg = og / nx;
            if (og + 1u == (tg + 1u) * nx) xb_add(&bar[XB_TOPGEN], 1u);
            else XB_SPIN(xb_ld(&bar[XB_TOPGEN]) == tg, bar);
            __builtin_amdgcn_fence(__ATOMIC_ACQUIRE, "agent");
            xb_add(&bar[XB_XGEN(b.x)], 1u);
            asm volatile("s_waitcnt vmcnt(0)" ::: "memory");
        } else {
            XB_SPIN(xb_ld(&bar[XB_XGEN(b.x)]) == gen, bar);
            __builtin_amdgcn_fence(__ATOMIC_ACQUIRE, "agent");
            asm volatile("s_waitcnt vmcnt(0)" ::: "memory");
        }
    }
    __syncthreads();
}

struct Args { const float* in[14]; float* out; unsigned char* ws; int ph_lo, ph_hi; };

struct Ctx {
    LAS unsigned char* lds; int tid, lane, wave, G, bid;
    const float *x, *emb_g, *emb_b, *w_in, *b_in, *w_out, *b_out, *ln_g, *ln_b, *t5, *sink, *fbias, *norm_g, *rpb;
    float* out; unsigned char* ws;
    bf16* hby; bf16* yb; bf16* unat; bf16* ut; bf16* cst; float* nst; float* gs; float* ml; float* mprev; float* gate; float* stat;
};

__device__ __forceinline__ int src_col_of_row(int r) {
    if (r < 768) return r;
    if (r < 1024) return r - 768 + 768;
    if (r < 1792) return r - 1024 + 1280;
    if (r < 2304) return r - 1792 + 2048;
    if (r < 2816) return r - 2304 + 2560;
    if (r < 3328) return r - 2816 + 3584;
    if (r < 3840) return r - 3328 + 4096;
    if (r < 4608) return r - 3840 + 4624;
    if (r < 5376) return r - 4608 + 5392;
    if (r < 6144) return r - 5376 + 6928;
    if (r < 6400) return r - 6144 + 1024;
    if (r < 6912) return r - 6400 + 2560;
    if (r < 7424) return r - 6912 + 3072;
    if (r < 8192) return r - 7424 + 6160;
    return r - 8192 + 4608;
}
__device__ __forceinline__ void ln_row(const float* xrow, float* orow, bf16* brow, float* stat, const float* g, const float* b, int lane) {
    f32x4 v[8]; float s = 0.f;
#pragma unroll
    for (int j = 0; j < 8; ++j) { v[j] = *(const f32x4*)(xrow + 4 * (lane + 64 * j)); s += (v[j][0] + v[j][1]) + (v[j][2] + v[j][3]); }
    const float mean = wave_sum(s, lane) * (1.f / DM); float q = 0.f;
#pragma unroll
    for (int j = 0; j < 8; ++j) { v[j] = v[j] - mean; q += (v[j][0] * v[j][0] + v[j][1] * v[j][1]) + (v[j][2] * v[j][2] + v[j][3] * v[j][3]); }
    const float rstd = 1.f / sqrtf(wave_sum(q, lane) * (1.f / DM) + LN_EPS);
    if (stat && lane == 0) { stat[0] = mean; stat[1] = rstd; }
#pragma unroll
    for (int j = 0; j < 8; ++j) { const int c = 4 * (lane + 64 * j); const f32x4 gg = *(const f32x4*)(g + c), bb = *(const f32x4*)(b + c);
        const f32x4 o = v[j] * rstd * gg + bb;
        if (orow) *(f32x4*)(orow + c) = o;
        if (brow) { u32x2 w; w.x = cvt_pk_bf16(o[0], o[1]); w.y = cvt_pk_bf16(o[2], o[3]); *(u32x2*)(brow + c) = w; } }
}

__device__ __forceinline__ void ln_row2(const float* x0, const float* x1, float* o0, float* o1, bf16* b0, bf16* b1, float* st0, float* st1, const float* g, const float* b, int lane) {
    f32x4 v[8], u[8]; float s = 0.f, s_ = 0.f;
#pragma unroll
    for (int j = 0; j < 8; ++j) { v[j] = *(const f32x4*)(x0 + 4 * (lane + 64 * j)); u[j] = *(const f32x4*)(x1 + 4 * (lane + 64 * j)); }
#pragma unroll
    for (int j = 0; j < 8; ++j) { s += (v[j][0] + v[j][1]) + (v[j][2] + v[j][3]); s_ += (u[j][0] + u[j][1]) + (u[j][2] + u[j][3]); }
#pragma unroll
    for (int o = 1; o < 64; o <<= 1) { s += shx(s, o, lane); s_ += shx(s_, o, lane); }
    const float mean = s * (1.f / DM), mean_ = s_ * (1.f / DM); float q = 0.f, q_ = 0.f;
#pragma unroll
    for (int j = 0; j < 8; ++j) { v[j] = v[j] - mean; u[j] = u[j] - mean_; q += (v[j][0] * v[j][0] + v[j][1] * v[j][1]) + (v[j][2] * v[j][2] + v[j][3] * v[j][3]); q_ += (u[j][0] * u[j][0] + u[j][1] * u[j][1]) + (u[j][2] * u[j][2] + u[j][3] * u[j][3]); }
#pragma unroll
    for (int o = 1; o < 64; o <<= 1) { q += shx(q, o, lane); q_ += shx(q_, o, lane); }
    const float rstd = 1.f / sqrtf(q * (1.f / DM) + LN_EPS), rstd_ = 1.f / sqrtf(q_ * (1.f / DM) + LN_EPS);
    if (st0 && lane == 0) { st0[0] = mean; st0[1] = rstd; st1[0] = mean_; st1[1] = rstd_; }
#pragma unroll
    for (int j = 0; j < 8; ++j) { const int c = 4 * (lane + 64 * j); const f32x4 gg = *(const f32x4*)(g + c), bb = *(const f32x4*)(b + c);
        const f32x4 o = v[j] * rstd * gg + bb, p = u[j] * rstd_ * gg + bb;
        if (o0) { *(f32x4*)(o0 + c) = o; *(f32x4*)(o1 + c) = p; }
        if (b0) { u32x2 w; w.x = cvt_pk_bf16(o[0], o[1]); w.y = cvt_pk_bf16(o[2], o[3]); *(u32x2*)(b0 + c) = w; u32x2 w2; w2.x = cvt_pk_bf16(p[0], p[1]); w2.y = cvt_pk_bf16(p[2], p[3]); *(u32x2*)(b1 + c) = w2; } }
}

__device__ __forceinline__ void ln_row2_b(const bf16* x0, const bf16* x1, bf16* b0, bf16* b1, float* st0, float* st1, const float* g, const float* b, int lane) {
    f32x4 v[8], u[8]; float s = 0.f, s_ = 0.f;
#pragma unroll
    for (int j = 0; j < 4; ++j) { const u32x4 p = *(const u32x4*)(x0 + 8 * (lane + 64 * j)), q = *(const u32x4*)(x1 + 8 * (lane + 64 * j));
        v[2 * j] = (f32x4){bflo(p.x), bfhi(p.x), bflo(p.y), bfhi(p.y)}; v[2 * j + 1] = (f32x4){bflo(p.z), bfhi(p.z), bflo(p.w), bfhi(p.w)};
        u[2 * j] = (f32x4){bflo(q.x), bfhi(q.x), bflo(q.y), bfhi(q.y)}; u[2 * j + 1] = (f32x4){bflo(q.z), bfhi(q.z), bflo(q.w), bfhi(q.w)}; }
#pragma unroll
    for (int j = 0; j < 8; ++j) { s += (v[j][0] + v[j][1]) + (v[j][2] + v[j][3]); s_ += (u[j][0] + u[j][1]) + (u[j][2] + u[j][3]); }
#pragma unroll
    for (int o = 1; o < 64; o <<= 1) { s += shx(s, o, lane); s_ += shx(s_, o, lane); }
    const float mean = s * (1.f / DM), mean_ = s_ * (1.f / DM); float q = 0.f, q_ = 0.f;
#pragma unroll
    for (int j = 0; j < 8; ++j) { v[j] = v[j] - mean; u[j] = u[j] - mean_; q += (v[j][0] * v[j][0] + v[j][1] * v[j][1]) + (v[j][2] * v[j][2] + v[j][3] * v[j][3]); q_ += (u[j][0] * u[j][0] + u[j][1] * u[j][1]) + (u[j][2] * u[j][2] + u[j][3] * u[j][3]); }
#pragma unroll
    for (int o = 1; o < 64; o <<= 1) { q += shx(q, o, lane); q_ += shx(q_, o, lane); }
    const float rstd = 1.f / sqrtf(q * (1.f / DM) + LN_EPS), rstd_ = 1.f / sqrtf(q_ * (1.f / DM) + LN_EPS);
    if (lane == 0) { st0[0] = mean; st0[1] = rstd; st1[0] = mean_; st1[1] = rstd_; }
#pragma unroll
    for (int j = 0; j < 4; ++j) { const int c = 8 * (lane + 64 * j);
        const f32x4 g0 = *(const f32x4*)(g + c), g1 = *(const f32x4*)(g + c + 4), bb0 = *(const f32x4*)(b + c), bb1 = *(const f32x4*)(b + c + 4);
        const f32x4 o0 = v[2 * j] * rstd * g0 + bb0, o1 = v[2 * j + 1] * rstd * g1 + bb1, p0 = u[2 * j] * rstd_ * g0 + bb0, p1 = u[2 * j + 1] * rstd_ * g1 + bb1;
        u32x4 w; w.x = cvt_pk_bf16(o0[0], o0[1]); w.y = cvt_pk_bf16(o0[2], o0[3]); w.z = cvt_pk_bf16(o1[0], o1[1]); w.w = cvt_pk_bf16(o1[2], o1[3]); *(u32x4*)(b0 + c) = w;
        u32x4 w2; w2.x = cvt_pk_bf16(p0[0], p0[1]); w2.y = cvt_pk_bf16(p0[2], p0[3]); w2.z = cvt_pk_bf16(p1[0], p1[1]); w2.w = cvt_pk_bf16(p1[2], p1[3]); *(u32x4*)(b1 + c) = w2; }
}

__device__ __forceinline__ void fin_row2(const bf16* t1, const bf16* o2, const float* st, const float* g0, const float* b0, const float* g1, const float* b1, float* out, int lane) {
    f32x4 v[8], u[8]; float s = 0.f, s_ = 0.f;
    const float mA = st[0], rA = st[1] * ALPHA, mB = st[2], rB = st[3] * ALPHA;
#pragma unroll
    for (int j = 0; j < 4; ++j) { const int c = 8 * (lane + 64 * j);
        const u32x4 p = *(const u32x4*)(t1 + c), q = *(const u32x4*)(t1 + DM + c), x = *(const u32x4*)(o2 + c), y = *(const u32x4*)(o2 + DM + c);
        const f32x4 ga = *(const f32x4*)(g0 + c), gb = *(const f32x4*)(g0 + c + 4), ba = *(const f32x4*)(b0 + c) * ALPHA, bb = *(const f32x4*)(b0 + c + 4) * ALPHA;
        v[2 * j] = ((f32x4){bflo(p.x), bfhi(p.x), bflo(p.y), bfhi(p.y)} - mA) * rA * ga + ba + (f32x4){bflo(x.x), bfhi(x.x), bflo(x.y), bfhi(x.y)};
        v[2 * j + 1] = ((f32x4){bflo(p.z), bfhi(p.z), bflo(p.w), bfhi(p.w)} - mA) * rA * gb + bb + (f32x4){bflo(x.z), bfhi(x.z), bflo(x.w), bfhi(x.w)};
        u[2 * j] = ((f32x4){bflo(q.x), bfhi(q.x), bflo(q.y), bfhi(q.y)} - mB) * rB * ga + ba + (f32x4){bflo(y.x), bfhi(y.x), bflo(y.y), bfhi(y.y)};
        u[2 * j + 1] = ((f32x4){bflo(q.z), bfhi(q.z), bflo(q.w), bfhi(q.w)} - mB) * rB * gb + bb + (f32x4){bflo(y.z), bfhi(y.z), bflo(y.w), bfhi(y.w)}; }
#pragma unroll
    for (int j = 0; j < 8; ++j) { s += (v[j][0] + v[j][1]) + (v[j][2] + v[j][3]); s_ += (u[j][0] + u[j][1]) + (u[j][2] + u[j][3]); }
#pragma unroll
    for (int o = 1; o < 64; o <<= 1) { s += shx(s, o, lane); s_ += shx(s_, o, lane); }
    const float mean = s * (1.f / DM), mean_ = s_ * (1.f / DM); float q2 = 0.f, q2_ = 0.f;
#pragma unroll
    for (int j = 0; j < 8; ++j) { v[j] = v[j] - mean; u[j] = u[j] - mean_; q2 += (v[j][0] * v[j][0] + v[j][1] * v[j][1]) + (v[j][2] * v[j][2] + v[j][3] * v[j][3]); q2_ += (u[j][0] * u[j][0] + u[j][1] * u[j][1]) + (u[j][2] * u[j][2] + u[j][3] * u[j][3]); }
#pragma unroll
    for (int o = 1; o < 64; o <<= 1) { q2 += shx(q2, o, lane); q2_ += shx(q2_, o, lane); }
    const float rstd = 1.f / sqrtf(q2 * (1.f / DM) + LN_EPS), rstd_ = 1.f / sqrtf(q2_ * (1.f / DM) + LN_EPS);
#pragma unroll
    for (int j = 0; j < 4; ++j) { const int c = 8 * (lane + 64 * j);
        const f32x4 ga = *(const f32x4*)(g1 + c), gb = *(const f32x4*)(g1 + c + 4), ba = *(const f32x4*)(b1 + c), bb = *(const f32x4*)(b1 + c + 4);
        *(f32x4*)(out + c) = v[2 * j] * rstd * ga + ba; *(f32x4*)(out + c + 4) = v[2 * j + 1] * rstd * gb + bb;
        *(f32x4*)(out + DM + c) = u[2 * j] * rstd_ * ga + ba; *(f32x4*)(out + DM + c + 4) = u[2 * j + 1] * rstd_ * gb + bb; }
}

__device__ __forceinline__ bf16* t1_row(unsigned char* ws, int m) { return m < 8192 ? (bf16*)(ws + WS_WIN) + (size_t)m * DM : (bf16*)(ws + WS_T1B) + (size_t)(m - 8192) * DM; }
struct TrItem { const float* src; bf16* dst; int ldw, nvalid; };
__device__ __forceinline__ void tr_load(const TrItem& t, float (&wv)[32], int lane) {
#pragma unroll
    for (int i = 0; i < 8; ++i) { const int kk = 8 * i + (lane >> 3); const f32x4 v = *(const f32x4*)(t.src + (size_t)kk * t.ldw + 4 * (lane & 7));
        wv[4 * i] = v[0]; wv[4 * i + 1] = v[1]; wv[4 * i + 2] = v[2]; wv[4 * i + 3] = v[3]; }
}
__device__ __forceinline__ void tr_store(const TrItem& t, const float (&wv)[32], LAS float* scr, int lane) {
#pragma unroll
    for (int i = 0; i < 8; ++i) { const int kk = 8 * i + (lane >> 3); LAS float* d = scr + kk * 33 + 4 * (lane & 7); d[0] = wv[4 * i]; d[1] = wv[4 * i + 1]; d[2] = wv[4 * i + 2]; d[3] = wv[4 * i + 3]; }
    LDS_WAIT();
    const int c = lane & 7;
#pragma unroll
    for (int j = 0; j < 4; ++j) { const int n = (lane >> 3) + 8 * j; const LAS float* sp = scr + (8 * c) * 33 + n;
        u32x4 o; o.x = cvt_pk_bf16(sp[0 * 33], sp[1 * 33]); o.y = cvt_pk_bf16(sp[2 * 33], sp[3 * 33]); o.z = cvt_pk_bf16(sp[4 * 33], sp[5 * 33]); o.w = cvt_pk_bf16(sp[6 * 33], sp[7 * 33]);
        if (n < t.nvalid) *(u32x4*)(t.dst + (size_t)n * 2048 + 8 * c) = o; }
    LDS_WAIT();
}
__device__ __forceinline__ bool tr_item(const Ctx& F, int l, int it, TrItem& t) {
    constexpr int I_IN = 241 * 32, I_OUT = 64 * 32;
    if (it >= I_IN + I_OUT) return false;
    if (it < I_IN) { int rb = it >> 5; const int kb = it & 31; rb = rb < 200 ? rb : rb + 16;
        t.ldw = IN_W; t.nvalid = rb == 256 ? 16 : 32; t.src = F.w_in + (size_t)l * DM * IN_W + (size_t)(kb * 64) * IN_W + src_col_of_row(rb * 32);
        t.dst = (bf16*)(F.ws + WS_WIN + l * WIN_STRIDE) + (size_t)rb * 32 * 2048 + kb * 64; }
    else { const int r = it - I_IN, rb = r >> 5, kb = r & 31;
        t.ldw = DM; t.nvalid = 32; t.src = F.w_out + (size_t)l * DM * DM + (size_t)(kb * 64) * DM + rb * 32;
        t.dst = (bf16*)(F.ws + WS_WOUT + l * WOUT_STRIDE) + (size_t)rb * 32 * 2048 + kb * 64; }
    return true;
}
__device__ __forceinline__ void weights_job(Ctx& F, int l, int gw, int ngw) {
    LAS float* scr = (LAS float*)(F.lds + F.wave * 16384);
    TrItem ta, tb; float wa[32], wb[32];
    int it = gw; bool ha = tr_item(F, l, it, ta), hb;
    if (ha) tr_load(ta, wa, F.lane);
    while (ha) {
        it += ngw; hb = tr_item(F, l, it, tb); if (hb) tr_load(tb, wb, F.lane);
        tr_store(ta, wa, scr, F.lane);
        if (!hb) break;
        it += ngw; ha = tr_item(F, l, it, ta); if (ha) tr_load(ta, wa, F.lane);
        tr_store(tb, wb, scr, F.lane);
    }
}
__device__ __forceinline__ void helper_of(const Ctx& F, int l, bool& is_h, int& hid, int& nh) { (void)l; if (F.G == 256) { is_h = F.bid >= 128; hid = F.bid - 128; nh = 128; } else { is_h = true; hid = F.bid; nh = F.G; } }
__device__ __forceinline__ void phase_prologue(Ctx& F) {
    const int gw = F.bid * NWAVES + F.wave, NGW = F.G * NWAVES;
    weights_job(F, 0, gw, NGW);
    for (int i = F.bid * NTHR + F.tid; i < 2 * WROWS; i += F.G * NTHR) { const int l = i / WROWS, r = i % WROWS; ((float*)(F.ws + WS_BIAS))[i] = F.b_in[l * IN_W + src_col_of_row(r)]; }
    for (int m = 2 * gw; m < M; m += 2 * NGW) ln_row2(F.x + (size_t)m * DM, F.x + (size_t)(m + 1) * DM, (float*)nullptr, (float*)nullptr, F.hby + (size_t)m * DM, F.hby + (size_t)(m + 1) * DM, F.stat + (size_t)m * 2, F.stat + (size_t)(m + 1) * 2, F.emb_g, F.emb_b, F.lane);
}

__device__ __forceinline__ void gates_job(Ctx& F, int l) {
    const bf16* Wg = (const bf16*)(F.ws + WS_WIN + l * WIN_STRIDE) + (size_t)8192 * 2048;
    const float* bg = (const float*)(F.ws + WS_BIAS) + l * WROWS + 8192;
    LAS f32x4* red = (LAS f32x4*)F.lds;
    const int w = F.wave, fr = F.lane & 15, fq = F.lane >> 4;
    bool is_h; int hid, nh; helper_of(F, l, is_h, hid, nh); if (!is_h) return;
    for (int rb = hid; rb < M / 64; rb += nh) {
        const bf16* bp = Wg + (size_t)fr * 2048 + w * 256 + 8 * fq;
        f32x4 acc[4];
#pragma unroll
        for (int tt = 0; tt < 4; ++tt) acc[tt] = (f32x4){0.f, 0.f, 0.f, 0.f};
        bf16x8 bfr[8], afr[4][8];
#pragma unroll
        for (int i = 0; i < 8; ++i) bfr[i] = *(const bf16x8*)(bp + 32 * i);
#pragma unroll
        for (int tt = 0; tt < 4; ++tt)
#pragma unroll
            for (int i = 0; i < 8; ++i) afr[tt][i] = *(const bf16x8*)(F.hby + (size_t)(rb * 64 + tt * 16 + fr) * DM + w * 256 + 8 * fq + 32 * i);
#pragma unroll
        for (int i = 0; i < 8; ++i)
#pragma unroll
            for (int tt = 0; tt < 4; ++tt) acc[tt] = __builtin_amdgcn_mfma_f32_16x16x32_bf16(afr[tt][i], bfr[i], acc[tt], 0, 0, 0);
#pragma unroll
        for (int tt = 0; tt < 4; ++tt) red[(w * 4 + tt) * 64 + F.lane] = acc[tt];
        __syncthreads();
        if (w < 4) { f32x4 o = red[w * 64 + F.lane];
#pragma unroll
            for (int ww = 1; ww < 8; ++ww) o = o + red[(ww * 4 + w) * 64 + F.lane];
            const float bb = bg[fr];
#pragma unroll
            for (int j = 0; j < 4; ++j) F.gate[(size_t)(rb * 64 + w * 16 + 4 * fq + j) * 16 + fr] = o[j] + bb; }
        __syncthreads();
    }
}

constexpr int WA_K = 0, WA_V = 65536, WA_VSTR = 1032, WA_TB = WA_V + 64 * WA_VSTR  , WA_TBS = 320, WA_END = WA_TB + 3 * WA_TBS * 4;
static_assert(WA_END <= MISC_OFF, "WA LDS map");
__device__ __forceinline__ void wattn_item(Ctx& F, int item, int l) {
    const int b = item >> 6, kvh = (item >> 4) & 3, p = item & 15;
    const int tokb = b * SEQ, kpos0 = 256 * p - 128;
    LAS unsigned char* lds = F.lds;
    {
        u32x4 kr[8], vr[8];
        const int kc0 = F.tid >> 3, c = F.tid & 7;
#pragma unroll
        for (int j = 0; j < 8; ++j) { const int kk = kc0 + 64 * j; int pos = kpos0 + kk; pos = pos < 0 ? 0 : (pos > SEQ - 1 ? SEQ - 1 : pos);
            kr[j] = *(const u32x4*)(F.unat + (size_t)(tokb + pos) * LDN + N_AK + kvh * 64 + c * 8); }
        const int d0 = F.tid >> 6, cc = F.tid & 63;
        int vpos = kpos0 + cc * 8; vpos = vpos < 0 ? 0 : (vpos > SEQ - 8 ? SEQ - 8 : vpos);
#pragma unroll
        for (int j = 0; j < 8; ++j) vr[j] = *(const u32x4*)(F.ut + (size_t)(T_AV + kvh * 64 + d0 + 8 * j) * M + tokb + vpos);
#pragma unroll
        for (int j = 0; j < 8; ++j) { const int kk = kc0 + 64 * j; *(LAS u32x4*)(lds + WA_K + kk * 128 + ((c ^ ((kk >> 1) & 7)) << 4)) = kr[j]; }
#pragma unroll
        for (int j = 0; j < 8; ++j) { LAS unsigned char* dst = lds + WA_V + (d0 + 8 * j) * WA_VSTR + cc * 16;
            *(LAS u32x2*)dst = (u32x2){vr[j].x, vr[j].y}; *(LAS u32x2*)(dst + 8) = (u32x2){vr[j].z, vr[j].w}; }
    }
    LAS float* tbw = (LAS float*)(lds + WA_TB);
    for (int i = F.tid; i < 3 * WA_TBS; i += NTHR) { const int g = i / WA_TBS, idx = i % WA_TBS - 31; tbw[i] = (idx >= 0 && idx <= 256) ? F.t5[t5_bucket(idx - 128) * 12 + kvh * 3 + g] * LOG2E : -INFINITY; }
    const int qt = F.wave, r = F.lane & 31, h = F.lane >> 5, ql = 32 * qt + r;
    const int tokq = tokb + 256 * p + ql;
    unsigned bad[16];
#pragma unroll
    for (int i = 0; i < 16; ++i) bad[i] = (unsigned)(WA_TB + (crow(i, h) - r + 31) * 4);
    bf16x8 qf[4];
#pragma unroll
    for (int s = 0; s < 4; ++s) qf[s] = *(const bf16x8*)(F.unat + (size_t)tokq * LDN + N_AQ + (kvh * 3) * 64 + 16 * s + 8 * h);
    __syncthreads();
    const int dlo = (p == 0) ? ((4 - qt) > 0 ? (4 - qt) : 0) : 0;
    const int dhi = (p == 15) ? ((12 - qt) < 9 ? (12 - qt) : 9) : 9;
#pragma unroll 1
    for (int g = 0; g < 3; ++g) {
        const int head = kvh * 3 + g;
        bf16x8 qn[4];
        if (g < 2) {
#pragma unroll
            for (int s = 0; s < 4; ++s) qn[s] = *(const bf16x8*)(F.unat + (size_t)tokq * LDN + N_AQ + (head + 1) * 64 + 16 * s + 8 * h);
        } else {
#pragma unroll
            for (int s = 0; s < 4; ++s) qn[s] = qf[s];
        }
        const bf16* zp = F.unat + (size_t)tokq * LDN + N_AZ + head * 64 + 8 * h;
        u32x2 zz[8];
#pragma unroll
        for (int p = 0; p < 4; ++p) { const u32x4 q_ = *(const u32x4*)(zp + 16 * p); zz[2 * p] = (u32x2){q_.x, q_.y}; zz[2 * p + 1] = (u32x2){q_.z, q_.w}; }
        float m = F.sink[l * 12 + head] * LOG2E, lsum = h ? 0.f : 1.f;
        f32x16 O0 = zero16(), O1 = zero16();
        const unsigned goff = (unsigned)(g * WA_TBS * 4);
#pragma unroll
        for (int dt_ = 0; dt_ < 9; ++dt_) {
            if (dt_ >= dlo && dt_ < dhi) {
                const int kt = qt + dt_;
                f32x16 S = zero16();
                const int krow_ = kt * 32 + r;
#pragma unroll
                for (int s = 0; s < 4; ++s) { const bf16x8 kf = *(const LAS bf16x8*)(lds + WA_K + krow_ * 128 + (((2 * s + h) ^ ((krow_ >> 1) & 7)) << 4)); S = MFMA32(kf, qf[s], S); }
                float bs[16];
#pragma unroll
                for (int i = 0; i < 16; ++i) bs[i] = *(const LAS float*)(lds + (bad[i] + goff) + dt_ * 128);
                float mx = -INFINITY;
#pragma unroll
                for (int i = 0; i < 16; ++i) { const float sv = fmaf(S[i], C2A, bs[i]); S[i] = sv; mx = fmaxf(mx, sv); }
                if (__builtin_amdgcn_ballot_w64(mx > m + 6.f) != 0ull) {
                    mx = fmaxf(mx, shx(mx, 32, F.lane));
                    const float mn = fmaxf(m, mx), al = ex2(m - mn); m = mn; lsum *= al;
#pragma unroll
                    for (int i = 0; i < 16; ++i) { O0[i] *= al; O1[i] *= al; }
                }
#pragma unroll
                for (int i = 0; i < 16; ++i) { const float pv = ex2(S[i] - m); S[i] = pv; lsum += pv; }
                const bf16x8 pb0 = pack8(S, 0), pb1 = pack8(S, 1);
#pragma unroll
                for (int s2 = 0; s2 < 2; ++s2) {
                    const int kof = (kt * 32 + 16 * s2 + 4 * h) * 2;
                    const s16x4 a0 = *(const LAS s16x4*)(lds + WA_V + r * WA_VSTR + kof), a1 = *(const LAS s16x4*)(lds + WA_V + r * WA_VSTR + kof + 16);
                    const s16x4 c0 = *(const LAS s16x4*)(lds + WA_V + (32 + r) * WA_VSTR + kof), c1 = *(const LAS s16x4*)(lds + WA_V + (32 + r) * WA_VSTR + kof + 16);
                    const bf16x8 v0 = __builtin_shufflevector(a0, a1, 0, 1, 2, 3, 4, 5, 6, 7), v1 = __builtin_shufflevector(c0, c1, 0, 1, 2, 3, 4, 5, 6, 7);
                    O0 = MFMA32(v0, s2 ? pb1 : pb0, O0); O1 = MFMA32(v1, s2 ? pb1 : pb0, O1);
                }
            }
        }
        lsum += shx(lsum, 32, F.lane);
        const float inv = frcp(lsum);
        bf16* yp = F.yb + (size_t)tokq * DM + head * 64 + 8 * h;
#pragma unroll
        for (int p = 0; p < 4; ++p) { const auto sx = __builtin_amdgcn_permlane32_swap(zz[2 * p].x, zz[2 * p + 1].x, false, false), sy = __builtin_amdgcn_permlane32_swap(zz[2 * p].y, zz[2 * p + 1].y, false, false);
            zz[2 * p] = (u32x2){sx[0], sy[0]}; zz[2 * p + 1] = (u32x2){sx[1], sy[1]}; }
#pragma unroll
        for (int dt = 0; dt < 2; ++dt) {
            u32x2 wy[4];
#pragma unroll
            for (int g4 = 0; g4 < 4; ++g4) { const u32x2 z2 = zz[dt * 4 + g4];
                const f32x16& O = dt ? O1 : O0;
                const float y0 = O[4 * g4] * inv * silu(bflo(z2.x)), y1 = O[4 * g4 + 1] * inv * silu(bfhi(z2.x)), y2 = O[4 * g4 + 2] * inv * silu(bflo(z2.y)), y3 = O[4 * g4 + 3] * inv * silu(bfhi(z2.y));
                wy[g4].x = cvt_pk_bf16(y0, y1); wy[g4].y = cvt_pk_bf16(y2, y3); }
#pragma unroll
            for (int p = 0; p < 2; ++p) { const auto sx = __builtin_amdgcn_permlane32_swap(wy[2 * p].x, wy[2 * p + 1].x, false, false), sy = __builtin_amdgcn_permlane32_swap(wy[2 * p].y, wy[2 * p + 1].y, false, false);
                u32x4 o; o.x = sx[0]; o.y = sy[0]; o.z = sx[1]; o.w = sy[1]; *(u32x4*)(yp + 32 * dt + 16 * p) = o; }
        }
#pragma unroll
        for (int s = 0; s < 4; ++s) qf[s] = qn[s];
    }
    __syncthreads();
}

constexpr int NA_K = 0, NA_V = 73728, NA_VSTR = 1160, NA_TB = NA_V + 64 * NA_VSTR  , NA_TI = NA_TB + 480 * 4  , NA_X = NA_TI + 2048, NA_XQ = 2560, NA_END = NA_X + 4 * NA_XQ;
static_assert(NA_END <= MISC_OFF, "NA LDS map");
struct NaRegs { u32x4 k[9]; u32x4 v[9]; };
__device__ __forceinline__ void na_decode(int item, int& b, int& head, int& r0, int& rs0) { b = item / 384; head = (item / 32) % 12; r0 = 2 * (item & 31); int t = r0 - 4; rs0 = t < 0 ? 0 : (t > 56 ? 56 : t); }
__device__ __forceinline__ void na_row_issue(Ctx& F, int b, int head, int gr, u32x4& kreg, u32x4& vreg) {
    const int kc = F.tid >> 3, c = F.tid & 7;
    kreg = *(const u32x4*)(F.unat + (size_t)(b * SEQ + gr * 64 + kc) * LDN + N_CK + head * 64 + c * 8);
    vreg = *(const u32x4*)(F.ut + (size_t)(T_CV + head * 64 + kc) * M + b * SEQ + gr * 64 + c * 8);
}
__device__ __forceinline__ void na_row_commit(Ctx& F, int gr, const u32x4& kreg, const u32x4& vreg) {
    const int kc = F.tid >> 3, c = F.tid & 7, slot = gr % 9, kk = slot * 64 + kc;
    *(LAS u32x4*)(F.lds + NA_K + kk * 128 + ((c ^ ((kk >> 1) & 7)) << 4)) = kreg;
    LAS unsigned char* dst = F.lds + NA_V + kc * NA_VSTR + (slot * 64 + c * 8) * 2;
    *(LAS u32x2*)dst = (u32x2){vreg.x, vreg.y}; *(LAS u32x2*)(dst + 8) = (u32x2){vreg.z, vreg.w};
}
#define SCHED_FENCE() __builtin_amdgcn_sched_barrier(0)
template <int CH>
__device__ __forceinline__ void na_tiles(LAS unsigned char* lds, const bf16x8 (&qf)[4], const unsigned (&badf)[16], const unsigned (&badc)[4], int rsj, int khalf, int r, int h,
                                         float& m, float& lsum, f32x16& O0, f32x16& O1) {
    bf16x8 kc[4];
    { const int kb0 = ((rsj + 4 * khalf) % 9) * 64, krow_ = kb0 + r;
#pragma unroll
      for (int s = 0; s < 4; ++s) kc[s] = *(const LAS bf16x8*)(lds + NA_K + krow_ * 128 + (((2 * s + h) ^ ((krow_ >> 1) & 7)) << 4)); }
#pragma unroll
    for (int it = 0; it < 8; ++it) {
        const int kri = it >> 1, kct = it & 1;
        const bool full = (kct == CH);
        const int kbase = ((rsj + 4 * khalf + kri) % 9) * 64 + kct * 32;
        s16x4 va[2][2], vc[2][2]; float bs[16];
#pragma unroll
        for (int s2 = 0; s2 < 2; ++s2) if (full || s2 == (kct ? 0 : 1)) {
            const int kof = (kbase + 16 * s2 + 4 * h) * 2;
            va[s2][0] = *(const LAS s16x4*)(lds + NA_V + r * NA_VSTR + kof); va[s2][1] = *(const LAS s16x4*)(lds + NA_V + r * NA_VSTR + kof + 16);
            vc[s2][0] = *(const LAS s16x4*)(lds + NA_V + (32 + r) * NA_VSTR + kof); vc[s2][1] = *(const LAS s16x4*)(lds + NA_V + (32 + r) * NA_VSTR + kof + 16);
        }
        if (full) {
#pragma unroll
            for (int i = 0; i < 16; ++i) bs[i] = *(const LAS float*)(lds + badf[i] + kri * 128);
        } else {
#pragma unroll
            for (int i = 0; i < 4; ++i) bs[i] = *(const LAS float*)(lds + badc[i] + kri * 128);
        }
        SCHED_FENCE();
        f32x16 S = zero16();
#pragma unroll
        for (int s = 0; s < 4; ++s) S = MFMA32(kc[s], qf[s], S);
        if (it < 7) { const int nb = ((rsj + 4 * khalf + ((it + 1) >> 1)) % 9) * 64 + ((it + 1) & 1) * 32, krow_ = nb + r;
#pragma unroll
            for (int s = 0; s < 4; ++s) kc[s] = *(const LAS bf16x8*)(lds + NA_K + krow_ * 128 + (((2 * s + h) ^ ((krow_ >> 1) & 7)) << 4)); }
        SCHED_FENCE();
        constexpr int NV = 16;
        const int i0 = full ? 0 : (kct ? 0 : 12), nv = full ? NV : 4;
        float mx = -INFINITY;
#pragma unroll
        for (int i = 0; i < NV; ++i) if (i < nv) { const float sv = fmaf(S[i0 + i], C2A, bs[i]); bs[i] = sv; mx = fmaxf(mx, sv); }
        { const auto sw = __builtin_amdgcn_permlane32_swap(__float_as_uint(mx), __float_as_uint(mx), false, false); mx = fmaxf(__uint_as_float(sw[0]), __uint_as_float(sw[1])); }
        const float mn = fmaxf(m, mx), al = ex2(m - mn); m = mn; lsum *= al;
#pragma unroll
        for (int i = 0; i < 16; ++i) { O0[i] *= al; O1[i] *= al; }
#pragma unroll
        for (int i = 0; i < NV; ++i) if (i < nv) { const float pv = ex2(bs[i] - mn); bs[i] = pv; lsum += pv; }
        if (full) {
            u32x4 p0, p1;
            p0.x = cvt_pk_bf16(bs[0], bs[1]); p0.y = cvt_pk_bf16(bs[2], bs[3]); p0.z = cvt_pk_bf16(bs[4], bs[5]); p0.w = cvt_pk_bf16(bs[6], bs[7]);
            p1.x = cvt_pk_bf16(bs[8], bs[9]); p1.y = cvt_pk_bf16(bs[10], bs[11]); p1.z = cvt_pk_bf16(bs[12], bs[13]); p1.w = cvt_pk_bf16(bs[14], bs[15]);
            const bf16x8 pb0 = __builtin_bit_cast(bf16x8, p0), pb1 = __builtin_bit_cast(bf16x8, p1);
            O0 = MFMA32(__builtin_shufflevector(va[0][0], va[0][1], 0, 1, 2, 3, 4, 5, 6, 7), pb0, O0); O1 = MFMA32(__builtin_shufflevector(vc[0][0], vc[0][1], 0, 1, 2, 3, 4, 5, 6, 7), pb0, O1);
            O0 = MFMA32(__builtin_shufflevector(va[1][0], va[1][1], 0, 1, 2, 3, 4, 5, 6, 7), pb1, O0); O1 = MFMA32(__builtin_shufflevector(vc[1][0], vc[1][1], 0, 1, 2, 3, 4, 5, 6, 7), pb1, O1);
        } else {
            u32x4 pw; const unsigned p01 = cvt_pk_bf16(bs[0], bs[1]), p23 = cvt_pk_bf16(bs[2], bs[3]);
            if (kct) { pw.x = p01; pw.y = p23; pw.z = 0u; pw.w = 0u; } else { pw.x = 0u; pw.y = 0u; pw.z = p01; pw.w = p23; }
            const bf16x8 pbx = __builtin_bit_cast(bf16x8, pw);
            const int s2 = kct ? 0 : 1;
            O0 = MFMA32(__builtin_shufflevector(va[s2][0], va[s2][1], 0, 1, 2, 3, 4, 5, 6, 7), pbx, O0); O1 = MFMA32(__builtin_shufflevector(vc[s2][0], vc[s2][1], 0, 1, 2, 3, 4, 5, 6, 7), pbx, O1);
        }
    }
}

__device__ __forceinline__ void nattn_all(Ctx& F, int l) {
    LAS unsigned char* lds = F.lds;
    const int vb = (F.G == 256) ? ((F.bid & 7) * 32 + (F.bid >> 3)) : F.bid;
    const int per = (1536 + F.G - 1) / F.G, it0 = vb * per, it1 = (it0 + per) < 1536 ? (it0 + per) : 1536;
    if (F.wave >= 4) __builtin_amdgcn_s_setprio(1);
    const int qt = F.wave & 3, khalf = F.wave >> 2, j = qt >> 1, ch = qt & 1, r = F.lane & 31, h = F.lane >> 5;
    const int qc = 32 * ch + r; int cs = qc - 8; cs = cs < 0 ? 0 : (cs > 48 ? 48 : cs);
    unsigned badf[16], badc[4];
#pragma unroll
    for (int i = 0; i < 16; ++i) { const int kc = ch * 32 + crow(i, h); const bool ok = (kc >= cs) && (kc < cs + 16); int dc = kc - qc; dc = dc < -15 ? -15 : (dc > 15 ? 15 : dc);
        badf[i] = (unsigned)(NA_TI + ((j * 8 + khalf * 4) * 32 + (ok ? dc + 15 : 31)) * 4); }
#pragma unroll
    for (int i = 0; i < 4; ++i) { const int kct = 1 - ch, ii = (kct ? 0 : 12) + i; const int kc = kct * 32 + crow(ii, h); const bool ok = (kc >= cs) && (kc < cs + 16); int dc = kc - qc; dc = dc < -15 ? -15 : (dc > 15 ? 15 : dc);
        badc[i] = (unsigned)(NA_TI + ((j * 8 + khalf * 4) * 32 + (ok ? dc + 15 : 31)) * 4); }
    int have_bh = -1, have_hi = -1, pf_lo = 0, pf_n = 0, tb_bh = -1;
    u32x4 pk0, pv0, pk1, pv1; bf16x8 qn[4]; bool have_qn = false;
    pk0 = pv0 = pk1 = pv1 = (u32x4){0u, 0u, 0u, 0u};
#pragma unroll
    for (int s = 0; s < 4; ++s) qn[s] = (bf16x8){0, 0, 0, 0, 0, 0, 0, 0};
#pragma unroll 1
    for (int item = it0; item < it1; ++item) {
        int b, head, r0, rs0; na_decode(item, b, head, r0, rs0);
        const int bh = b * 12 + head, need_hi = (rs0 + 8) < 63 ? (rs0 + 8) : 63, tokb = b * SEQ;
        if (bh != have_bh) {
            NaRegs R;
#pragma unroll
            for (int jj = 0; jj < 9; ++jj) { const int gr = (rs0 + jj) < 63 ? (rs0 + jj) : 63; na_row_issue(F, b, head, gr, R.k[jj], R.v[jj]); }
#pragma unroll
            for (int jj = 0; jj < 9; ++jj) { if (rs0 + jj <= 63) na_row_commit(F, rs0 + jj, R.k[jj], R.v[jj]); }
            LAS float* tbw = (LAS float*)(lds + NA_TB);
            for (int i = F.tid; i < 465; i += NTHR) tbw[i] = F.rpb[(size_t)(l * 12 + head) * 465 + i] * LOG2E;
            have_bh = bh;
        } else {
            if (pf_n > 0) na_row_commit(F, pf_lo, pk0, pv0);
            if (pf_n > 1) na_row_commit(F, pf_lo + 1, pk1, pv1);
        }
        have_hi = need_hi;
        if (bh != tb_bh) { LDS_BARRIER(); tb_bh = bh; }
        { const LAS float* tb = (const LAS float*)(lds + NA_TB); const int jj = F.tid >> 8, kidx = (F.tid >> 5) & 7, dci = F.tid & 31;
          int rsq = r0 + jj - 4; rsq = rsq < 0 ? 0 : (rsq > 56 ? 56 : rsq); const int dr = rsq + kidx - (r0 + jj) + 7;
          ((LAS float*)(lds + NA_TI))[F.tid] = dci < 31 ? tb[dr * 31 + dci] : -INFINITY; }
        const int qrow = r0 + j; int rsj = qrow - 4; rsj = rsj < 0 ? 0 : (rsj > 56 ? 56 : rsj);
        const int tokq = tokb + qrow * 64 + qc;
        bf16x8 qf[4];
        if (have_qn) {
#pragma unroll
            for (int s = 0; s < 4; ++s) qf[s] = qn[s];
        } else {
#pragma unroll
            for (int s = 0; s < 4; ++s) qf[s] = *(const bf16x8*)(F.unat + (size_t)tokq * LDN + N_CQ + head * 64 + 16 * s + 8 * h);
        }
        const bf16* zp = F.unat + (size_t)tokq * LDN + N_CZ + head * 64 + 32 * khalf + 4 * h;
        u32x2 zz[4];
#pragma unroll
        for (int g4 = 0; g4 < 4; ++g4) zz[g4] = *(const u32x2*)(zp + 8 * g4);
        LDS_BARRIER();
        pf_n = 0; have_qn = false;
        if (item + 1 < it1) {
            int nb, nhead, nr0, nrs0; na_decode(item + 1, nb, nhead, nr0, nrs0);
            if (nb * 12 + nhead == bh) {
                const int nhi = (nrs0 + 8) < 63 ? (nrs0 + 8) : 63;
                pf_lo = have_hi + 1; pf_n = nhi - have_hi;
                if (pf_n > 0) na_row_issue(F, b, head, pf_lo, pk0, pv0);
                if (pf_n > 1) na_row_issue(F, b, head, pf_lo + 1, pk1, pv1);
            }
            const int ntokq = nb * SEQ + (nr0 + j) * 64 + qc;
#pragma unroll
            for (int s = 0; s < 4; ++s) qn[s] = *(const bf16x8*)(F.unat + (size_t)ntokq * LDN + N_CQ + nhead * 64 + 16 * s + 8 * h);
            have_qn = true;
        }
        float m = -1e30f, lsum = 0.f;
        f32x16 O0 = zero16(), O1 = zero16();
        if (ch == 0) na_tiles<0>(lds, qf, badf, badc, rsj, khalf, r, h, m, lsum, O0, O1); else na_tiles<1>(lds, qf, badf, badc, rsj, khalf, r, h, m, lsum, O0, O1);
        lsum += shx(lsum, 32, F.lane);
        LAS unsigned* xq = (LAS unsigned*)(lds + NA_X + qt * NA_XQ);
        LAS float* xf = (LAS float*)(lds + NA_X + qt * NA_XQ + 2048);
        bf16* yp = F.yb + (size_t)tokq * DM + 1280 + head * 64 + 32 * khalf + 4 * h;
        if (khalf == 1) {
#pragma unroll
            for (int i = 0; i < 8; ++i) xq[i * 64 + F.lane] = cvt_pk_bf16(O0[2 * i], O0[2 * i + 1]);
            xf[F.lane] = m; xf[64 + F.lane] = lsum;
        }
        LDS_BARRIER();
        float m2 = 0.f, l2 = 0.f; unsigned ox[8];
        if (khalf == 0) {
            m2 = xf[F.lane]; l2 = xf[64 + F.lane];
#pragma unroll
            for (int i = 0; i < 8; ++i) ox[i] = xq[i * 64 + F.lane];
        }
        LDS_BARRIER();
        if (khalf == 0) {
#pragma unroll
            for (int i = 0; i < 8; ++i) xq[i * 64 + F.lane] = cvt_pk_bf16(O1[2 * i], O1[2 * i + 1]);
            xf[F.lane] = m; xf[64 + F.lane] = lsum;
        }
        LDS_BARRIER();
        if (khalf == 1) {
            m2 = xf[F.lane]; l2 = xf[64 + F.lane];
#pragma unroll
            for (int i = 0; i < 8; ++i) ox[i] = xq[i * 64 + F.lane];
        }
        {
            const float mn = fmaxf(m, m2), a1 = ex2(m - mn), a2 = ex2(m2 - mn);
            const float inv = frcp(lsum * a1 + l2 * a2);
#pragma unroll
            for (int g4 = 0; g4 < 4; ++g4) {
                float o[4];
#pragma unroll
                for (int e = 0; e < 4; ++e) { const float mine = khalf ? O1[4 * g4 + e] : O0[4 * g4 + e]; const unsigned pw = ox[2 * g4 + (e >> 1)]; const float oth = (e & 1) ? bfhi(pw) : bflo(pw);
                    o[e] = (mine * a1 + oth * a2) * inv; }
                const u32x2 z2 = zz[g4];
                const float y0 = o[0] * silu(bflo(z2.x)), y1 = o[1] * silu(bfhi(z2.x)), y2 = o[2] * silu(bflo(z2.y)), y3 = o[3] * silu(bfhi(z2.y));
                u32x2 w; w.x = cvt_pk_bf16(y0, y1); w.y = cvt_pk_bf16(y2, y3); *(u32x2*)(yp + 8 * g4) = w; }
        }
    }
    __builtin_amdgcn_s_setprio(0);
    LDS_BARRIER();
}

__device__ __forceinline__ size_t cst_off(int cid, int c, int d) { return ((size_t)((cid * 8 + (d >> 4)) * 64 + c)) * 2048 + (size_t)(d & 15) * 128; }
__device__ __forceinline__ void m1_wave(Ctx& F, int wi, int l) {
    const int b = wi >> 9, head = (wi >> 7) & 3, c = (wi >> 1) & 63, dir = wi & 1;
    const int tok0 = b * SEQ + c * 64;
    const int lane = F.lane, r = lane & 31, h = lane >> 5;
    LAS float* wtab = (LAS float*)(F.lds + F.wave * 256);
    const float ig = F.gate[(size_t)(tok0 + lane) * 16 + (2 * dir) * 4 + head];
    const float fg = F.gate[(size_t)(tok0 + lane) * 16 + (2 * dir + 1) * 4 + head] + F.fbias[l * 8 + dir * 4 + head];
    const float lf = logsigmoid(fg);
    const float cs = dir == 0 ? scan_sum_up(lf, lane) : scan_sum_down(lf, lane);
    const float g = shi(cs, dir == 0 ? 63 : 0);
    const float a = g - cs + ig;
    const float mloc = wave_max(a, lane);
    const float w = fexp(a - mloc);
    wtab[lane] = w;
    LDS_WAIT();
    const int cid = dir * 16 + b * 4 + head;
    if (lane == 0) { F.gs[cid * 64 + c] = g; F.ml[cid * 64 + c] = mloc; }
    f32x4 wv[8];
#pragma unroll
    for (int s = 0; s < 4; ++s) { wv[2 * s] = *(const LAS f32x4*)(wtab + 16 * s + 4 * h); wv[2 * s + 1] = *(const LAS f32x4*)(wtab + 16 * s + 8 + 4 * h); }
    bf16x8 af[4][4];
    {
        bf16x8 kn[2][8];
#pragma unroll
        for (int T = 0; T < 2; ++T)
#pragma unroll
            for (int j = 0; j < 8; ++j) kn[T][j] = *(const bf16x8*)(F.unat + (size_t)(tok0 + 32 * T + r) * LDN + N_BK + head * 128 + 16 * j + 8 * h);
        u32x4 i0, i1;
        { const unsigned one_lo = 0x3F80u, one_hi = 0x3F800000u; const int d0 = r - 8 * h, d1 = r - 16 - 8 * h;
          i0.x = d0 == 0 ? one_lo : d0 == 1 ? one_hi : 0u; i0.y = d0 == 2 ? one_lo : d0 == 3 ? one_hi : 0u; i0.z = d0 == 4 ? one_lo : d0 == 5 ? one_hi : 0u; i0.w = d0 == 6 ? one_lo : d0 == 7 ? one_hi : 0u;
          i1.x = d1 == 0 ? one_lo : d1 == 1 ? one_hi : 0u; i1.y = d1 == 2 ? one_lo : d1 == 3 ? one_hi : 0u; i1.z = d1 == 4 ? one_lo : d1 == 5 ? one_hi : 0u; i1.w = d1 == 6 ? one_lo : d1 == 7 ? one_hi : 0u; }
        const bf16x8 I0 = __builtin_bit_cast(bf16x8, i0), I1 = __builtin_bit_cast(bf16x8, i1);
#pragma unroll
        for (int et = 0; et < 4; ++et)
#pragma unroll
            for (int T = 0; T < 2; ++T) {
                f32x16 d = zero16();
                d = MFMA32(kn[T][2 * et], I0, d); d = MFMA32(kn[T][2 * et + 1], I1, d);
                af[et][2 * T] = pack8(d, 0); af[et][2 * T + 1] = pack8(d, 1);
            }
    }
#pragma unroll
    for (int et = 0; et < 4; ++et) { float ns = 0.f;
#pragma unroll
        for (int s = 0; s < 4; ++s) { const u32x4 raw = __builtin_bit_cast(u32x4, af[et][s]); const f32x4 w0 = wv[2 * s], w1 = wv[2 * s + 1];
            ns += bflo(raw.x) * w0[0] + bfhi(raw.x) * w0[1] + bflo(raw.y) * w0[2] + bfhi(raw.y) * w0[3] + bflo(raw.z) * w1[0] + bfhi(raw.z) * w1[1] + bflo(raw.w) * w1[2] + bfhi(raw.w) * w1[3]; }
        ns += shx(ns, 32, lane);
        if (h == 0) F.nst[(size_t)(cid * 64 + c) * 128 + 32 * et + r] = ns; }
#pragma unroll 1
    for (int dt = 0; dt < 4; ++dt) {
        bf16x8 bfr[4];
#pragma unroll
        for (int s = 0; s < 4; ++s) {
            const u32x4 q = *(const u32x4*)(F.ut + (size_t)(T_BV + head * 128 + 32 * dt + r) * M + tok0 + 16 * s + 8 * h);
            const auto sx = __builtin_amdgcn_permlane32_swap(q.x, q.z, false, false), sy = __builtin_amdgcn_permlane32_swap(q.y, q.w, false, false);
            u32x4 raw; raw.x = sx[0]; raw.y = sy[0]; raw.z = sx[1]; raw.w = sy[1];
            const f32x4 w0 = wv[2 * s], w1 = wv[2 * s + 1];
            u32x4 o; o.x = cvt_pk_bf16(bflo(raw.x) * w0[0], bfhi(raw.x) * w0[1]); o.y = cvt_pk_bf16(bflo(raw.y) * w0[2], bfhi(raw.y) * w0[3]);
            o.z = cvt_pk_bf16(bflo(raw.z) * w1[0], bfhi(raw.z) * w1[1]); o.w = cvt_pk_bf16(bflo(raw.w) * w1[2], bfhi(raw.w) * w1[3]);
            bfr[s] = __builtin_bit_cast(bf16x8, o);
        }
        bf16* cdst = F.cst + cst_off(cid, c, 32 * dt + r);
#pragma unroll
        for (int et = 0; et < 4; ++et) {
            f32x16 acc = zero16();
#pragma unroll
            for (int s = 0; s < 4; ++s) acc = MFMA32(af[et][s], bfr[s], acc);
#pragma unroll
            for (int p = 0; p < 2; ++p) {
                const unsigned a0 = cvt_pk_bf16(acc[8 * p], acc[8 * p + 1]), a1 = cvt_pk_bf16(acc[8 * p + 2], acc[8 * p + 3]);
                const unsigned b0 = cvt_pk_bf16(acc[8 * p + 4], acc[8 * p + 5]), b1 = cvt_pk_bf16(acc[8 * p + 6], acc[8 * p + 7]);
                const auto s0 = __builtin_amdgcn_permlane32_swap(a0, b0, false, false), s1 = __builtin_amdgcn_permlane32_swap(a1, b1, false, false);
                u32x4 o; o.x = s0[0]; o.y = s1[0]; o.z = s0[1]; o.w = s1[1];
                *(u32x4*)(cdst + 32 * et + 16 * p + 8 * h) = o; }
        }
    }
    LDS_WAIT();
}

__device__ __forceinline__ void m2_scan(Ctx& F) {
    LAS float* sps = (LAS float*)F.lds; LAS float* sls = sps + 64;
    for (int blk = F.bid; blk < 256; blk += F.G) {
        const int cid = blk >> 3, dir = cid >> 4, e4 = (blk & 7) * 512 + F.tid;
        if (F.wave == 0) {
            const int sidx = F.lane, c = dir ? 63 - sidx : sidx;
            const float g = F.gs[cid * 64 + c], mloc = F.ml[cid * 64 + c];
            const float Gs = scan_sum_up(g, sidx);
            const float ma = Gs + fmaxf(0.f, scan_max_up(mloc - Gs, sidx));
            const float mb0 = shi(ma, sidx - 1); const float mb = sidx == 0 ? 0.f : mb0;
            sps[sidx] = fexp(g + mb - ma); sls[sidx] = fexp(mloc - ma); F.mprev[cid * 64 + c] = mb;
        }
        __syncthreads();
        float C0 = 0.f, C1 = 0.f, C2 = 0.f, C3 = 0.f;
        f32x4 nn = {0.f, 0.f, 0.f, 0.f};
        const bool do_n = e4 < 32;
        bf16* cb = F.cst + (size_t)(cid * 8 + (blk & 7)) * 64 * 2048 + F.tid * 4;
        float* nb = F.nst + (size_t)cid * 64 * 128 + (e4 & 31) * 4;
#pragma unroll 1
        for (int s0 = 0; s0 < 64; s0 += 16) {
            u32x2 cl[16]; f32x4 nl[16];
#pragma unroll
            for (int j = 0; j < 16; ++j) { const int c = dir ? 63 - (s0 + j) : (s0 + j); cl[j] = *(const u32x2*)(cb + (size_t)c * 2048); }
            if (do_n) {
#pragma unroll
                for (int j = 0; j < 16; ++j) { const int c = dir ? 63 - (s0 + j) : (s0 + j); nl[j] = *(const f32x4*)(nb + (size_t)c * 128); }
            }
#pragma unroll
            for (int j = 0; j < 16; ++j) {
                const int c = dir ? 63 - (s0 + j) : (s0 + j);
                u32x2 o; o.x = cvt_pk_bf16(C0, C1); o.y = cvt_pk_bf16(C2, C3); *(u32x2*)(cb + (size_t)c * 2048) = o;
                const float sp = sps[s0 + j], sl = sls[s0 + j];
                C0 = sp * C0 + sl * bflo(cl[j].x); C1 = sp * C1 + sl * bfhi(cl[j].x); C2 = sp * C2 + sl * bflo(cl[j].y); C3 = sp * C3 + sl * bfhi(cl[j].y);
                if (do_n) { *(f32x4*)(nb + (size_t)c * 128) = nn; nn = nn * sp + nl[j] * sl; }
            }
        }
        __syncthreads();
    }
}

constexpr int M3_TABW = 2560, M3_HB = 8 * M3_TABW  , M3_HW = 16384;
static_assert(M3_HB + 8 * M3_HW <= MISC_OFF, "M3 LDS map");
__device__ __forceinline__ void m3_wave(Ctx& F, int wi, int l) {
    const int b = wi >> 9, head = (wi >> 7) & 3, c = (wi >> 1) & 63, tt = wi & 1;
    const int tok0 = b * SEQ + c * 64;
    int lane_ = 0; asm volatile("" : "+v"(lane_)); lane_ = (int)__builtin_amdgcn_mbcnt_hi(~0u, __builtin_amdgcn_mbcnt_lo(~0u, (unsigned)lane_));
    const int lane = lane_, r = lane & 31, h = lane >> 5;
    LAS float* tab = (LAS float*)(F.lds + F.wave * M3_TABW);
    LAS float* hb = (LAS float*)(F.lds + M3_HB + F.wave * M3_HW);
    const int cidf = b * 4 + head, cidb = 16 + b * 4 + head;
    const int t = 32 * tt + r;
    const float* gp = F.gate + (size_t)(tok0 + lane) * 16;
    const float g_if = gp[head], g_ff = gp[4 + head], g_ib = gp[8 + head], g_fb = gp[12 + head];
    const float mpf = F.mprev[cidf * 64 + c], mpb = F.mprev[cidb * 64 + c];
    const float* nf = F.nst + (size_t)(cidf * 64 + c) * 128; const float* nbw = F.nst + (size_t)(cidb * 64 + c) * 128;
    const float n0_ = nf[lane], n1_ = nf[64 + lane], n2_ = nbw[lane], n3_ = nbw[64 + lane];
    bf16x8 qf[8], kf0[8];
#pragma unroll
    for (int s = 0; s < 8; ++s) qf[s] = *(const bf16x8*)(F.unat + (size_t)(tok0 + t) * LDN + N_BQ + head * 128 + 16 * s + 8 * h);
#pragma unroll
    for (int s = 0; s < 8; ++s) kf0[s] = *(const bf16x8*)(F.unat + (size_t)(tok0 + r) * LDN + N_BK + head * 128 + 16 * s + 8 * h);
    SCHED_FENCE();
    {
        const float f_f = g_ff + F.fbias[l * 8 + head], f_b = g_fb + F.fbias[l * 8 + 4 + head];
        const float bf_ = scan_sum_up(logsigmoid(f_f), lane), bb_ = scan_sum_down(logsigmoid(f_b), lane);
        const float uf = g_if - bf_, ub = g_ib - bb_;
        const float MF = fmaxf(mpf, scan_max_up(uf, lane)), MB = fmaxf(mpb, scan_max_down(ub, lane));
        tab[lane] = uf; tab[64 + lane] = ub; tab[128 + lane] = MF; tab[192 + lane] = MB; tab[256 + lane] = bf_; tab[320 + lane] = bb_;
        tab[384 + lane] = n0_; tab[448 + lane] = n1_; tab[512 + lane] = n2_; tab[576 + lane] = n3_;
        LDS_WAIT();
    }
    f32x16 S0 = zero16(), S1 = zero16();
    {
        bf16x8 kf1[8];
#pragma unroll
        for (int s = 0; s < 8; ++s) kf1[s] = *(const bf16x8*)(F.unat + (size_t)(tok0 + 32 + r) * LDN + N_BK + head * 128 + 16 * s + 8 * h);
        SCHED_FENCE();
#pragma unroll
        for (int s = 0; s < 8; ++s) S0 = MFMA32(kf0[s], qf[s], S0);
#pragma unroll
        for (int s = 0; s < 8; ++s) S1 = MFMA32(kf1[s], qf[s], S1);
    }
    bf16x8 pb[2][4]; float interw[2], inv[2];
#pragma unroll
    for (int dir = 0; dir < 2; ++dir) {
        const LAS float* U = tab + dir * 64;
        const float Mt = tab[128 + dir * 64 + t], Bt = tab[256 + dir * 64 + t], mp = dir ? mpb : mpf;
        const LAS float* np = tab + 384 + dir * 128 + 8 * h;
        float nq = 0.f;
#pragma unroll
        for (int s = 0; s < 8; ++s) { const f32x4 n0 = *(const LAS f32x4*)(np + 16 * s), n1 = *(const LAS f32x4*)(np + 16 * s + 4); const u32x4 qq = __builtin_bit_cast(u32x4, qf[s]);
            nq += n0[0] * bflo(qq.x) + n0[1] * bfhi(qq.x) + n0[2] * bflo(qq.y) + n0[3] * bfhi(qq.y) + n1[0] * bflo(qq.z) + n1[1] * bfhi(qq.z) + n1[2] * bflo(qq.w) + n1[3] * bfhi(qq.w); }
        nq += shx(nq, 32, lane);
        interw[dir] = fexp(mp - Mt) * QS;
        float den = 0.f;
#pragma unroll
        for (int st = 0; st < 2; ++st) {
            f32x16 P;
#pragma unroll
            for (int g4 = 0; g4 < 4; ++g4) { const f32x4 uu = *(const LAS f32x4*)(U + 32 * st + 8 * g4 + 4 * h);
#pragma unroll
                for (int e = 0; e < 4; ++e) { const int sp = 32 * st + 8 * g4 + 4 * h + e; const bool ok = dir ? (sp >= t) : (sp <= t);
                    const float wgt = ok ? fexp(uu[e] - Mt) : 0.f; const float pv = (st ? S1[4 * g4 + e] : S0[4 * g4 + e]) * QS * wgt; P[4 * g4 + e] = pv; den += pv; } }
            pb[dir][2 * st] = pack8(P, 0); pb[dir][2 * st + 1] = pack8(P, 1);
        }
        den += shx(den, 32, lane);
        den += nq * interw[dir];
        inv[dir] = frcp(fmaxf(fabsf(den), fexp(-(Bt + Mt))));
    }
    bf16x8 cfa[8], cfb[8]; s16x4 vv[8]; u32x2 og[4];
    int ro = r, ho = h; asm volatile("" : "+v"(ro), "+v"(ho));
    const int to = 32 * tt + ro;
#define M3_LOADC(dst, dir, dt) do { SCHED_FENCE(); { const bf16* cp = F.cst + cst_off((dir ? cidb : cidf), c, 32 * (dt) + ro) + 8 * ho; \
        _Pragma("unroll") for (int s = 0; s < 8; ++s) dst[s] = *(const bf16x8*)(cp + 16 * s); } SCHED_FENCE(); } while (0)
#define M3_LOADV(dt) do { SCHED_FENCE(); { const bf16* vp = F.ut + (size_t)(T_BV + head * 128 + 32 * (dt) + ro) * M + tok0 + 8 * ho; \
        _Pragma("unroll") for (int ks = 0; ks < 4; ++ks) { const u32x4 q_ = *(const u32x4*)(vp + 16 * ks); vv[2 * ks] = __builtin_bit_cast(s16x4, (u32x2){q_.x, q_.y}); vv[2 * ks + 1] = __builtin_bit_cast(s16x4, (u32x2){q_.z, q_.w}); } } \
        { const bf16* op = F.unat + (size_t)(tok0 + to) * LDN + N_BO + head * 128 + 32 * (dt) + 8 * ho; \
        _Pragma("unroll") for (int p = 0; p < 2; ++p) { const u32x4 q_ = *(const u32x4*)(op + 16 * p); og[2 * p] = (u32x2){q_.x, q_.y}; og[2 * p + 1] = (u32x2){q_.z, q_.w}; } } SCHED_FENCE(); } while (0)
    M3_LOADC(cfa, 0, 0); M3_LOADV(0);
    float s1 = 0.f, s2 = 0.f;
#pragma unroll 1
    for (int dt = 0; dt < 4; ++dt) {
        f32x16 H;
#pragma unroll
        for (int ks = 0; ks < 4; ++ks) {
            const u32x2 lo = __builtin_bit_cast(u32x2, vv[2 * ks]), hi = __builtin_bit_cast(u32x2, vv[2 * ks + 1]);
            const auto sx = __builtin_amdgcn_permlane32_swap(lo.x, hi.x, false, false), sy = __builtin_amdgcn_permlane32_swap(lo.y, hi.y, false, false);
            vv[2 * ks] = __builtin_bit_cast(s16x4, (u32x2){sx[0], sy[0]}); vv[2 * ks + 1] = __builtin_bit_cast(s16x4, (u32x2){sx[1], sy[1]}); }
        {
            f32x16 X = zero16();
#pragma unroll
            for (int s = 0; s < 8; ++s) X = MFMA32(cfa[s], qf[s], X);
            M3_LOADC(cfb, 1, dt);
            const float iw = interw[0];
#pragma unroll
            for (int i = 0; i < 16; ++i) X[i] *= iw;
#pragma unroll
            for (int ks = 0; ks < 4; ++ks) X = MFMA32(__builtin_shufflevector(vv[2 * ks], vv[2 * ks + 1], 0, 1, 2, 3, 4, 5, 6, 7), pb[0][ks], X);
            const float iv = inv[0];
#pragma unroll
            for (int i = 0; i < 16; ++i) H[i] = X[i] * iv;
        }
        {
            f32x16 X = zero16();
#pragma unroll
            for (int s = 0; s < 8; ++s) X = MFMA32(cfb[s], qf[s], X);
            if (dt < 3) M3_LOADC(cfa, 0, dt + 1);
            const float iw = interw[1];
#pragma unroll
            for (int i = 0; i < 16; ++i) X[i] *= iw;
#pragma unroll
            for (int ks = 0; ks < 4; ++ks) X = MFMA32(__builtin_shufflevector(vv[2 * ks], vv[2 * ks + 1], 0, 1, 2, 3, 4, 5, 6, 7), pb[1][ks], X);
            const float iv = inv[1];
#pragma unroll
            for (int i = 0; i < 16; ++i) H[i] += X[i] * iv;
        }
#pragma unroll
        for (int p = 0; p < 2; ++p) { const auto sx = __builtin_amdgcn_permlane32_swap(og[2 * p].x, og[2 * p + 1].x, false, false), sy = __builtin_amdgcn_permlane32_swap(og[2 * p].y, og[2 * p + 1].y, false, false);
            og[2 * p] = (u32x2){sx[0], sy[0]}; og[2 * p + 1] = (u32x2){sx[1], sy[1]}; }
#pragma unroll
        for (int g4 = 0; g4 < 4; ++g4) { const u32x2 oo = og[g4];
            H[4 * g4] *= sigm(bflo(oo.x)); H[4 * g4 + 1] *= sigm(bfhi(oo.x)); H[4 * g4 + 2] *= sigm(bflo(oo.y)); H[4 * g4 + 3] *= sigm(bfhi(oo.y)); }
        if (dt < 3) M3_LOADV(dt + 1);
#pragma unroll
        for (int i = 0; i < 16; ++i) { s1 += H[i]; s2 += H[i] * H[i]; hb[(dt * 16 + i) * 64 + lane] = H[i]; }
    }
#undef M3_LOADC
#undef M3_LOADV
    s1 += shx(s1, 32, lane); s2 += shx(s2, 32, lane);
    const float mean = s1 * (1.f / 128.f), var = fmaxf(s2 * (1.f / 128.f) - mean * mean, 0.f), rstd = __builtin_amdgcn_rsqf(var + LN_EPS);
    LDS_WAIT();
    int rz = r, hz = h; asm volatile("" : "+v"(rz), "+v"(hz)); const int tz = 32 * tt + rz;
    bf16* yp = F.yb + (size_t)(tok0 + tz) * DM + 768 + head * 128 + 8 * hz;
    const bf16* zp = F.unat + (size_t)(tok0 + tz) * LDN + N_BZ + head * 128 + 8 * hz; const float* ng = F.norm_g + l * 512 + head * 128 + 4 * hz;
#pragma unroll 1
    for (int half = 0; half < 2; ++half) {
        u32x4 zq[4]; u32x2 zz[8]; f32x4 gn[8];
#pragma unroll
        for (int p = 0; p < 4; ++p) zq[p] = *(const u32x4*)(zp + 16 * (4 * half + p));
#pragma unroll
        for (int i = 0; i < 8; ++i) gn[i] = *(const f32x4*)(ng + 8 * (8 * half + i));
#pragma unroll
        for (int p = 0; p < 4; ++p) { const auto sx = __builtin_amdgcn_permlane32_swap(zq[p].x, zq[p].z, false, false), sy = __builtin_amdgcn_permlane32_swap(zq[p].y, zq[p].w, false, false);
            zz[2 * p] = (u32x2){sx[0], sy[0]}; zz[2 * p + 1] = (u32x2){sx[1], sy[1]}; }
        u32x2 wy[8];
#pragma unroll
        for (int i = 0; i < 8; ++i) { const int ii = 8 * half + i;
            const float h0 = hb[(4 * ii) * 64 + lane], h1 = hb[(4 * ii + 1) * 64 + lane], h2 = hb[(4 * ii + 2) * 64 + lane], h3 = hb[(4 * ii + 3) * 64 + lane];
            const float y0 = (h0 - mean) * rstd * gn[i][0] * silu(bflo(zz[i].x)), y1 = (h1 - mean) * rstd * gn[i][1] * silu(bfhi(zz[i].x));
            const float y2 = (h2 - mean) * rstd * gn[i][2] * silu(bflo(zz[i].y)), y3 = (h3 - mean) * rstd * gn[i][3] * silu(bfhi(zz[i].y));
            wy[i].x = cvt_pk_bf16(y0, y1); wy[i].y = cvt_pk_bf16(y2, y3); }
#pragma unroll
        for (int p = 0; p < 4; ++p) { const auto sx = __builtin_amdgcn_permlane32_swap(wy[2 * p].x, wy[2 * p + 1].x, false, false), sy = __builtin_amdgcn_permlane32_swap(wy[2 * p].y, wy[2 * p + 1].y, false, false);
            u32x4 o; o.x = sx[0]; o.y = sy[0]; o.z = sx[1]; o.w = sy[1]; *(u32x4*)(yp + 16 * (4 * half + p)) = o; }
    }
    LDS_WAIT();
}

__global__ void __launch_bounds__(NTHR, 2) mega(Args args) {
    extern __shared__ __attribute__((aligned(16))) unsigned char lds_raw[];
    LAS unsigned char* const ldsb = (LAS unsigned char*)lds_raw;
    const int wave_s = __builtin_amdgcn_readfirstlane((int)threadIdx.x >> 6);
#define TID_NOW() ([&]() { unsigned z_ = 0u; asm volatile("" : "+v"(z_)); return wave_s * 64 + (int)__builtin_amdgcn_mbcnt_hi(~0u, __builtin_amdgcn_mbcnt_lo(~0u, z_)); }())
#define MAKE_CTX() MAKE_CTX_L(1)
#define MAKE_CTX_L(lyr) Ctx F; { const int l_ = (lyr); auto kp_ = __builtin_amdgcn_kernarg_segment_ptr(); asm volatile("" : "+s"(kp_)); \
    const __attribute__((address_space(4))) Args* ap_ = (const __attribute__((address_space(4))) Args*)kp_; \
    F.lds = ldsb; { int tid_ = TID_NOW(); asm volatile("" : "+v"(tid_)); F.tid = tid_; } F.lane = F.tid & 63; F.wave = wave_s; F.G = gridDim.x; F.bid = blockIdx.x; \
    F.x = ap_->in[0]; F.emb_g = ap_->in[1]; F.emb_b = ap_->in[2]; F.w_in = ap_->in[3]; F.b_in = ap_->in[4]; F.w_out = ap_->in[5]; F.b_out = ap_->in[6]; \
    F.ln_g = ap_->in[7]; F.ln_b = ap_->in[8]; F.t5 = ap_->in[9]; F.sink = ap_->in[10]; F.fbias = ap_->in[11]; F.norm_g = ap_->in[12]; F.rpb = ap_->in[13]; \
    F.out = ap_->out; F.ws = ap_->ws; \
    F.hby = (bf16*)(F.ws + WS_HBY); F.yb = l_ == 0 ? (bf16*)F.out : F.hby; F.unat = (bf16*)(F.ws + WS_UNAT); F.ut = (bf16*)(F.ws + WS_UT); F.cst = (bf16*)(F.ws + WS_CST); F.nst = (float*)(F.ws + WS_NST); \
    F.gs = (float*)(F.ws + WS_SCAL); F.ml = F.gs + 2048; F.mprev = F.gs + 4096; F.gate = (float*)(F.ws + WS_GATE); F.stat = (float*)(F.ws + WS_SCAL + 65536); }
    volatile LAS unsigned* MISC = (volatile LAS unsigned*)(ldsb + MISC_OFF);
    if (threadIdx.x < 32) MISC[threadIdx.x] = 0u;
    __syncthreads();
    XcdBarrier bar; bar.bar = (unsigned*)(args.ws + WS_CTL) + CW_BAR; bar.x = 0; bar.st = nullptr;
    if (!MK_PER_PHASE) bar = xcd_barrier_post((unsigned*)(args.ws + WS_CTL) + CW_BAR, MISC + 8, (int)threadIdx.x);
    const int lo = args.ph_lo, hi = args.ph_hi;
#define IN(k) (lo <= (k) && (k) < hi)
#define SEAM(k) do { if (IN(k) && IN((k) + 1)) { for (int rb_ = 0; rb_ < REP_BAR; ++rb_) xcd_barrier(bar, TID_NOW()); } } while (0)
    #ifndef NO_P0
    if (IN(0)) { MAKE_CTX(); for (int rep_ = 0, nrep_ = opaque_int(REP_P0); rep_ < nrep_; ++rep_) phase_prologue(F); }
#endif
    SEAM(0);
#pragma unroll 1
    for (int l = 0; l < 2; ++l) {
        const int pb = 1 + 6 * l;
        if (IN(pb)) {
#ifndef NO_G1
            {   MAKE_CTX_L(l);
                pg8::Sched1 S{(const char*)F.hby, (const char*)(F.ws + WS_WIN + l * WIN_STRIDE), F.G, F.bid};
                pg8::Epi1 E{F.unat, F.ut, (const float*)(F.ws + WS_BIAS) + l * WROWS};
                pg8::gemm_phase<pg8::Epi1, pg8::Sched1, true, true>(F.lds, S, E, F.tid); }
#endif
#ifndef NO_GATES
            {   MAKE_CTX_L(l);
                if (l == 0) { bool is_h; int hid, nh; helper_of(F, 0, is_h, hid, nh); if (is_h) { weights_job(F, 1, hid * NWAVES + F.wave, nh * NWAVES); } __syncthreads(); }
                gates_job(F, l); }
#endif
        }
        SEAM(pb);
        if (IN(pb + 1)) {
            MAKE_CTX_L(l);
#ifndef NO_M1
            for (int rep_ = 0, nrep_ = opaque_int(REP_M1); rep_ < nrep_; ++rep_) for (int wi = F.bid * NWAVES + F.wave; wi < 2048; wi += F.G * NWAVES) m1_wave(F, wi, l);
#endif
            __syncthreads();
#ifndef NO_WA
            for (int rep_ = 0, nrep_ = opaque_int(REP_WA); rep_ < nrep_; ++rep_) for (int it0 = F.bid; it0 < 256; it0 += F.G) wattn_item(F, (F.G == 256) ? ((it0 & 7) * 32 + (it0 >> 3)) : it0, l);
#endif
        }
        SEAM(pb + 1);
        if (IN(pb + 2)) {
            MAKE_CTX_L(l);
#ifndef NO_M2
            m2_scan(F);
#endif
#ifndef NO_NA
            for (int rep_ = 0, nrep_ = opaque_int(REP_NA); rep_ < nrep_; ++rep_) nattn_all(F, l);
#endif
        }
        SEAM(pb + 2);
        if (IN(pb + 3)) {
            MAKE_CTX_L(l);
#ifndef NO_M3
            for (int rep_ = 0, nrep_ = opaque_int(REP_M3); rep_ < nrep_; ++rep_) for (int wi = F.bid * NWAVES + F.wave; wi < 2048; wi += F.G * NWAVES) m3_wave(F, wi, l);
#endif
        }
        SEAM(pb + 3);
        if (IN(pb + 4)) {
            MAKE_CTX_L(l);
            pg8::Sched2 S{(const char*)F.yb, (const char*)(F.ws + WS_WOUT + l * WOUT_STRIDE), F.G, F.bid};
#ifndef NO_G2
            if (l == 0) { pg8::Epi2<0> E{(float*)nullptr, (bf16*)(F.ws + WS_WIN), F.b_out, F.x, (const bf16*)F.hby, F.stat, F.emb_g, F.emb_b, (bf16*)(F.ws + WS_T1B)};
                pg8::gemm_phase<pg8::Epi2<0>, pg8::Sched2, true, true>(F.lds, S, E, F.tid); }
            else { pg8::Epi2<1> E{(float*)nullptr, (bf16*)(F.ws + WS_UNAT), F.b_out + DM, (const float*)nullptr, (const bf16*)nullptr, (const float*)nullptr, (const float*)nullptr, (const float*)nullptr, (bf16*)nullptr};
                pg8::gemm_phase<pg8::Epi2<1>, pg8::Sched2, true, true>(F.lds, S, E, F.tid); }
#endif
        }
        SEAM(pb + 4);
        if (IN(pb + 5)) {
            MAKE_CTX_L(l);
            const int gw = F.bid * NWAVES + F.wave, NGW = F.G * NWAVES;
            if (l == 0) { for (int m = 2 * gw; m < M; m += 2 * NGW) ln_row2_b(t1_row(F.ws, m), t1_row(F.ws, m + 1), F.hby + (size_t)m * DM, F.hby + (size_t)(m + 1) * DM, F.stat + (size_t)(M + m) * 2, F.stat + (size_t)(M + m + 1) * 2, F.ln_g, F.ln_b, F.lane); }
            else { const bf16* O2 = (const bf16*)(F.ws + WS_UNAT);
                   for (int m = 2 * gw; m < M; m += 2 * NGW) fin_row2(t1_row(F.ws, m), O2 + (size_t)m * DM, F.stat + (size_t)(M + m) * 2, F.ln_g, F.ln_b, F.ln_g + DM, F.ln_b + DM, F.out + (size_t)m * DM, F.lane); }
        }
        if (l == 0) SEAM(pb + 5);
    }
#undef IN
#undef SEAM
}

extern "C" void kernel_launch(void* const* d_in, const int* in_sizes, int n_in, void* d_out, int out_size, void* d_ws, size_t ws_size, hipStream_t stream) {
    static int grid = 0;
    if (grid == 0) {
        if (n_in != 14 || out_size != M * DM || ws_size < WS_END) { fprintf(stderr, "kernel_launch: unexpected shapes (n_in %d out %d ws %zu)\n", n_in, out_size, ws_size); grid = -1; return; }
        int dev = 0, cus = 0, per_cu = 0;
        if (hipGetDevice(&dev) != hipSuccess || hipDeviceGetAttribute(&cus, hipDeviceAttributeMultiprocessorCount, dev) != hipSuccess) { grid = -1; return; }
        if (hipFuncSetAttribute((const void*)mega, hipFuncAttributeMaxDynamicSharedMemorySize, LDS_BYTES) != hipSuccess) { fprintf(stderr, "kernel_launch: hipFuncSetAttribute failed\n"); grid = -1; return; }
        if (hipOccupancyMaxActiveBlocksPerMultiprocessor(&per_cu, (const void*)mega, NTHR, LDS_BYTES) != hipSuccess || per_cu < 1) fprintf(stderr, "kernel_launch: occupancy query says %d\n", per_cu);
        (void)hipGetLastError();
        grid = cus;
    }
    if (grid < 0) return;
    (void)hipMemsetAsync((char*)d_ws + WS_CTL, 0, CTL_BYTES, stream);
    Args a{};
    for (int i = 0; i < 14; ++i) a.in[i] = (const float*)d_in[i];
    a.out = (float*)d_out; a.ws = (unsigned char*)d_ws;
#if MK_PER_PHASE
    for (int p = 0; p < 13; ++p) { a.ph_lo = p; a.ph_hi = p + 1; hipLaunchKernelGGL(mega, dim3(grid), dim3(NTHR), LDS_BYTES, stream, a); }
#else
    a.ph_lo = 0; a.ph_hi = 13;
    hipLaunchKernelGGL(mega, dim3(grid), dim3(NTHR), LDS_BYTES, stream, a);
#endif
}
```

```cpp
#include <hip/hip_runtime.h>
#include <cstdio>
#include <cstdint>

#ifndef REP_P0
#define REP_P0 1
#endif
#ifndef REP_G1
#define REP_G1 1
#endif
#ifndef REP_M1
#define REP_M1 1
#endif
#ifndef REP_WA
#define REP_WA 1
#endif
#ifndef REP_NA
#define REP_NA 1
#endif
#ifndef REP_M3
#define REP_M3 1
#endif
#ifndef REP_GATES
#define REP_GATES 1
#endif
#ifndef REP_BAR
#define REP_BAR 1
#endif
#ifndef MK_PER_PHASE
#define MK_PER_PHASE 0
#endif

#define LAS __attribute__((address_space(3)))
#define GAS __attribute__((address_space(1)))
typedef unsigned short bf16;
typedef short bf16x8 __attribute__((ext_vector_type(8)));
typedef short s16x4 __attribute__((ext_vector_type(4)));
typedef float f32x4 __attribute__((ext_vector_type(4)));
typedef float f32x16 __attribute__((ext_vector_type(16)));
typedef unsigned u32x4 __attribute__((ext_vector_type(4)));
typedef unsigned u32x2 __attribute__((ext_vector_type(2)));
typedef GAS unsigned gu32;

constexpr int M = 16384, DM = 2048, SEQ = 4096, IN_W = 7696, NWAVES = 8, NTHR = 512;
constexpr int LDN = 6144;
constexpr int N_AQ = 0, N_AK = 768, N_AZ = 1024, N_BQ = 1792, N_BK = 2304, N_BO = 2816, N_BZ = 3328, N_CQ = 3840, N_CK = 4608, N_CZ = 5376;
constexpr int T_AV = 0, T_BK = 256, T_BV = 768, T_CV = 1280;
constexpr int WROWS = 8192 + 16;
constexpr float LN_EPS = 1e-5f, LOG2E = 1.4426950408889634f, ALPHA = 1.4142135623730951f;
constexpr float C2A = 0.125f * LOG2E;
constexpr float QS = 0.08838834764831845f;

constexpr size_t MiB = 1u << 20;
constexpr size_t WS_CTL = 0, CTL_BYTES = 1 * MiB;
constexpr size_t WS_WIN = 2 * MiB, WIN_STRIDE = 33 * MiB;
constexpr size_t WS_WOUT = 68 * MiB, WOUT_STRIDE = 8 * MiB;
constexpr size_t WS_BIAS = 84 * MiB;
constexpr size_t WS_GATE = 85 * MiB;
constexpr size_t WS_HBY = 86 * MiB;
constexpr size_t WS_UNAT = 150 * MiB;
constexpr size_t WS_UT = 342 * MiB;
constexpr size_t WS_CST = 406 * MiB;
constexpr size_t WS_NST = 470 * MiB;
constexpr size_t WS_SCAL = 471 * MiB;
constexpr size_t WS_T1B = 472 * MiB;
constexpr size_t WS_END = 504 * MiB;
constexpr int CW_BAR = 4096;

constexpr int LDS_BYTES = 163840, MISC_OFF = LDS_BYTES - 128;

__device__ __forceinline__ int opaque_int(int v) { asm volatile("" : "+s"(v)); return v; }
#define LDS_WAIT() asm volatile("s_waitcnt lgkmcnt(0)" ::: "memory")
#define LDS_BARRIER() do { asm volatile("s_waitcnt lgkmcnt(0)" ::: "memory"); __builtin_amdgcn_s_barrier(); asm volatile("" ::: "memory"); } while (0)
#define VM_WAIT() asm volatile("s_waitcnt vmcnt(0)" ::: "memory")
__device__ __forceinline__ float bf2f(unsigned v) { return __uint_as_float(v << 16); }
__device__ __forceinline__ float bflo(unsigned v) { return __uint_as_float(v << 16); }
__device__ __forceinline__ float bfhi(unsigned v) { return __uint_as_float(v & 0xffff0000u); }
typedef float f32x2_t __attribute__((ext_vector_type(2)));
typedef __bf16 bf16x2_t __attribute__((ext_vector_type(2)));
__device__ __forceinline__ unsigned cvt_pk_bf16(float lo, float hi) { const f32x2_t v = {lo, hi}; const bf16x2_t b = __builtin_convertvector(v, bf16x2_t); return __builtin_bit_cast(unsigned, b); }
__device__ __forceinline__ float ex2(float x) { return __builtin_amdgcn_exp2f(x); }
__device__ __forceinline__ float fexp(float x) { return __builtin_amdgcn_exp2f(x * LOG2E); }
__device__ __forceinline__ float frcp(float x) { return __builtin_amdgcn_rcpf(x); }
__device__ __forceinline__ float silu(float x) { return x * frcp(1.f + fexp(-x)); }
__device__ __forceinline__ float sigm(float x) { return frcp(1.f + fexp(-x)); }
__device__ __forceinline__ float logsigmoid(float x) { return fminf(x, 0.f) - log1pf(expf(-fabsf(x))); }
__device__ __forceinline__ int crow(int reg, int h) { return (reg & 3) + 8 * (reg >> 2) + 4 * h; }
__device__ __forceinline__ float shx(float v, int mask, int lane) { return __int_as_float(__builtin_amdgcn_ds_bpermute((lane ^ mask) << 2, __float_as_int(v))); }
__device__ __forceinline__ float shi(float v, int src) { return __int_as_float(__builtin_amdgcn_ds_bpermute(src << 2, __float_as_int(v))); }
__device__ __forceinline__ float wave_sum(float v, int lane) {
#pragma unroll
    for (int o = 1; o < 64; o <<= 1) v += shx(v, o, lane);
    return v;
}
__device__ __forceinline__ float wave_max(float v, int lane) {
#pragma unroll
    for (int o = 1; o < 64; o <<= 1) v = fmaxf(v, shx(v, o, lane));
    return v;
}
__device__ __forceinline__ float scan_sum_up(float v, int lane) {
#pragma unroll
    for (int o = 1; o < 64; o <<= 1) { const float t = shi(v, lane - o); if (lane >= o) v += t; }
    return v;
}
__device__ __forceinline__ float scan_sum_down(float v, int lane) {
#pragma unroll
    for (int o = 1; o < 64; o <<= 1) { const float t = shi(v, lane + o); if (lane + o < 64) v += t; }
    return v;
}
__device__ __forceinline__ float scan_max_up(float v, int lane) {
#pragma unroll
    for (int o = 1; o < 64; o <<= 1) { const float t = shi(v, lane - o); if (lane >= o) v = fmaxf(v, t); }
    return v;
}
__device__ __forceinline__ float scan_max_down(float v, int lane) {
#pragma unroll
    for (int o = 1; o < 64; o <<= 1) { const float t = shi(v, lane + o); if (lane + o < 64) v = fmaxf(v, t); }
    return v;
}
__device__ __forceinline__ int t5_bucket(int rel) {
    const int n = rel < 0 ? -rel : rel; const int ret = rel > 0 ? 16 : 0;
    const int large = 8 + (n >= 12) + (n >= 16) + (n >= 23) + (n >= 32) + (n >= 46) + (n >= 64) + (n >= 91);
    return ret + (n < 8 ? n : large);
}
#define PIN16(a) asm volatile("" : "+v"(a[0]), "+v"(a[1]), "+v"(a[2]), "+v"(a[3]), "+v"(a[4]), "+v"(a[5]), "+v"(a[6]), "+v"(a[7]), "+v"(a[8]), "+v"(a[9]), "+v"(a[10]), "+v"(a[11]), "+v"(a[12]), "+v"(a[13]), "+v"(a[14]), "+v"(a[15]))
#define MFMA32(a, b, c) __builtin_amdgcn_mfma_f32_32x32x16_bf16((a), (b), (c), 0, 0, 0)
__device__ __forceinline__ bf16x8 pack8(const f32x16& x, int s) {
    u32x4 p; p.x = cvt_pk_bf16(x[8 * s], x[8 * s + 1]); p.y = cvt_pk_bf16(x[8 * s + 2], x[8 * s + 3]); p.z = cvt_pk_bf16(x[8 * s + 4], x[8 * s + 5]); p.w = cvt_pk_bf16(x[8 * s + 6], x[8 * s + 7]);
    return __builtin_bit_cast(bf16x8, p);
}
__device__ __forceinline__ f32x16 zero16() { f32x16 z;
#pragma unroll
    for (int i = 0; i < 16; ++i) z[i] = 0.f; return z; }

namespace pg8 {
constexpr int BM = 256, BK = 64, HALF = 128, HTB = HALF * BK * 2, STAGE_BYTES = 8 * HTB, NXCD = 8, WGM = 4;
__device__ __forceinline__ int lds_byte(int r, int c) { const int st = (r >> 4) * 2 + (c >> 5), rr = r & 15, cc = c & 31, ob = rr * 64 + cc * 2; return st * 1024 + (ob ^ (((ob >> 9) & 1) << 5)); }
__device__ __forceinline__ void stage_rc(int b, int& R, int& C) { const int st = b / 1024, sb = b % 1024, swz = sb ^ (((sb >> 9) & 1) << 5); R = (st >> 1) * 16 + swz / 64; C = (st & 1) * 32 + (swz % 64) / 2; }
__device__ __forceinline__ int perm32(int rho) { const int n = rho >> 4, i = rho & 15; return 8 * (i >> 2) + 4 * n + (i & 3); }

struct Unit { const char* a; const char* b; int pm, pn, kind; };

__device__ __forceinline__ bool tile_of(int i, int G, int c, int nM, int nN, int& pm, int& pn) {
    const int nwg = nM * nN; const long L = (long)i * G + c; if (L >= nwg) return false;
    int wgid = (int)L; { const int q = nwg / NXCD, r = nwg % NXCD, xcd = wgid % NXCD, off = wgid / NXCD; wgid = (xcd < r ? xcd * (q + 1) : r * (q + 1) + (xcd - r) * q) + off; }
    const int nig = WGM * nN, gid = wgid / nig, fm = gid * WGM, gsz = (nM - fm) < WGM ? (nM - fm) : WGM;
    pm = fm + ((wgid % nig) % gsz); pn = (wgid % nig) / gsz; return true;
}
constexpr size_t TSTEP = (size_t)256 * 2048 * 2;
struct Sched1 {
    const char* X; const char* W; int G, c;
    __device__ __forceinline__ bool next(int i, Unit& u) const {
        int pm, pn;
        if (G == 256) {
            if (i >= 8) return false;
            const int x = c & 7, k = c >> 3, j = i;
            if (i == 7) { if (c >= 128) return false; pm = 8 * x + (k & 7); pn = 28 + (k >> 3); }
            else if (j < 4) { pm = 16 * j + 4 * (x & 3) + (k & 3); pn = 8 * (x >> 2) + (k >> 2); }
            else if (j < 6) { pm = 32 * (j - 4) + 8 * (x & 3) + (k & 7); pn = 16 + 4 * (x >> 2) + (k >> 3); }
            else { pm = 8 * x + (k & 7); pn = 24 + (k >> 3); }
            if (pn >= 25) pn += 2;
        } else if (!tile_of(i, G, c, 64, 32, pm, pn)) return false;
        u.pm = pm; u.pn = pn;
        if (pn < 24) { u.kind = 0; u.a = X + (size_t)pm * TSTEP; u.b = W + (size_t)pn * TSTEP; }
        else { u.kind = 1; u.a = W + (size_t)pn * TSTEP; u.b = X + (size_t)pm * TSTEP; }
        return true;
    }
};
struct Sched2 {
    const char* Y; const char* W; int G, c;
    __device__ __forceinline__ bool next(int i, Unit& u) const {
        int pm, pn; if (!tile_of(i, G, c, 64, 8, pm, pn)) return false;
        u.pm = pm; u.pn = pn; u.kind = 2; u.a = Y + (size_t)pm * TSTEP; u.b = W + (size_t)pn * TSTEP; return true;
    }
};

struct Epi1 {
    static constexpr bool PERM = true;
    bf16* Unat; bf16* Ut; const float* bias;
    __device__ __forceinline__ void operator()(const f32x4 (&acc)[2][2][4][2], const Unit& u, int wr, int wc, int fr, int fq) const {
        if (u.kind == 0) {
            const int row0 = u.pm * BM + wr * 64 + fr, col0 = u.pn * BM + wc * 32 + 8 * fq;
            f32x4 bv[2][2];
#pragma unroll
            for (int bj = 0; bj < 2; ++bj)
#pragma unroll
                for (int n = 0; n < 2; ++n) bv[bj][n] = *(const f32x4*)(bias + col0 + bj * HALF + 4 * n);
#pragma unroll
            for (int ai = 0; ai < 2; ++ai)
#pragma unroll
                for (int m = 0; m < 4; ++m) { bf16* rowp = Unat + (size_t)(row0 + ai * HALF + m * 16) * LDN + col0;
#pragma unroll
                    for (int bj = 0; bj < 2; ++bj) { const f32x4 v0 = acc[ai][bj][m][0] + bv[bj][0], v1 = acc[ai][bj][m][1] + bv[bj][1];
                        u32x4 w; w.x = cvt_pk_bf16(v0[0], v0[1]); w.y = cvt_pk_bf16(v0[2], v0[3]); w.z = cvt_pk_bf16(v1[0], v1[1]); w.w = cvt_pk_bf16(v1[2], v1[3]);
                        *(u32x4*)(rowp + bj * HALF) = w; } }
        } else {
            const int nrow0 = (u.pn - 24) * BM + wr * 64 + fr, tok0 = u.pm * BM + wc * 32 + 8 * fq;
#pragma unroll
            for (int ai = 0; ai < 2; ++ai)
#pragma unroll
                for (int m = 0; m < 4; ++m) { const int nr = nrow0 + ai * HALF + m * 16; const float bs = bias[6144 + nr]; bf16* rowp = Ut + (size_t)nr * M + tok0;
#pragma unroll
                    for (int bj = 0; bj < 2; ++bj) { const f32x4 v0 = acc[ai][bj][m][0] + bs, v1 = acc[ai][bj][m][1] + bs;
                        u32x4 w; w.x = cvt_pk_bf16(v0[0], v0[1]); w.y = cvt_pk_bf16(v0[2], v0[3]); w.z = cvt_pk_bf16(v1[0], v1[1]); w.w = cvt_pk_bf16(v1[2], v1[3]);
                        *(u32x4*)(rowp + bj * HALF) = w; } }
        }
    }
};
template <int L> struct Epi2 {
    static constexpr bool PERM = true;
    float* Tf; bf16* Tb; const float* bias; const float* srcf; const bf16* srcb; const float* stat; const float* gam; const float* bet; bf16* Tb_hi;
    __device__ __forceinline__ void operator()(const f32x4 (&acc)[2][2][4][2], const Unit& u, int wr, int wc, int fr, int fq) const {
        const int row0 = u.pm * BM + wr * 64 + fr, col0 = u.pn * BM + wc * 32 + 8 * fq;
        bf16* const Tbu = (Tb_hi && u.pm >= 32) ? Tb_hi - (size_t)8192 * DM : Tb;
        float mean[2][4], rs[2][4];
#pragma unroll
        for (int ai = 0; ai < 2; ++ai)
#pragma unroll
            for (int m = 0; m < 4; ++m) { mean[ai][m] = 0.f; rs[ai][m] = 0.f; }
#pragma unroll
        for (int bj = 0; bj < 2; ++bj) { const int c = col0 + bj * HALF;
            f32x4 g0 = {0.f, 0.f, 0.f, 0.f}, g1 = g0, b0 = *(const f32x4*)(bias + c), b1 = *(const f32x4*)(bias + c + 4);
#pragma unroll
            for (int ai = 0; ai < 2; ++ai)
#pragma unroll
                for (int m = 0; m < 4; ++m) { const size_t off = (size_t)(row0 + ai * HALF + m * 16) * DM + c;
                    f32x4 t0, t1;
                    if (L == 0) { const u32x4 hv = *(const u32x4*)(srcb + off);
                        const f32x4 o0 = {bflo(hv.x), bfhi(hv.x), bflo(hv.y), bfhi(hv.y)}, o1 = {bflo(hv.z), bfhi(hv.z), bflo(hv.w), bfhi(hv.w)};
                        t0 = o0 * ALPHA + b0 + acc[ai][bj][m][0]; t1 = o1 * ALPHA + b1 + acc[ai][bj][m][1]; }
                    else { t0 = acc[ai][bj][m][0] + b0; t1 = acc[ai][bj][m][1] + b1; }
                    u32x4 w; w.x = cvt_pk_bf16(t0[0], t0[1]); w.y = cvt_pk_bf16(t0[2], t0[3]); w.z = cvt_pk_bf16(t1[0], t1[1]); w.w = cvt_pk_bf16(t1[2], t1[3]); *(u32x4*)(Tbu + off) = w; } }
    }
};

template <class Epi, class Sched, bool ALIGN_EPI, bool SP2>
__device__ __forceinline__ void gemm_phase(LAS unsigned char* lds, const Sched& S, const Epi& E, const int tid) {
    const int wid = __builtin_amdgcn_readfirstlane(tid >> 6), lane = tid & 63, wr = wid >> 2, wc = wid & 3, fr = lane & 15, fq = lane >> 4;
    constexpr int K = 2048, nt = K / BK;
    unsigned voffA[2], voffB[2];
#pragma unroll
    for (int i = 0; i < 2; ++i) { int R, C; stage_rc(tid * 16 + i * 8192, R, C); const int Rb = Epi::PERM ? ((R & ~31) + perm32(R & 31)) : R;
        voffA[i] = (unsigned)(R * K + C) * 2u; voffB[i] = (unsigned)(Rb * K + C) * 2u; }
    const size_t kstep = (size_t)(BK * 2);
    const size_t hstep = (size_t)HALF * K * 2;
    const unsigned ldsw = (unsigned)wid * 1024u;
    const int aoff = lds_byte(wr * 64 + fr, fq * 8), boff = lds_byte(wc * 32 + fr, fq * 8);
#define PG8_SA(b, h) (((b) * 2 + (h)) * HTB)
#define PG8_SB(b, h) ((4 + (b) * 2 + (h)) * HTB)
#define PG8_STAGE(bufoff, gbase, voff) do { _Pragma("unroll") for (int _i = 0; _i < 2; ++_i) \
        __builtin_amdgcn_global_load_lds((const unsigned*)((const char*)(gbase) + (voff)[_i]), (LAS unsigned*)(lds + (bufoff) + ldsw + _i * 8192), 16, 0, 0); } while (0)
#define PG8_LDA(dst, b, h) do { _Pragma("unroll") for (int m = 0; m < 4; ++m) _Pragma("unroll") for (int k = 0; k < 2; ++k) dst[m][k] = *(const LAS bf16x8*)(lds + PG8_SA(b, h) + aoff + m * 2048 + k * 1024); } while (0)
#define PG8_LDB(dst, b, h) do { _Pragma("unroll") for (int n = 0; n < 2; ++n) _Pragma("unroll") for (int k = 0; k < 2; ++k) dst[n][k] = *(const LAS bf16x8*)(lds + PG8_SB(b, h) + boff + n * 2048 + k * 1024); } while (0)
#define PG8_MMA(ai, bj, At, Bt) do { __builtin_amdgcn_s_setprio(1); _Pragma("unroll") for (int m = 0; m < 4; ++m) _Pragma("unroll") for (int n = 0; n < 2; ++n) _Pragma("unroll") for (int k = 0; k < 2; ++k) \
        acc[ai][bj][m][n] = __builtin_amdgcn_mfma_f32_16x16x32_bf16(Bt[n][k], At[m][k], acc[ai][bj][m][n], 0, 0, 0); __builtin_amdgcn_s_setprio(0); } while (0)
#define PG8_WAIT_V(n) asm volatile("s_waitcnt vmcnt(" #n ")" ::: "memory")
#define PG8_WAIT_L(n) asm volatile("s_waitcnt lgkmcnt(" #n ")" ::: "memory")
#define PG8_BAR __builtin_amdgcn_s_barrier()
#define PG8_SCHED __builtin_amdgcn_sched_barrier(0)
    Unit cur, nxt; int ui = 0;
    if (!S.next(0, cur)) return;
    f32x4 acc[2][2][4][2];
#pragma unroll
    for (int a = 0; a < 2; ++a)
#pragma unroll
        for (int b = 0; b < 2; ++b)
#pragma unroll
            for (int m = 0; m < 4; ++m)
#pragma unroll
                for (int n = 0; n < 2; ++n) acc[a][b][m][n] = (f32x4){0.f, 0.f, 0.f, 0.f};
    bf16x8 At[4][2], B0[2][2], B1[2][2];
    const char* cA = cur.a; const char* cB = cur.b;
    if constexpr (SP2) {
        PG8_STAGE(PG8_SB(0, 0), cB, voffB); PG8_STAGE(PG8_SB(0, 1), cB + hstep, voffB); PG8_STAGE(PG8_SA(0, 0), cA, voffA); PG8_STAGE(PG8_SA(0, 1), cA + hstep, voffA);
        if (wr == 1) PG8_BAR;
        PG8_WAIT_V(2); PG8_BAR;
        PG8_STAGE(PG8_SB(1, 0), cB + kstep, voffB); PG8_STAGE(PG8_SA(1, 0), cA + kstep, voffA); PG8_STAGE(PG8_SB(1, 1), cB + hstep + kstep, voffB);
        PG8_WAIT_V(6); PG8_BAR;
    } else {
        PG8_STAGE(PG8_SB(0, 0), cB, voffB); PG8_STAGE(PG8_SA(0, 0), cA, voffA); PG8_STAGE(PG8_SB(0, 1), cB + hstep, voffB); PG8_STAGE(PG8_SA(0, 1), cA + hstep, voffA);
        if (wr == 1) PG8_BAR;
        PG8_WAIT_V(4); PG8_BAR;
        PG8_STAGE(PG8_SB(1, 0), cB + kstep, voffB); PG8_STAGE(PG8_SA(1, 0), cA + kstep, voffA); PG8_STAGE(PG8_SB(1, 1), cB + hstep + kstep, voffB);
        PG8_WAIT_V(6); PG8_BAR;
    }
    for (;;) {
        const bool has_next = S.next(ui + 1, nxt);
        const char* nA = has_next ? nxt.a : cA; const char* nB = has_next ? nxt.b : cB;
        for (int t = 0; t < nt; t += 2) {
            const bool last = (t == nt - 2);
            const char* a1 = cA + (size_t)(t + 1) * kstep;
            const char* a2 = last ? nA : cA + (size_t)(t + 2) * kstep; const char* b2 = last ? nB : cB + (size_t)(t + 2) * kstep;
            const char* a3 = a2 + kstep; const char* b3 = b2 + kstep;
            if constexpr (SP2) {
            PG8_LDB(B0, 0, 0); PG8_LDB(B1, 0, 1); PG8_SCHED; PG8_LDA(At, 0, 0); PG8_STAGE(PG8_SA(1, 1), a1 + hstep, voffA);
            PG8_WAIT_V(8); PG8_WAIT_L(0); PG8_BAR; PG8_MMA(0, 0, At, B0); PG8_MMA(0, 1, At, B1); PG8_BAR; PG8_SCHED;
            PG8_LDA(At, 0, 1); PG8_STAGE(PG8_SB(0, 0), b2, voffB); PG8_STAGE(PG8_SB(0, 1), b2 + hstep, voffB); PG8_STAGE(PG8_SA(0, 0), a2, voffA);
            PG8_WAIT_V(8); PG8_WAIT_L(0); PG8_BAR; PG8_MMA(1, 0, At, B0); PG8_MMA(1, 1, At, B1); PG8_BAR; PG8_SCHED;
            PG8_LDB(B0, 1, 0); PG8_LDB(B1, 1, 1); PG8_SCHED; PG8_LDA(At, 1, 0); PG8_STAGE(PG8_SA(0, 1), a2 + hstep, voffA);
            PG8_WAIT_V(8); PG8_WAIT_L(0); PG8_BAR; PG8_MMA(0, 0, At, B0); PG8_MMA(0, 1, At, B1); PG8_BAR; PG8_SCHED;
            PG8_LDA(At, 1, 1); PG8_STAGE(PG8_SB(1, 0), b3, voffB); PG8_STAGE(PG8_SB(1, 1), b3 + hstep, voffB); PG8_STAGE(PG8_SA(1, 0), a3, voffA);
            PG8_WAIT_V(8); PG8_WAIT_L(0); PG8_BAR; PG8_MMA(1, 0, At, B0); PG8_MMA(1, 1, At, B1); PG8_BAR; PG8_SCHED;
            } else {
            PG8_LDB(B0, 0, 0); PG8_SCHED; PG8_LDA(At, 0, 0); PG8_STAGE(PG8_SA(1, 1), a1 + hstep, voffA);
            PG8_WAIT_L(8); PG8_BAR; PG8_WAIT_L(0); PG8_MMA(0, 0, At, B0); PG8_BAR; PG8_SCHED;
            PG8_LDB(B1, 0, 1); PG8_STAGE(PG8_SB(0, 0), b2, voffB);
            PG8_BAR; PG8_WAIT_L(0); PG8_MMA(0, 1, At, B1); PG8_BAR;
            PG8_LDA(At, 0, 1); PG8_STAGE(PG8_SA(0, 0), a2, voffA);
            PG8_BAR; PG8_WAIT_L(0); PG8_MMA(1, 0, At, B0); PG8_BAR; PG8_SCHED;
            PG8_STAGE(PG8_SB(0, 1), b2 + hstep, voffB);
            PG8_WAIT_V(6); PG8_BAR; PG8_MMA(1, 1, At, B1); PG8_BAR;
            PG8_LDB(B0, 1, 0); PG8_SCHED; PG8_LDA(At, 1, 0); PG8_STAGE(PG8_SA(0, 1), a2 + hstep, voffA);
            PG8_WAIT_L(8); PG8_BAR; PG8_WAIT_L(0); PG8_MMA(0, 0, At, B0); PG8_BAR; PG8_SCHED;
            PG8_LDB(B1, 1, 1); PG8_STAGE(PG8_SB(1, 0), b3, voffB);
            PG8_BAR; PG8_WAIT_L(0); PG8_MMA(0, 1, At, B1); PG8_BAR;
            PG8_LDA(At, 1, 1); PG8_STAGE(PG8_SA(1, 0), a3, voffA);
            PG8_BAR; PG8_WAIT_L(0); PG8_MMA(1, 0, At, B0); PG8_BAR; PG8_SCHED;
            PG8_STAGE(PG8_SB(1, 1), b3 + hstep, voffB);
            PG8_WAIT_V(6); PG8_BAR; PG8_MMA(1, 1, At, B1); PG8_BAR;
            }
        }
        if constexpr (ALIGN_EPI) { if (wr == 0) PG8_BAR; }
        int fr_ = fr, fq_ = fq; asm volatile("" : "+v"(fr_), "+v"(fq_));
        E(acc, cur, wr, wc, fr_, fq_);
        if (!has_next) break;
#pragma unroll
        for (int a = 0; a < 2; ++a)
#pragma unroll
            for (int b = 0; b < 2; ++b)
#pragma unroll
                for (int m = 0; m < 4; ++m)
#pragma unroll
                    for (int n = 0; n < 2; ++n) acc[a][b][m][n] = (f32x4){0.f, 0.f, 0.f, 0.f};
        cur = nxt; cA = nA; cB = nB; ++ui;
        if constexpr (ALIGN_EPI) { if (wr == 1) PG8_BAR; }
    }
    PG8_WAIT_V(0);
    if constexpr (!ALIGN_EPI) { if (wr == 0) PG8_BAR; }
    PG8_BAR;
#undef PG8_SA
#undef PG8_SB
#undef PG8_STAGE
#undef PG8_LDA
#undef PG8_LDB
#undef PG8_MMA
#undef PG8_WAIT_V
#undef PG8_WAIT_L
#undef PG8_BAR
#undef PG8_SCHED
}
}

#define XB_TMO      128
#define XB_XCNT(j)  (256  + 64 * (j))
#define XB_XSUB(j)  (1280 + 64 * (j))
#define XB_XGEN(j)  (2304 + 64 * (j))
#define XB_TOP      3328
#define XB_TOPGEN   3392
#define XCD_BAR_WORDS 3456
#define XB_SPIN_CAP (1u << 22)
__device__ __forceinline__ unsigned xb_ld(unsigned* p)              { return __hip_atomic_load(p, __ATOMIC_RELAXED, __HIP_MEMORY_SCOPE_AGENT); }
__device__ __forceinline__ unsigned xb_add(unsigned* p, unsigned v) { return __hip_atomic_fetch_add(p, v, __ATOMIC_RELAXED, __HIP_MEMORY_SCOPE_AGENT); }
__device__ __forceinline__ unsigned xb_xcc_id() { return (unsigned)__builtin_amdgcn_s_getreg((3 << 11) | 20) & 0xFu; }
#define XB_SPIN(cond, bar) do { unsigned _sp = 0; while (cond) { __builtin_amdgcn_s_sleep(1); \
    if ((++_sp & 255u) == 0u) { if (xb_ld(&(bar)[XB_TMO])) break; if (_sp > XB_SPIN_CAP) { atomicAdd(&(bar)[XB_TMO], 1u); break; } } } } while (0)
struct XcdBarrier { unsigned* bar; unsigned x; volatile LAS unsigned* st; };
__device__ __forceinline__ XcdBarrier xcd_barrier_post(unsigned* bar, volatile LAS unsigned* st, int tid) {
    XcdBarrier b; b.bar = bar; b.x = xb_xcc_id(); b.st = st;
    if (tid == 0) (void)xb_add(&bar[XB_XCNT(b.x)], 1u);
    return b;
}
__device__ __forceinline__ void xcd_barrier_complete(unsigned* bar, unsigned x, unsigned& nloc, unsigned& nx) {
    const unsigned G = gridDim.x * gridDim.y * gridDim.z;
    unsigned sum, cnt, mine, sp = 0u;
    for (;;) {
        sum = 0u; cnt = 0u; mine = 0u;
#pragma unroll
        for (unsigned j = 0; j < 16; ++j) { const unsigned c = xb_ld(&bar[XB_XCNT(j)]); sum += c; cnt += (c > 0u) ? 1u : 0u; mine = (j == x) ? c : mine; }
        if (sum == G) break;
        __builtin_amdgcn_s_sleep(1);
        if ((++sp & 255u) == 0u) { if (xb_ld(&bar[XB_TMO])) break; if (sp > XB_SPIN_CAP) { atomicAdd(&bar[XB_TMO], 1u); break; } }
    }
    nloc = mine > 0u ? mine : 1u; nx = cnt > 0u ? cnt : 1u;
}
__device__ __forceinline__ void xcd_barrier(const XcdBarrier& b, int tid) {
    asm volatile("s_waitcnt vmcnt(0)" ::: "memory");
    __syncthreads();
    if (tid == 0) {
        unsigned* bar = b.bar; asm volatile("" : "+s"(bar));
        __builtin_amdgcn_s_waitcnt(0);
        unsigned nloc = b.st[0], nx = b.st[1];
        if (nloc == 0u) { xcd_barrier_complete(bar, b.x, nloc, nx); b.st[0] = nloc; b.st[1] = nx; }
        const unsigned old = xb_add(&bar[XB_XSUB(b.x)], 1u);
        const unsigned gen = old / nloc;
        if (old + 1u == (gen + 1u) * nloc) {
            __builtin_amdgcn_fence(__ATOMIC_RELEASE, "agent");
            asm volatile("s_waitcnt vmcnt(0)" ::: "memory");
            const unsigned og = xb_add(&bar[XB_TOP], 1u);
            const unsigned tg = og / nx;
            if (og + 1u == (tg + 1u) * nx) xb_add(&bar[XB_TOPGEN], 1u);
            else XB_SPIN(xb_ld(&bar[XB_TOPGEN]) == tg, bar);
            __builtin_amdgcn_fence(__ATOMIC_ACQUIRE, "agent");
            xb_add(&bar[XB_XGEN(b.x)], 1u);
            asm volatile("s_waitcnt vmcnt(0)" ::: "memory");
        } else {
            XB_SPIN(xb_ld(&bar[XB_XGEN(b.x)]) == gen, bar);
            __builtin_amdgcn_fence(__ATOMIC_ACQUIRE, "agent");
            asm volatile("s_waitcnt vmcnt(0)" ::: "memory");
        }
    }
    __syncthreads();
}

struct Args { const float* in[14]; float* out; unsigned char* ws; int ph_lo, ph_hi; };

struct Ctx {
    LAS unsigned char* lds; int tid, lane, wave, G, bid;
    const float *x, *emb_g, *emb_b, *w_in, *b_in, *w_out, *b_out, *ln_g, *ln_b, *t5, *sink, *fbias, *norm_g, *rpb;
    float* out; unsigned char* ws;
    bf16* hby; bf16* yb; bf16* unat; bf16* ut; bf16* cst; float* nst; float* gs; float* ml; float* mprev; float* gate; float* stat;
};

__device__ __forceinline__ int src_col_of_row(int r) {
    if (r < 768) return r;
    if (r < 1024) return r - 768 + 768;
    if (r < 1792) return r - 1024 + 1280;
    if (r < 2304) return r - 1792 + 2048;
    if (r < 2816) return r - 2304 + 2560;
    if (r < 3328) return r - 2816 + 3584;
    if (r < 3840) return r - 3328 + 4096;
    if (r < 4608) return r - 3840 + 4624;
    if (r < 5376) return r - 4608 + 5392;
    if (r < 6144) return r - 5376 + 6928;
    if (r < 6400) return r - 6144 + 1024;
    if (r < 6912) return r - 6400 + 2560;
    if (r < 7424) return r - 6912 + 3072;
    if (r < 8192) return r - 7424 + 6160;
    return r - 8192 + 4608;
}
__device__ __forceinline__ void ln_row(const float* xrow, float* orow, bf16* brow, float* stat, const float* g, const float* b, int lane) {
    f32x4 v[8]; float s = 0.f;
#pragma unroll
    for (int j = 0; j < 8; ++j) { v[j] = *(const f32x4*)(xrow + 4 * (lane + 64 * j)); s += (v[j][0] + v[j][1]) + (v[j][2] + v[j][3]); }
    const float mean = wave_sum(s, lane) * (1.f / DM); float q = 0.f;
#pragma unroll
    for (int j = 0; j < 8; ++j) { v[j] = v[j] - mean; q += (v[j][0] * v[j][0] + v[j][1] * v[j][1]) + (v[j][2] * v[j][2] + v[j][3] * v[j][3]); }
    const float rstd = 1.f / sqrtf(wave_sum(q, lane) * (1.f / DM) + LN_EPS);
    if (stat && lane == 0) { stat[0] = mean; stat[1] = rstd; }
#pragma unroll
    for (int j = 0; j < 8; ++j) { const int c = 4 * (lane + 64 * j); const f32x4 gg = *(const f32x4*)(g + c), bb = *(const f32x4*)(b + c);
        const f32x4 o = v[j] * rstd * gg + bb;
        if (orow) *(f32x4*)(orow + c) = o;
        if (brow) { u32x2 w; w.x = cvt_pk_bf16(o[0], o[1]); w.y = cvt_pk_bf16(o[2], o[3]); *(u32x2*)(brow + c) = w; } }
}

__device__ __forceinline__ void ln_row2(const float* x0, const float* x1, float* o0, float* o1, bf16* b0, bf16* b1, float* st0, float* st1, const float* g, const float* b, int lane) {
    f32x4 v[8], u[8]; float s = 0.f, s_ = 0.f;
#pragma unroll
    for (int j = 0; j < 8; ++j) { v[j] = *(const f32x4*)(x0 + 4 * (lane + 64 * j)); u[j] = *(const f32x4*)(x1 + 4 * (lane + 64 * j)); }
#pragma unroll
    for (int j = 0; j < 8; ++j) { s += (v[j][0] + v[j][1]) + (v[j][2] + v[j][3]); s_ += (u[j][0] + u[j][1]) + (u[j][2] + u[j][3]); }
#pragma unroll
    for (int o = 1; o < 64; o <<= 1) { s += shx(s, o, lane); s_ += shx(s_, o, lane); }
    const float mean = s * (1.f / DM), mean_ = s_ * (1.f / DM); float q = 0.f, q_ = 0.f;
#pragma unroll
    for (int j = 0; j < 8; ++j) { v[j] = v[j] - mean; u[j] = u[j] - mean_; q += (v[j][0] * v[j][0] + v[j][1] * v[j][1]) + (v[j][2] * v[j][2] + v[j][3] * v[j][3]); q_ += (u[j][0] * u[j][0] + u[j][1] * u[j][1]) + (u[j][2] * u[j][2] + u[j][3] * u[j][3]); }
#pragma unroll
    for (int o = 1; o < 64; o <<= 1) { q += shx(q, o, lane); q_ += shx(q_, o, lane); }
    const float rstd = 1.f / sqrtf(q * (1.f / DM) + LN_EPS), rstd_ = 1.f / sqrtf(q_ * (1.f / DM) + LN_EPS);
    if (st0 && lane == 0) { st0[0] = mean; st0[1] = rstd; st1[0] = mean_; st1[1] = rstd_; }
#pragma unroll
    for (int j = 0; j < 8; ++j) { const int c = 4 * (lane + 64 * j); const f32x4 gg = *(const f32x4*)(g + c), bb = *(const f32x4*)(b + c);
        const f32x4 o = v[j] * rstd * gg + bb, p = u[j] * rstd_ * gg + bb;
        if (o0) { *(f32x4*)(o0 + c) = o; *(f32x4*)(o1 + c) = p; }
        if (b0) { u32x2 w; w.x = cvt_pk_bf16(o[0], o[1]); w.y = cvt_pk_bf16(o[2], o[3]); *(u32x2*)(b0 + c) = w; u32x2 w2; w2.x = cvt_pk_bf16(p[0], p[1]); w2.y = cvt_pk_bf16(p[2], p[3]); *(u32x2*)(b1 + c) = w2; } }
}

__device__ __forceinline__ void ln_row2_b(const bf16* x0, const bf16* x1, bf16* b0, bf16* b1, float* st0, float* st1, const float* g, const float* b, int lane) {
    f32x4 v[8], u[8]; float s = 0.f, s_ = 0.f;
#pragma unroll
    for (int j = 0; j < 4; ++j) { const u32x4 p = *(const u32x4*)(x0 + 8 * (lane + 64 * j)), q = *(const u32x4*)(x1 + 8 * (lane + 64 * j));
        v[2 * j] = (f32x4){bflo(p.x), bfhi(p.x), bflo(p.y), bfhi(p.y)}; v[2 * j + 1] = (f32x4){bflo(p.z), bfhi(p.z), bflo(p.w), bfhi(p.w)};
        u[2 * j] = (f32x4){bflo(q.x), bfhi(q.x), bflo(q.y), bfhi(q.y)}; u[2 * j + 1] = (f32x4){bflo(q.z), bfhi(q.z), bflo(q.w), bfhi(q.w)}; }
#pragma unroll
    for (int j = 0; j < 8; ++j) { s += (v[j][0] + v[j][1]) + (v[j][2] + v[j][3]); s_ += (u[j][0] + u[j][1]) + (u[j][2] + u[j][3]); }
#pragma unroll
    for (int o = 1; o < 64; o <<= 1) { s += shx(s, o, lane); s_ += shx(s_, o, lane); }
    const float mean = s * (1.f / DM), mean_ = s_ * (1.f / DM); float q = 0.f, q_ = 0.f;
#pragma unroll
    for (int j = 0; j < 8; ++j) { v[j] = v[j] - mean; u[j] = u[j] - mean_; q += (v[j][0] * v[j][0] + v[j][1] * v[j][1]) + (v[j][2] * v[j][2] + v[j][3] * v[j][3]); q_ += (u[j][0] * u[j][0] + u[j][1] * u[j][1]) + (u[j][2] * u[j][2] + u[j][3] * u[j][3]); }
#pragma unroll
    for (int o = 1; o < 64; o <<= 1) { q += shx(q, o, lane); q_ += shx(q_, o, lane); }
    const float rstd = 1.f / sqrtf(q * (1.f / DM) + LN_EPS), rstd_ = 1.f / sqrtf(q_ * (1.f / DM) + LN_EPS);
    if (lane == 0) { st0[0] = mean; st0[1] = rstd; st1[0] = mean_; st1[1] = rstd_; }
#pragma unroll
    for (int j = 0; j < 4; ++j) { const int c = 8 * (lane + 64 * j);
        const f32x4 g0 = *(const f32x4*)(g + c), g1 = *(const f32x4*)(g + c + 4), bb0 = *(const f32x4*)(b + c), bb1 = *(const f32x4*)(b + c + 4);
        const f32x4 o0 = v[2 * j] * rstd * g0 + bb0, o1 = v[2 * j + 1] * rstd * g1 + bb1, p0 = u[2 * j] * rstd_ * g0 + bb0, p1 = u[2 * j + 1] * rstd_ * g1 + bb1;
        u32x4 w; w.x = cvt_pk_bf16(o0[0], o0[1]); w.y = cvt_pk_bf16(o0[2], o0[3]); w.z = cvt_pk_bf16(o1[0], o1[1]); w.w = cvt_pk_bf16(o1[2], o1[3]); *(u32x4*)(b0 + c) = w;
        u32x4 w2; w2.x = cvt_pk_bf16(p0[0], p0[1]); w2.y = cvt_pk_bf16(p0[2], p0[3]); w2.z = cvt_pk_bf16(p1[0], p1[1]); w2.w = cvt_pk_bf16(p1[2], p1[3]); *(u32x4*)(b1 + c) = w2; }
}

__device__ __forceinline__ void fin_row2(const bf16* t1, const bf16* o2, const float* st, const float* g0, const float* b0, const float* g1, const float* b1, float* out, int lane) {
    f32x4 v[8], u[8]; float s = 0.f, s_ = 0.f;
    const float mA = st[0], rA = st[1] * ALPHA, mB = st[2], rB = st[3] * ALPHA;
#pragma unroll
    for (int j = 0; j < 4; ++j) { const int c = 8 * (lane + 64 * j);
        const u32x4 p = *(const u32x4*)(t1 + c), q = *(const u32x4*)(t1 + DM + c), x = *(const u32x4*)(o2 + c), y = *(const u32x4*)(o2 + DM + c);
        const f32x4 ga = *(const f32x4*)(g0 + c), gb = *(const f32x4*)(g0 + c + 4), ba = *(const f32x4*)(b0 + c) * ALPHA, bb = *(const f32x4*)(b0 + c + 4) * ALPHA;
        v[2 * j] = ((f32x4){bflo(p.x), bfhi(p.x), bflo(p.y), bfhi(p.y)} - mA) * rA * ga + ba + (f32x4){bflo(x.x), bfhi(x.x), bflo(x.y), bfhi(x.y)};
        v[2 * j + 1] = ((f32x4){bflo(p.z), bfhi(p.z), bflo(p.w), bfhi(p.w)} - mA) * rA * gb + bb + (f32x4){bflo(x.z), bfhi(x.z), bflo(x.w), bfhi(x.w)};
        u[2 * j] = ((f32x4){bflo(q.x), bfhi(q.x), bflo(q.y), bfhi(q.y)} - mB) * rB * ga + ba + (f32x4){bflo(y.x), bfhi(y.x), bflo(y.y), bfhi(y.y)};
        u[2 * j + 1] = ((f32x4){bflo(q.z), bfhi(q.z), bflo(q.w), bfhi(q.w)} - mB) * rB * gb + bb + (f32x4){bflo(y.z), bfhi(y.z), bflo(y.w), bfhi(y.w)}; }
#pragma unroll
    for (int j = 0; j < 8; ++j) { s += (v[j][0] + v[j][1]) + (v[j][2] + v[j][3]); s_ += (u[j][0] + u[j][1]) + (u[j][2] + u[j][3]); }
#pragma unroll
    for (int o = 1; o < 64; o <<= 1) { s += shx(s, o, lane); s_ += shx(s_, o, lane); }
    const float mean = s * (1.f / DM), mean_ = s_ * (1.f / DM); float q2 = 0.f, q2_ = 0.f;
#pragma unroll
    for (int j = 0; j < 8; ++j) { v[j] = v[j] - mean; u[j] = u[j] - mean_; q2 += (v[j][0] * v[j][0] + v[j][1] * v[j][1]) + (v[j][2] * v[j][2] + v[j][3] * v[j][3]); q2_ += (u[j][0] * u[j][0] + u[j][1] * u[j][1]) + (u[j][2] * u[j][2] + u[j][3] * u[j][3]); }
#pragma unroll
    for (int o = 1; o < 64; o <<= 1) { q2 += shx(q2, o, lane); q2_ += shx(q2_, o, lane); }
    const float rstd = 1.f / sqrtf(q2 * (1.f / DM) + LN_EPS), rstd_ = 1.f / sqrtf(q2_ * (1.f / DM) + LN_EPS);
#pragma unroll
    for (int j = 0; j < 4; ++j) { const int c = 8 * (lane + 64 * j);
        const f32x4 ga = *(const f32x4*)(g1 + c), gb = *(const f32x4*)(g1 + c + 4), ba = *(const f32x4*)(b1 + c), bb = *(const f32x4*)(b1 + c + 4);
        *(f32x4*)(out + c) = v[2 * j] * rstd * ga + ba; *(f32x4*)(out + c + 4) = v[2 * j + 1] * rstd * gb + bb;
        *(f32x4*)(out + DM + c) = u[2 * j] * rstd_ * ga + ba; *(f32x4*)(out + DM + c + 4) = u[2 * j + 1] * rstd_ * gb + bb; }
}

__device__ __forceinline__ bf16* t1_row(unsigned char* ws, int m) { return m < 8192 ? (bf16*)(ws + WS_WIN) + (size_t)m * DM : (bf16*)(ws + WS_T1B) + (size_t)(m - 8192) * DM; }
struct TrItem { const float* src; bf16* dst; int ldw, nvalid; };
__device__ __forceinline__ void tr_load(const TrItem& t, float (&wv)[32], int lane) {
#pragma unroll
    for (int i = 0; i < 8; ++i) { const int kk = 8 * i + (lane >> 3); const f32x4 v = *(const f32x4*)(t.src + (size_t)kk * t.ldw + 4 * (lane & 7));
        wv[4 * i] = v[0]; wv[4 * i + 1] = v[1]; wv[4 * i + 2] = v[2]; wv[4 * i + 3] = v[3]; }
}
__device__ __forceinline__ void tr_store(const TrItem& t, const float (&wv)[32], LAS float* scr, int lane) {
#pragma unroll
    for (int i = 0; i < 8; ++i) { const int kk = 8 * i + (lane >> 3); LAS float* d = scr + kk * 33 + 4 * (lane & 7); d[0] = wv[4 * i]; d[1] = wv[4 * i + 1]; d[2] = wv[4 * i + 2]; d[3] = wv[4 * i + 3]; }
    LDS_WAIT();
    const int c = lane & 7;
#pragma unroll
    for (int j = 0; j < 4; ++j) { const int n = (lane >> 3) + 8 * j; const LAS float* sp = scr + (8 * c) * 33 + n;
        u32x4 o; o.x = cvt_pk_bf16(sp[0 * 33], sp[1 * 33]); o.y = cvt_pk_bf16(sp[2 * 33], sp[3 * 33]); o.z = cvt_pk_bf16(sp[4 * 33], sp[5 * 33]); o.w = cvt_pk_bf16(sp[6 * 33], sp[7 * 33]);
        if (n < t.nvalid) *(u32x4*)(t.dst + (size_t)n * 2048 + 8 * c) = o; }
    LDS_WAIT();
}
__device__ __forceinline__ bool tr_item(const Ctx& F, int l, int it, TrItem& t) {
    constexpr int I_IN = 241 * 32, I_OUT = 64 * 32;
    if (it >= I_IN + I_OUT) return false;
    if (it < I_IN) { int rb = it >> 5; const int kb = it & 31; rb = rb < 200 ? rb : rb + 16;
        t.ldw = IN_W; t.nvalid = rb == 256 ? 16 : 32; t.src = F.w_in + (size_t)l * DM * IN_W + (size_t)(kb * 64) * IN_W + src_col_of_row(rb * 32);
        t.dst = (bf16*)(F.ws + WS_WIN + l * WIN_STRIDE) + (size_t)rb * 32 * 2048 + kb * 64; }
    else { const int r = it - I_IN, rb = r >> 5, kb = r & 31;
        t.ldw = DM; t.nvalid = 32; t.src = F.w_out + (size_t)l * DM * DM + (size_t)(kb * 64) * DM + rb * 32;
        t.dst = (bf16*)(F.ws + WS_WOUT + l * WOUT_STRIDE) + (size_t)rb * 32 * 2048 + kb * 64; }
    return true;
}
__device__ __forceinline__ void weights_job(Ctx& F, int l, int gw, int ngw) {
    LAS float* scr = (LAS float*)(F.lds + F.wave * 16384);
    TrItem ta, tb; float wa[32], wb[32];
    int it = gw; bool ha = tr_item(F, l, it, ta), hb;
    if (ha) tr_load(ta, wa, F.lane);
    while (ha) {
        it += ngw; hb = tr_item(F, l, it, tb); if (hb) tr_load(tb, wb, F.lane);
        tr_store(ta, wa, scr, F.lane);
        if (!hb) break;
        it += ngw; ha = tr_item(F, l, it, ta); if (ha) tr_load(ta, wa, F.lane);
        tr_store(tb, wb, scr, F.lane);
    }
}
__device__ __forceinline__ void helper_of(const Ctx& F, int l, bool& is_h, int& hid, int& nh) { (void)l; if (F.G == 256) { is_h = F.bid >= 128; hid = F.bid - 128; nh = 128; } else { is_h = true; hid = F.bid; nh = F.G; } }
__device__ __forceinline__ void phase_prologue(Ctx& F) {
    const int gw = F.bid * NWAVES + F.wave, NGW = F.G * NWAVES;
    weights_job(F, 0, gw, NGW);
    for (int i = F.bid * NTHR + F.tid; i < 2 * WROWS; i += F.G * NTHR) { const int l = i / WROWS, r = i % WROWS; ((float*)(F.ws + WS_BIAS))[i] = F.b_in[l * IN_W + src_col_of_row(r)]; }
    for (int m = 2 * gw; m < M; m += 2 * NGW) ln_row2(F.x + (size_t)m * DM, F.x + (size_t)(m + 1) * DM, (float*)nullptr, (float*)nullptr, F.hby + (size_t)m * DM, F.hby + (size_t)(m + 1) * DM, F.stat + (size_t)m * 2, F.stat + (size_t)(m + 1) * 2, F.emb_g, F.emb_b, F.lane);
}

__device__ __forceinline__ void gates_job(Ctx& F, int l) {
    const bf16* Wg = (const bf16*)(F.ws + WS_WIN + l * WIN_STRIDE) + (size_t)8192 * 2048;
    const float* bg = (const float*)(F.ws + WS_BIAS) + l * WROWS + 8192;
    LAS f32x4* red = (LAS f32x4*)F.lds;
    const int w = F.wave, fr = F.lane & 15, fq = F.lane >> 4;
    bool is_h; int hid, nh; helper_of(F, l, is_h, hid, nh); if (!is_h) return;
    for (int rb = hid; rb < M / 64; rb += nh) {
        const bf16* bp = Wg + (size_t)fr * 2048 + w * 256 + 8 * fq;
        f32x4 acc[4];
#pragma unroll
        for (int tt = 0; tt < 4; ++tt) acc[tt] = (f32x4){0.f, 0.f, 0.f, 0.f};
        bf16x8 bfr[8], afr[4][8];
#pragma unroll
        for (int i = 0; i < 8; ++i) bfr[i] = *(const bf16x8*)(bp + 32 * i);
#pragma unroll
        for (int tt = 0; tt < 4; ++tt)
#pragma unroll
            for (int i = 0; i < 8; ++i) afr[tt][i] = *(const bf16x8*)(F.hby + (size_t)(rb * 64 + tt * 16 + fr) * DM + w * 256 + 8 * fq + 32 * i);
#pragma unroll
        for (int i = 0; i < 8; ++i)
#pragma unroll
            for (int tt = 0; tt < 4; ++tt) acc[tt] = __builtin_amdgcn_mfma_f32_16x16x32_bf16(afr[tt][i], bfr[i], acc[tt], 0, 0, 0);
#pragma unroll
        for (int tt = 0; tt < 4; ++tt) red[(w * 4 + tt) * 64 + F.lane] = acc[tt];
        __syncthreads();
        if (w < 4) { f32x4 o = red[w * 64 + F.lane];
#pragma unroll
            for (int ww = 1; ww < 8; ++ww) o = o + red[(ww * 4 + w) * 64 + F.lane];
            const float bb = bg[fr];
#pragma unroll
            for (int j = 0; j < 4; ++j) F.gate[(size_t)(rb * 64 + w * 16 + 4 * fq + j) * 16 + fr] = o[j] + bb; }
        __syncthreads();
    }
}

constexpr int WA_K = 0, WA_V = 65536, WA_VSTR = 1032, WA_TB = WA_V + 64 * WA_VSTR  , WA_TBS = 320, WA_END = WA_TB + 3 * WA_TBS * 4;
static_assert(WA_END <= MISC_OFF, "WA LDS map");
__device__ __forceinline__ void wattn_item(Ctx& F, int item, int l) {
    const int b = item >> 6, kvh = (item >> 4) & 3, p = item & 15;
    const int tokb = b * SEQ, kpos0 = 256 * p - 128;
    LAS unsigned char* lds = F.lds;
    {
        u32x4 kr[8], vr[8];
        const int kc0 = F.tid >> 3, c = F.tid & 7;
#pragma unroll
        for (int j = 0; j < 8; ++j) { const int kk = kc0 + 64 * j; int pos = kpos0 + kk; pos = pos < 0 ? 0 : (pos > SEQ - 1 ? SEQ - 1 : pos);
            kr[j] = *(const u32x4*)(F.unat + (size_t)(tokb + pos) * LDN + N_AK + kvh * 64 + c * 8); }
        const int d0 = F.tid >> 6, cc = F.tid & 63;
        int vpos = kpos0 + cc * 8; vpos = vpos < 0 ? 0 : (vpos > SEQ - 8 ? SEQ - 8 : vpos);
#pragma unroll
        for (int j = 0; j < 8; ++j) vr[j] = *(const u32x4*)(F.ut + (size_t)(T_AV + kvh * 64 + d0 + 8 * j) * M + tokb + vpos);
#pragma unroll
        for (int j = 0; j < 8; ++j) { const int kk = kc0 + 64 * j; *(LAS u32x4*)(lds + WA_K + kk * 128 + ((c ^ ((kk >> 1) & 7)) << 4)) = kr[j]; }
#pragma unroll
        for (int j = 0; j < 8; ++j) { LAS unsigned char* dst = lds + WA_V + (d0 + 8 * j) * WA_VSTR + cc * 16;
            *(LAS u32x2*)dst = (u32x2){vr[j].x, vr[j].y}; *(LAS u32x2*)(dst + 8) = (u32x2){vr[j].z, vr[j].w}; }
    }
    LAS float* tbw = (LAS float*)(lds + WA_TB);
    for (int i = F.tid; i < 3 * WA_TBS; i += NTHR) { const int g = i / WA_TBS, idx = i % WA_TBS - 31; tbw[i] = (idx >= 0 && idx <= 256) ? F.t5[t5_bucket(idx - 128) * 12 + kvh * 3 + g] * LOG2E : -INFINITY; }
    const int qt = F.wave, r = F.lane & 31, h = F.lane >> 5, ql = 32 * qt + r;
    const int tokq = tokb + 256 * p + ql;
    unsigned bad[16];
#pragma unroll
    for (int i = 0; i < 16; ++i) bad[i] = (unsigned)(WA_TB + (crow(i, h) - r + 31) * 4);
    bf16x8 qf[4];
#pragma unroll
    for (int s = 0; s < 4; ++s) qf[s] = *(const bf16x8*)(F.unat + (size_t)tokq * LDN + N_AQ + (kvh * 3) * 64 + 16 * s + 8 * h);
    __syncthreads();
    const int dlo = (p == 0) ? ((4 - qt) > 0 ? (4 - qt) : 0) : 0;
    const int dhi = (p == 15) ? ((12 - qt) < 9 ? (12 - qt) : 9) : 9;
#pragma unroll 1
    for (int g = 0; g < 3; ++g) {
        const int head = kvh * 3 + g;
        bf16x8 qn[4];
        if (g < 2) {
#pragma unroll
            for (int s = 0; s < 4; ++s) qn[s] = *(const bf16x8*)(F.unat + (size_t)tokq * LDN + N_AQ + (head + 1) * 64 + 16 * s + 8 * h);
        } else {
#pragma unroll
            for (int s = 0; s < 4; ++s) qn[s] = qf[s];
        }
        const bf16* zp = F.unat + (size_t)tokq * LDN + N_AZ + head * 64 + 8 * h;
        u32x2 zz[8];
#pragma unroll
        for (int p = 0; p < 4; ++p) { const u32x4 q_ = *(const u32x4*)(zp + 16 * p); zz[2 * p] = (u32x2){q_.x, q_.y}; zz[2 * p + 1] = (u32x2){q_.z, q_.w}; }
        float m = F.sink[l * 12 + head] * LOG2E, lsum = h ? 0.f : 1.f;
        f32x16 O0 = zero16(), O1 = zero16();
        const unsigned goff = (unsigned)(g * WA_TBS * 4);
#pragma unroll
        for (int dt_ = 0; dt_ < 9; ++dt_) {
            if (dt_ >= dlo && dt_ < dhi) {
                const int kt = qt + dt_;
                f32x16 S = zero16();
                const int krow_ = kt * 32 + r;
#pragma unroll
                for (int s = 0; s < 4; ++s) { const bf16x8 kf = *(const LAS bf16x8*)(lds + WA_K + krow_ * 128 + (((2 * s + h) ^ ((krow_ >> 1) & 7)) << 4)); S = MFMA32(kf, qf[s], S); }
                float bs[16];
#pragma unroll
                for (int i = 0; i < 16; ++i) bs[i] = *(const LAS float*)(lds + (bad[i] + goff) + dt_ * 128);
                float mx = -INFINITY;
#pragma unroll
                for (int i = 0; i < 16; ++i) { const float sv = fmaf(S[i], C2A, bs[i]); S[i] = sv; mx = fmaxf(mx, sv); }
                if (__builtin_amdgcn_ballot_w64(mx > m + 6.f) != 0ull) {
                    mx = fmaxf(mx, shx(mx, 32, F.lane));
                    const float mn = fmaxf(m, mx), al = ex2(m - mn); m = mn; lsum *= al;
#pragma unroll
                    for (int i = 0; i < 16; ++i) { O0[i] *= al; O1[i] *= al; }
                }
#pragma unroll
                for (int i = 0; i < 16; ++i) { const float pv = ex2(S[i] - m); S[i] = pv; lsum += pv; }
                const bf16x8 pb0 = pack8(S, 0), pb1 = pack8(S, 1);
#pragma unroll
                for (int s2 = 0; s2 < 2; ++s2) {
                    const int kof = (kt * 32 + 16 * s2 + 4 * h) * 2;
                    const s16x4 a0 = *(const LAS s16x4*)(lds + WA_V + r * WA_VSTR + kof), a1 = *(const LAS s16x4*)(lds + WA_V + r * WA_VSTR + kof + 16);
                    const s16x4 c0 = *(const LAS s16x4*)(lds + WA_V + (32 + r) * WA_VSTR + kof), c1 = *(const LAS s16x4*)(lds + WA_V + (32 + r) * WA_VSTR + kof + 16);
                    const bf16x8 v0 = __builtin_shufflevector(a0, a1, 0, 1, 2, 3, 4, 5, 6, 7), v1 = __builtin_shufflevector(c0, c1, 0, 1, 2, 3, 4, 5, 6, 7);
                    O0 = MFMA32(v0, s2 ? pb1 : pb0, O0); O1 = MFMA32(v1, s2 ? pb1 : pb0, O1);
                }
            }
        }
        lsum += shx(lsum, 32, F.lane);
        const float inv = frcp(lsum);
        bf16* yp = F.yb + (size_t)tokq * DM + head * 64 + 8 * h;
#pragma unroll
        for (int p = 0; p < 4; ++p) { const auto sx = __builtin_amdgcn_permlane32_swap(zz[2 * p].x, zz[2 * p + 1].x, false, false), sy = __builtin_amdgcn_permlane32_swap(zz[2 * p].y, zz[2 * p + 1].y, false, false);
            zz[2 * p] = (u32x2){sx[0], sy[0]}; zz[2 * p + 1] = (u32x2){sx[1], sy[1]}; }
#pragma unroll
        for (int dt = 0; dt < 2; ++dt) {
            u32x2 wy[4];
#pragma unroll
            for (int g4 = 0; g4 < 4; ++g4) { const u32x2 z2 = zz[dt * 4 + g4];
                const f32x16& O = dt ? O1 : O0;
                const float y0 = O[4 * g4] * inv * silu(bflo(z2.x)), y1 = O[4 * g4 + 1] * inv * silu(bfhi(z2.x)), y2 = O[4 * g4 + 2] * inv * silu(bflo(z2.y)), y3 = O[4 * g4 + 3] * inv * silu(bfhi(z2.y));
                wy[g4].x = cvt_pk_bf16(y0, y1); wy[g4].y = cvt_pk_bf16(y2, y3); }
#pragma unroll
            for (int p = 0; p < 2; ++p) { const auto sx = __builtin_amdgcn_permlane32_swap(wy[2 * p].x, wy[2 * p + 1].x, false, false), sy = __builtin_amdgcn_permlane32_swap(wy[2 * p].y, wy[2 * p + 1].y, false, false);
                u32x4 o; o.x = sx[0]; o.y = sy[0]; o.z = sx[1]; o.w = sy[1]; *(u32x4*)(yp + 32 * dt + 16 * p) = o; }
        }
#pragma unroll
        for (int s = 0; s < 4; ++s) qf[s] = qn[s];
    }
    __syncthreads();
}

constexpr int NA_K = 0, NA_V = 73728, NA_VSTR = 1160, NA_TB = NA_V + 64 * NA_VSTR  , NA_TI = NA_TB + 480 * 4  , NA_X = NA_TI + 2048, NA_XQ = 2560, NA_END = NA_X + 4 * NA_XQ;
static_assert(NA_END <= MISC_OFF, "NA LDS map");
struct NaRegs { u32x4 k[9]; u32x4 v[9]; };
__device__ __forceinline__ void na_decode(int item, int& b, int& head, int& r0, int& rs0) { b = item / 384; head = (item / 32) % 12; r0 = 2 * (item & 31); int t = r0 - 4; rs0 = t < 0 ? 0 : (t > 56 ? 56 : t); }
__device__ __forceinline__ void na_row_issue(Ctx& F, int b, int head, int gr, u32x4& kreg, u32x4& vreg) {
    const int kc = F.tid >> 3, c = F.tid & 7;
    kreg = *(const u32x4*)(F.unat + (size_t)(b * SEQ + gr * 64 + kc) * LDN + N_CK + head * 64 + c * 8);
    vreg = *(const u32x4*)(F.ut + (size_t)(T_CV + head * 64 + kc) * M + b * SEQ + gr * 64 + c * 8);
}
__device__ __forceinline__ void na_row_commit(Ctx& F, int gr, const u32x4& kreg, const u32x4& vreg) {
    const int kc = F.tid >> 3, c = F.tid & 7, slot = gr % 9, kk = slot * 64 + kc;
    *(LAS u32x4*)(F.lds + NA_K + kk * 128 + ((c ^ ((kk >> 1) & 7)) << 4)) = kreg;
    LAS unsigned char* dst = F.lds + NA_V + kc * NA_VSTR + (slot * 64 + c * 8) * 2;
    *(LAS u32x2*)dst = (u32x2){vreg.x, vreg.y}; *(LAS u32x2*)(dst + 8) = (u32x2){vreg.z, vreg.w};
}
#define SCHED_FENCE() __builtin_amdgcn_sched_barrier(0)
template <int CH>
__device__ __forceinline__ void na_tiles(LAS unsigned char* lds, const bf16x8 (&qf)[4], const unsigned (&badf)[16], const unsigned (&badc)[4], int rsj, int khalf, int r, int h,
                                         float& m, float& lsum, f32x16& O0, f32x16& O1) {
    bf16x8 kc[4];
    { const int kb0 = ((rsj + 4 * khalf) % 9) * 64, krow_ = kb0 + r;
#pragma unroll
      for (int s = 0; s < 4; ++s) kc[s] = *(const LAS bf16x8*)(lds + NA_K + krow_ * 128 + (((2 * s + h) ^ ((krow_ >> 1) & 7)) << 4)); }
#pragma unroll
    for (int it = 0; it < 8; ++it) {
        const int kri = it >> 1, kct = it & 1;
        const bool full = (kct == CH);
        const int kbase = ((rsj + 4 * khalf + kri) % 9) * 64 + kct * 32;
        s16x4 va[2][2], vc[2][2]; float bs[16];
#pragma unroll
        for (int s2 = 0; s2 < 2; ++s2) if (full || s2 == (kct ? 0 : 1)) {
            const int kof = (kbase + 16 * s2 + 4 * h) * 2;
            va[s2][0] = *(const LAS s16x4*)(lds + NA_V + r * NA_VSTR + kof); va[s2][1] = *(const LAS s16x4*)(lds + NA_V + r * NA_VSTR + kof + 16);
            vc[s2][0] = *(const LAS s16x4*)(lds + NA_V + (32 + r) * NA_VSTR + kof); vc[s2][1] = *(const LAS s16x4*)(lds + NA_V + (32 + r) * NA_VSTR + kof + 16);
        }
        if (full) {
#pragma unroll
            for (int i = 0; i < 16; ++i) bs[i] = *(const LAS float*)(lds + badf[i] + kri * 128);
        } else {
#pragma unroll
            for (int i = 0; i < 4; ++i) bs[i] = *(const LAS float*)(lds + badc[i] + kri * 128);
        }
        SCHED_FENCE();
        f32x16 S = zero16();
#pragma unroll
        for (int s = 0; s < 4; ++s) S = MFMA32(kc[s], qf[s], S);
        if (it < 7) { const int nb = ((rsj + 4 * khalf + ((it + 1) >> 1)) % 9) * 64 + ((it + 1) & 1) * 32, krow_ = nb + r;
#pragma unroll
            for (int s = 0; s < 4; ++s) kc[s] = *(const LAS bf16x8*)(lds + NA_K + krow_ * 128 + (((2 * s + h) ^ ((krow_ >> 1) & 7)) << 4)); }
        SCHED_FENCE();
        constexpr int NV = 16;
        const int i0 = full ? 0 : (kct ? 0 : 12), nv = full ? NV : 4;
        float mx = -INFINITY;
#pragma unroll
        for (int i = 0; i < NV; ++i) if (i < nv) { const float sv = fmaf(S[i0 + i], C2A, bs[i]); bs[i] = sv; mx = fmaxf(mx, sv); }
        { const auto sw = __builtin_amdgcn_permlane32_swap(__float_as_uint(mx), __float_as_uint(mx), false, false); mx = fmaxf(__uint_as_float(sw[0]), __uint_as_float(sw[1])); }
        const float mn = fmaxf(m, mx), al = ex2(m - mn); m = mn; lsum *= al;
#pragma unroll
        for (int i = 0; i < 16; ++i) { O0[i] *= al; O1[i] *= al; }
#pragma unroll
        for (int i = 0; i < NV; ++i) if (i < nv) { const float pv = ex2(bs[i] - mn); bs[i] = pv; lsum += pv; }
        if (full) {
            u32x4 p0, p1;
            p0.x = cvt_pk_bf16(bs[0], bs[1]); p0.y = cvt_pk_bf16(bs[2], bs[3]); p0.z = cvt_pk_bf16(bs[4], bs[5]); p0.w = cvt_pk_bf16(bs[6], bs[7]);
            p1.x = cvt_pk_bf16(bs[8], bs[9]); p1.y = cvt_pk_bf16(bs[10], bs[11]); p1.z = cvt_pk_bf16(bs[12], bs[13]); p1.w = cvt_pk_bf16(bs[14], bs[15]);
            const bf16x8 pb0 = __builtin_bit_cast(bf16x8, p0), pb1 = __builtin_bit_cast(bf16x8, p1);
            O0 = MFMA32(__builtin_shufflevector(va[0][0], va[0][1], 0, 1, 2, 3, 4, 5, 6, 7), pb0, O0); O1 = MFMA32(__builtin_shufflevector(vc[0][0], vc[0][1], 0, 1, 2, 3, 4, 5, 6, 7), pb0, O1);
            O0 = MFMA32(__builtin_shufflevector(va[1][0], va[1][1], 0, 1, 2, 3, 4, 5, 6, 7), pb1, O0); O1 = MFMA32(__builtin_shufflevector(vc[1][0], vc[1][1], 0, 1, 2, 3, 4, 5, 6, 7), pb1, O1);
        } else {
            u32x4 pw; const unsigned p01 = cvt_pk_bf16(bs[0], bs[1]), p23 = cvt_pk_bf16(bs[2], bs[3]);
            if (kct) { pw.x = p01; pw.y = p23; pw.z = 0u; pw.w = 0u; } else { pw.x = 0u; pw.y = 0u; pw.z = p01; pw.w = p23; }
            const bf16x8 pbx = __builtin_bit_cast(bf16x8, pw);
            const int s2 = kct ? 0 : 1;
            O0 = MFMA32(__builtin_shufflevector(va[s2][0], va[s2][1], 0, 1, 2, 3, 4, 5, 6, 7), pbx, O0); O1 = MFMA32(__builtin_shufflevector(vc[s2][0], vc[s2][1], 0, 1, 2, 3, 4, 5, 6, 7), pbx, O1);
        }
    }
}

__device__ __forceinline__ void nattn_all(Ctx& F, int l) {
    LAS unsigned char* lds = F.lds;
    const int vb = (F.G == 256) ? ((F.bid & 7) * 32 + (F.bid >> 3)) : F.bid;
    const int per = (1536 + F.G - 1) / F.G, it0 = vb * per, it1 = (it0 + per) < 1536 ? (it0 + per) : 1536;
    if (F.wave >= 4) __builtin_amdgcn_s_setprio(1);
    const int qt = F.wave & 3, khalf = F.wave >> 2, j = qt >> 1, ch = qt & 1, r = F.lane & 31, h = F.lane >> 5;
    const int qc = 32 * ch + r; int cs = qc - 8; cs = cs < 0 ? 0 : (cs > 48 ? 48 : cs);
    unsigned badf[16], badc[4];
#pragma unroll
    for (int i = 0; i < 16; ++i) { const int kc = ch * 32 + crow(i, h); const bool ok = (kc >= cs) && (kc < cs + 16); int dc = kc - qc; dc = dc < -15 ? -15 : (dc > 15 ? 15 : dc);
        badf[i] = (unsigned)(NA_TI + ((j * 8 + khalf * 4) * 32 + (ok ? dc + 15 : 31)) * 4); }
#pragma unroll
    for (int i = 0; i < 4; ++i) { const int kct = 1 - ch, ii = (kct ? 0 : 12) + i; const int kc = kct * 32 + crow(ii, h); const bool ok = (kc >= cs) && (kc < cs + 16); int dc = kc - qc; dc = dc < -15 ? -15 : (dc > 15 ? 15 : dc);
        badc[i] = (unsigned)(NA_TI + ((j * 8 + khalf * 4) * 32 + (ok ? dc + 15 : 31)) * 4); }
    int have_bh = -1, have_hi = -1, pf_lo = 0, pf_n = 0, tb_bh = -1;
    u32x4 pk0, pv0, pk1, pv1; bf16x8 qn[4]; bool have_qn = false;
    pk0 = pv0 = pk1 = pv1 = (u32x4){0u, 0u, 0u, 0u};
#pragma unroll
    for (int s = 0; s < 4; ++s) qn[s] = (bf16x8){0, 0, 0, 0, 0, 0, 0, 0};
#pragma unroll 1
    for (int item = it0; item < it1; ++item) {
        int b, head, r0, rs0; na_decode(item, b, head, r0, rs0);
        const int bh = b * 12 + head, need_hi = (rs0 + 8) < 63 ? (rs0 + 8) : 63, tokb = b * SEQ;
        if (bh != have_bh) {
            NaRegs R;
#pragma unroll
            for (int jj = 0; jj < 9; ++jj) { const int gr = (rs0 + jj) < 63 ? (rs0 + jj) : 63; na_row_issue(F, b, head, gr, R.k[jj], R.v[jj]); }
#pragma unroll
            for (int jj = 0; jj < 9; ++jj) { if (rs0 + jj <= 63) na_row_commit(F, rs0 + jj, R.k[jj], R.v[jj]); }
            LAS float* tbw = (LAS float*)(lds + NA_TB);
            for (int i = F.tid; i < 465; i += NTHR) tbw[i] = F.rpb[(size_t)(l * 12 + head) * 465 + i] * LOG2E;
            have_bh = bh;
        } else {
            if (pf_n > 0) na_row_commit(F, pf_lo, pk0, pv0);
            if (pf_n > 1) na_row_commit(F, pf_lo + 1, pk1, pv1);
        }
        have_hi = need_hi;
        if (bh != tb_bh) { LDS_BARRIER(); tb_bh = bh; }
        { const LAS float* tb = (const LAS float*)(lds + NA_TB); const int jj = F.tid >> 8, kidx = (F.tid >> 5) & 7, dci = F.tid & 31;
          int rsq = r0 + jj - 4; rsq = rsq < 0 ? 0 : (rsq > 56 ? 56 : rsq); const int dr = rsq + kidx - (r0 + jj) + 7;
          ((LAS float*)(lds + NA_TI))[F.tid] = dci < 31 ? tb[dr * 31 + dci] : -INFINITY; }
        const int qrow = r0 + j; int rsj = qrow - 4; rsj = rsj < 0 ? 0 : (rsj > 56 ? 56 : rsj);
        const int tokq = tokb + qrow * 64 + qc;
        bf16x8 qf[4];
        if (have_qn) {
#pragma unroll
            for (int s = 0; s < 4; ++s) qf[s] = qn[s];
        } else {
#pragma unroll
            for (int s = 0; s < 4; ++s) qf[s] = *(const bf16x8*)(F.unat + (size_t)tokq * LDN + N_CQ + head * 64 + 16 * s + 8 * h);
        }
        const bf16* zp = F.unat + (size_t)tokq * LDN + N_CZ + head * 64 + 32 * khalf + 4 * h;
        u32x2 zz[4];
#pragma unroll
        for (int g4 = 0; g4 < 4; ++g4) zz[g4] = *(const u32x2*)(zp + 8 * g4);
        LDS_BARRIER();
        pf_n = 0; have_qn = false;
        if (item + 1 < it1) {
            int nb, nhead, nr0, nrs0; na_decode(item + 1, nb, nhead, nr0, nrs0);
            if (nb * 12 + nhead == bh) {
                const int nhi = (nrs0 + 8) < 63 ? (nrs0 + 8) : 63;
                pf_lo = have_hi + 1; pf_n = nhi - have_hi;
                if (pf_n > 0) na_row_issue(F, b, head, pf_lo, pk0, pv0);
                if (pf_n > 1) na_row_issue(F, b, head, pf_lo + 1, pk1, pv1);
            }
            const int ntokq = nb * SEQ + (nr0 + j) * 64 + qc;
#pragma unroll
            for (int s = 0; s < 4; ++s) qn[s] = *(const bf16x8*)(F.unat + (size_t)ntokq * LDN + N_CQ + nhead * 64 + 16 * s + 8 * h);
            have_qn = true;
        }
        float m = -1e30f, lsum = 0.f;
        f32x16 O0 = zero16(), O1 = zero16();
        if (ch == 0) na_tiles<0>(lds, qf, badf, badc, rsj, khalf, r, h, m, lsum, O0, O1); else na_tiles<1>(lds, qf, badf, badc, rsj, khalf, r, h, m, lsum, O0, O1);
        lsum += shx(lsum, 32, F.lane);
        LAS unsigned* xq = (LAS unsigned*)(lds + NA_X + qt * NA_XQ);
        LAS float* xf = (LAS float*)(lds + NA_X + qt * NA_XQ + 2048);
        bf16* yp = F.yb + (size_t)tokq * DM + 1280 + head * 64 + 32 * khalf + 4 * h;
        if (khalf == 1) {
#pragma unroll
            for (int i = 0; i < 8; ++i) xq[i * 64 + F.lane] = cvt_pk_bf16(O0[2 * i], O0[2 * i + 1]);
            xf[F.lane] = m; xf[64 + F.lane] = lsum;
        }
        LDS_BARRIER();
        float m2 = 0.f, l2 = 0.f; unsigned ox[8];
        if (khalf == 0) {
            m2 = xf[F.lane]; l2 = xf[64 + F.lane];
#pragma unroll
            for (int i = 0; i < 8; ++i) ox[i] = xq[i * 64 + F.lane];
        }
        LDS_BARRIER();
        if (khalf == 0) {
#pragma unroll
            for (int i = 0; i < 8; ++i) xq[i * 64 + F.lane] = cvt_pk_bf16(O1[2 * i], O1[2 * i + 1]);
            xf[F.lane] = m; xf[64 + F.lane] = lsum;
        }
        LDS_BARRIER();
        if (khalf == 1) {
            m2 = xf[F.lane]; l2 = xf[64 + F.lane];
#pragma unroll
            for (int i = 0; i < 8; ++i) ox[i] = xq[i * 64 + F.lane];
        }
        {
            const float mn = fmaxf(m, m2), a1 = ex2(m - mn), a2 = ex2(m2 - mn);
            const float inv = frcp(lsum * a1 + l2 * a2);
#pragma unroll
            for (int g4 = 0; g4 < 4; ++g4) {
                float o[4];
#pragma unroll
                for (int e = 0; e < 4; ++e) { const float mine = khalf ? O1[4 * g4 + e] : O0[4 * g4 + e]; const unsigned pw = ox[2 * g4 + (e >> 1)]; const float oth = (e & 1) ? bfhi(pw) : bflo(pw);
                    o[e] = (mine * a1 + oth * a2) * inv; }
                const u32x2 z2 = zz[g4];
                const float y0 = o[0] * silu(bflo(z2.x)), y1 = o[1] * silu(bfhi(z2.x)), y2 = o[2] * silu(bflo(z2.y)), y3 = o[3] * silu(bfhi(z2.y));
                u32x2 w; w.x = cvt_pk_bf16(y0, y1); w.y = cvt_pk_bf16(y2, y3); *(u32x2*)(yp + 8 * g4) = w; }
        }
    }
    __builtin_amdgcn_s_setprio(0);
    LDS_BARRIER();
}

__device__ __forceinline__ size_t cst_chunk(int cid, int c, int dt, int k, int r) { const int L = ((dt * 16 + k) * 32 + r) * 8; return ((size_t)((cid * 8 + (L >> 11)) * 64 + c)) * 2048 + (size_t)(L & 2047); }
__device__ __forceinline__ void m1_wave(Ctx& F, int wi, int l) {
    const int b = wi >> 9, head = (wi >> 7) & 3, c = (wi >> 1) & 63, dir = wi & 1;
    const int tok0 = b * SEQ + c * 64;
    const int lane = F.lane, r = lane & 31, h = lane >> 5;
    LAS float* wtab = (LAS float*)(F.lds + F.wave * 256);
    const float ig = F.gate[(size_t)(tok0 + lane) * 16 + (2 * dir) * 4 + head];
    const float fg = F.gate[(size_t)(tok0 + lane) * 16 + (2 * dir + 1) * 4 + head] + F.fbias[l * 8 + dir * 4 + head];
    const float lf = logsigmoid(fg);
    const float cs = dir == 0 ? scan_sum_up(lf, lane) : scan_sum_down(lf, lane);
    const float g = shi(cs, dir == 0 ? 63 : 0);
    const float a = g - cs + ig;
    const float mloc = wave_max(a, lane);
    const float w = fexp(a - mloc);
    wtab[lane] = w;
    LDS_WAIT();
    const int cid = dir * 16 + b * 4 + head;
    if (lane == 0) { F.gs[cid * 64 + c] = g; F.ml[cid * 64 + c] = mloc; }
    f32x4 wv[8];
#pragma unroll
    for (int s = 0; s < 4; ++s) { wv[2 * s] = *(const LAS f32x4*)(wtab + 16 * s + 4 * h); wv[2 * s + 1] = *(const LAS f32x4*)(wtab + 16 * s + 8 + 4 * h); }
    bf16x8 af[4][4];
    {
        bf16x8 kn[2][8];
#pragma unroll
        for (int T = 0; T < 2; ++T)
#pragma unroll
            for (int j = 0; j < 8; ++j) kn[T][j] = *(const bf16x8*)(F.unat + (size_t)(tok0 + 32 * T + r) * LDN + N_BK + head * 128 + 16 * j + 8 * h);
        u32x4 i0, i1;
        { const unsigned one_lo = 0x3F80u, one_hi = 0x3F800000u; const int d0 = r - 8 * h, d1 = r - 16 - 8 * h;
          i0.x = d0 == 0 ? one_lo : d0 == 1 ? one_hi : 0u; i0.y = d0 == 2 ? one_lo : d0 == 3 ? one_hi : 0u; i0.z = d0 == 4 ? one_lo : d0 == 5 ? one_hi : 0u; i0.w = d0 == 6 ? one_lo : d0 == 7 ? one_hi : 0u;
          i1.x = d1 == 0 ? one_lo : d1 == 1 ? one_hi : 0u; i1.y = d1 == 2 ? one_lo : d1 == 3 ? one_hi : 0u; i1.z = d1 == 4 ? one_lo : d1 == 5 ? one_hi : 0u; i1.w = d1 == 6 ? one_lo : d1 == 7 ? one_hi : 0u; }
        const bf16x8 I0 = __builtin_bit_cast(bf16x8, i0), I1 = __builtin_bit_cast(bf16x8, i1);
#pragma unroll
        for (int et = 0; et < 4; ++et)
#pragma unroll
            for (int T = 0; T < 2; ++T) {
                f32x16 d = zero16();
                d = MFMA32(kn[T][2 * et], I0, d); d = MFMA32(kn[T][2 * et + 1], I1, d);
                af[et][2 * T] = pack8(d, 0); af[et][2 * T + 1] = pack8(d, 1);
            }
    }
#pragma unroll
    for (int et = 0; et < 4; ++et) { float ns = 0.f;
#pragma unroll
        for (int s = 0; s < 4; ++s) { const u32x4 raw = __builtin_bit_cast(u32x4, af[et][s]); const f32x4 w0 = wv[2 * s], w1 = wv[2 * s + 1];
            ns += bflo(raw.x) * w0[0] + bfhi(raw.x) * w0[1] + bflo(raw.y) * w0[2] + bfhi(raw.y) * w0[3] + bflo(raw.z) * w1[0] + bfhi(raw.z) * w1[1] + bflo(raw.w) * w1[2] + bfhi(raw.w) * w1[3]; }
        ns += shx(ns, 32, lane);
        if (h == 0) F.nst[(size_t)(cid * 64 + c) * 128 + 32 * et + r] = ns; }
#pragma unroll 1
    for (int dt = 0; dt < 4; ++dt) {
        bf16x8 bfr[4];
#pragma unroll
        for (int s = 0; s < 4; ++s) {
            const u32x4 q = *(const u32x4*)(F.ut + (size_t)(T_BV + head * 128 + 32 * dt + r) * M + tok0 + 16 * s + 8 * h);
            const auto sx = __builtin_amdgcn_permlane32_swap(q.x, q.z, false, false), sy = __builtin_amdgcn_permlane32_swap(q.y, q.w, false, false);
            u32x4 raw; raw.x = sx[0]; raw.y = sy[0]; raw.z = sx[1]; raw.w = sy[1];
            const f32x4 w0 = wv[2 * s], w1 = wv[2 * s + 1];
            u32x4 o; o.x = cvt_pk_bf16(bflo(raw.x) * w0[0], bfhi(raw.x) * w0[1]); o.y = cvt_pk_bf16(bflo(raw.y) * w0[2], bfhi(raw.y) * w0[3]);
            o.z = cvt_pk_bf16(bflo(raw.z) * w1[0], bfhi(raw.z) * w1[1]); o.w = cvt_pk_bf16(bflo(raw.w) * w1[2], bfhi(raw.w) * w1[3]);
            bfr[s] = __builtin_bit_cast(bf16x8, o);
        }
#pragma unroll
        for (int et = 0; et < 4; ++et) {
            f32x16 acc = zero16();
#pragma unroll
            for (int s = 0; s < 4; ++s) acc = MFMA32(af[et][s], bfr[s], acc);
#pragma unroll
            for (int p = 0; p < 2; ++p) {
                const unsigned a0 = cvt_pk_bf16(acc[8 * p], acc[8 * p + 1]), a1 = cvt_pk_bf16(acc[8 * p + 2], acc[8 * p + 3]);
                const unsigned b0 = cvt_pk_bf16(acc[8 * p + 4], acc[8 * p + 5]), b1 = cvt_pk_bf16(acc[8 * p + 6], acc[8 * p + 7]);
                const auto s0 = __builtin_amdgcn_permlane32_swap(a0, b0, false, false), s1 = __builtin_amdgcn_permlane32_swap(a1, b1, false, false);
                u32x4 o; o.x = s0[0]; o.y = s1[0]; o.z = s0[1]; o.w = s1[1];
                *(u32x4*)(F.cst + cst_chunk(cid, c, dt, 4 * et + 2 * p + h, r)) = o; }
        }
    }
    LDS_WAIT();
}

__device__ __forceinline__ void m2_scan(Ctx& F) {
    LAS float* sps = (LAS float*)F.lds; LAS float* sls = sps + 64;
    for (int blk = F.bid; blk < 256; blk += F.G) {
        const int cid = blk >> 3, dir = cid >> 4, e4 = (blk & 7) * 512 + F.tid;
        if (F.wave == 0) {
            const int sidx = F.lane, c = dir ? 63 - sidx : sidx;
            const float g = F.gs[cid * 64 + c], mloc = F.ml[cid * 64 + c];
            const float Gs = scan_sum_up(g, sidx);
            const float ma = Gs + fmaxf(0.f, scan_max_up(mloc - Gs, sidx));
            const float mb0 = shi(ma, sidx - 1); const float mb = sidx == 0 ? 0.f : mb0;
            sps[sidx] = fexp(g + mb - ma); sls[sidx] = fexp(mloc - ma); F.mprev[cid * 64 + c] = mb;
        }
        __syncthreads();
        float C0 = 0.f, C1 = 0.f, C2 = 0.f, C3 = 0.f;
        f32x4 nn = {0.f, 0.f, 0.f, 0.f};
        const bool do_n = e4 < 32;
        bf16* cb = F.cst + (size_t)(cid * 8 + (blk & 7)) * 64 * 2048 + F.tid * 4;
        float* nb = F.nst + (size_t)cid * 64 * 128 + (e4 & 31) * 4;
#pragma unroll 1
        for (int s0 = 0; s0 < 64; s0 += 16) {
            u32x2 cl[16]; f32x4 nl[16];
#pragma unroll
            for (int j = 0; j < 16; ++j) { const int c = dir ? 63 - (s0 + j) : (s0 + j); cl[j] = *(const u32x2*)(cb + (size_t)c * 2048); }
            if (do_n) {
#pragma unroll
                for (int j = 0; j < 16; ++j) { const int c = dir ? 63 - (s0 + j) : (s0 + j); nl[j] = *(const f32x4*)(nb + (size_t)c * 128); }
            }
#pragma unroll
            for (int j = 0; j < 16; ++j) {
                const int c = dir ? 63 - (s0 + j) : (s0 + j);
                u32x2 o; o.x = cvt_pk_bf16(C0, C1); o.y = cvt_pk_bf16(C2, C3); *(u32x2*)(cb + (size_t)c * 2048) = o;
                const float sp = sps[s0 + j], sl = sls[s0 + j];
                C0 = sp * C0 + sl * bflo(cl[j].x); C1 = sp * C1 + sl * bfhi(cl[j].x); C2 = sp * C2 + sl * bflo(cl[j].y); C3 = sp * C3 + sl * bfhi(cl[j].y);
                if (do_n) { *(f32x4*)(nb + (size_t)c * 128) = nn; nn = nn * sp + nl[j] * sl; }
            }
        }
        __syncthreads();
    }
}

constexpr int M3_TABW = 2560, M3_HB = 8 * M3_TABW  , M3_HW = 16384;
static_assert(M3_HB + 8 * M3_HW <= MISC_OFF, "M3 LDS map");
__device__ __forceinline__ void m3_wave(Ctx& F, int wi, int l) {
    const int b = wi >> 9, head = (wi >> 7) & 3, c = (wi >> 1) & 63, tt = wi & 1;
    const int tok0 = b * SEQ + c * 64;
    int lane_ = 0; asm volatile("" : "+v"(lane_)); lane_ = (int)__builtin_amdgcn_mbcnt_hi(~0u, __builtin_amdgcn_mbcnt_lo(~0u, (unsigned)lane_));
    const int lane = lane_, r = lane & 31, h = lane >> 5;
    LAS float* tab = (LAS float*)(F.lds + F.wave * M3_TABW);
    LAS float* hb = (LAS float*)(F.lds + M3_HB + F.wave * M3_HW);
    const int cidf = b * 4 + head, cidb = 16 + b * 4 + head;
    const int t = 32 * tt + r;
    const float* gp = F.gate + (size_t)(tok0 + lane) * 16;
    const float g_if = gp[head], g_ff = gp[4 + head], g_ib = gp[8 + head], g_fb = gp[12 + head];
    const float mpf = F.mprev[cidf * 64 + c], mpb = F.mprev[cidb * 64 + c];
    const float* nf = F.nst + (size_t)(cidf * 64 + c) * 128; const float* nbw = F.nst + (size_t)(cidb * 64 + c) * 128;
    const float n0_ = nf[lane], n1_ = nf[64 + lane], n2_ = nbw[lane], n3_ = nbw[64 + lane];
    bf16x8 qf[8], kf0[8];
#pragma unroll
    for (int s = 0; s < 8; ++s) qf[s] = *(const bf16x8*)(F.unat + (size_t)(tok0 + t) * LDN + N_BQ + head * 128 + 16 * s + 8 * h);
#pragma unroll
    for (int s = 0; s < 8; ++s) kf0[s] = *(const bf16x8*)(F.unat + (size_t)(tok0 + r) * LDN + N_BK + head * 128 + 16 * s + 8 * h);
    SCHED_FENCE();
    {
        const float f_f = g_ff + F.fbias[l * 8 + head], f_b = g_fb + F.fbias[l * 8 + 4 + head];
        const float bf_ = scan_sum_up(logsigmoid(f_f), lane), bb_ = scan_sum_down(logsigmoid(f_b), lane);
        const float uf = g_if - bf_, ub = g_ib - bb_;
        const float MF = fmaxf(mpf, scan_max_up(uf, lane)), MB = fmaxf(mpb, scan_max_down(ub, lane));
        tab[lane] = uf; tab[64 + lane] = ub; tab[128 + lane] = MF; tab[192 + lane] = MB; tab[256 + lane] = bf_; tab[320 + lane] = bb_;
        tab[384 + lane] = n0_; tab[448 + lane] = n1_; tab[512 + lane] = n2_; tab[576 + lane] = n3_;
        LDS_WAIT();
    }
    f32x16 S0 = zero16(), S1 = zero16();
    {
        bf16x8 kf1[8];
#pragma unroll
        for (int s = 0; s < 8; ++s) kf1[s] = *(const bf16x8*)(F.unat + (size_t)(tok0 + 32 + r) * LDN + N_BK + head * 128 + 16 * s + 8 * h);
        SCHED_FENCE();
#pragma unroll
        for (int s = 0; s < 8; ++s) S0 = MFMA32(kf0[s], qf[s], S0);
#pragma unroll
        for (int s = 0; s < 8; ++s) S1 = MFMA32(kf1[s], qf[s], S1);
    }
    bf16x8 pb[2][4]; float interw[2], inv[2];
#pragma unroll
    for (int dir = 0; dir < 2; ++dir) {
        const LAS float* U = tab + dir * 64;
        const float Mt = tab[128 + dir * 64 + t], Bt = tab[256 + dir * 64 + t], mp = dir ? mpb : mpf;
        const LAS float* np = tab + 384 + dir * 128 + 8 * h;
        float nq = 0.f;
#pragma unroll
        for (int s = 0; s < 8; ++s) { const f32x4 n0 = *(const LAS f32x4*)(np + 16 * s), n1 = *(const LAS f32x4*)(np + 16 * s + 4); const u32x4 qq = __builtin_bit_cast(u32x4, qf[s]);
            nq += n0[0] * bflo(qq.x) + n0[1] * bfhi(qq.x) + n0[2] * bflo(qq.y) + n0[3] * bfhi(qq.y) + n1[0] * bflo(qq.z) + n1[1] * bfhi(qq.z) + n1[2] * bflo(qq.w) + n1[3] * bfhi(qq.w); }
        nq += shx(nq, 32, lane);
        interw[dir] = fexp(mp - Mt) * QS;
        float den = 0.f;
#pragma unroll
        for (int st = 0; st < 2; ++st) {
            f32x16 P;
#pragma unroll
            for (int g4 = 0; g4 < 4; ++g4) { const f32x4 uu = *(const LAS f32x4*)(U + 32 * st + 8 * g4 + 4 * h);
#pragma unroll
                for (int e = 0; e < 4; ++e) { const int sp = 32 * st + 8 * g4 + 4 * h + e; const bool ok = dir ? (sp >= t) : (sp <= t);
                    const float wgt = ok ? fexp(uu[e] - Mt) : 0.f; const float pv = (st ? S1[4 * g4 + e] : S0[4 * g4 + e]) * QS * wgt; P[4 * g4 + e] = pv; den += pv; } }
            pb[dir][2 * st] = pack8(P, 0); pb[dir][2 * st + 1] = pack8(P, 1);
        }
        den += shx(den, 32, lane);
        den += nq * interw[dir];
        inv[dir] = frcp(fmaxf(fabsf(den), fexp(-(Bt + Mt))));
    }
    bf16x8 cfa[8], cfb[8]; s16x4 vv[8]; u32x2 og[4];
    int ro = r, ho = h; asm volatile("" : "+v"(ro), "+v"(ho));
    const int to = 32 * tt + ro;
#define M3_LOADC(dst, dir, dt) do { SCHED_FENCE(); { const bf16* cp = F.cst + cst_chunk((dir ? cidb : cidf), c, (dt), ho, ro); \
        _Pragma("unroll") for (int s = 0; s < 8; ++s) dst[s] = *(const bf16x8*)(cp + ((s & 3) * 2 * 256) + (s >> 2) * ((size_t)64 * 2048)); } SCHED_FENCE(); } while (0)
#define M3_LOADV(dt) do { SCHED_FENCE(); { const bf16* vp = F.ut + (size_t)(T_BV + head * 128 + 32 * (dt) + ro) * M + tok0 + 8 * ho; \
        _Pragma("unroll") for (int ks = 0; ks < 4; ++ks) { const u32x4 q_ = *(const u32x4*)(vp + 16 * ks); vv[2 * ks] = __builtin_bit_cast(s16x4, (u32x2){q_.x, q_.y}); vv[2 * ks + 1] = __builtin_bit_cast(s16x4, (u32x2){q_.z, q_.w}); } } \
        { const bf16* op = F.unat + (size_t)(tok0 + to) * LDN + N_BO + head * 128 + 32 * (dt) + 8 * ho; \
        _Pragma("unroll") for (int p = 0; p < 2; ++p) { const u32x4 q_ = *(const u32x4*)(op + 16 * p); og[2 * p] = (u32x2){q_.x, q_.y}; og[2 * p + 1] = (u32x2){q_.z, q_.w}; } } SCHED_FENCE(); } while (0)
    M3_LOADC(cfa, 0, 0); M3_LOADV(0);
    float s1 = 0.f, s2 = 0.f;
#pragma unroll 1
    for (int dt = 0; dt < 4; ++dt) {
        f32x16 H;
#pragma unroll
        for (int ks = 0; ks < 4; ++ks) {
            const u32x2 lo = __builtin_bit_cast(u32x2, vv[2 * ks]), hi = __builtin_bit_cast(u32x2, vv[2 * ks + 1]);
            const auto sx = __builtin_amdgcn_permlane32_swap(lo.x, hi.x, false, false), sy = __builtin_amdgcn_permlane32_swap(lo.y, hi.y, false, false);
            vv[2 * ks] = __builtin_bit_cast(s16x4, (u32x2){sx[0], sy[0]}); vv[2 * ks + 1] = __builtin_bit_cast(s16x4, (u32x2){sx[1], sy[1]}); }
        {
            f32x16 X = zero16();
#pragma unroll
            for (int s = 0; s < 8; ++s) X = MFMA32(cfa[s], qf[s], X);
            M3_LOADC(cfb, 1, dt);
            const float iw = interw[0];
#pragma unroll
            for (int i = 0; i < 16; ++i) X[i] *= iw;
#pragma unroll
            for (int ks = 0; ks < 4; ++ks) X = MFMA32(__builtin_shufflevector(vv[2 * ks], vv[2 * ks + 1], 0, 1, 2, 3, 4, 5, 6, 7), pb[0][ks], X);
            const float iv = inv[0];
#pragma unroll
            for (int i = 0; i < 16; ++i) H[i] = X[i] * iv;
        }
        {
            f32x16 X = zero16();
#pragma unroll
            for (int s = 0; s < 8; ++s) X = MFMA32(cfb[s], qf[s], X);
            if (dt < 3) M3_LOADC(cfa, 0, dt + 1);
            const float iw = interw[1];
#pragma unroll
            for (int i = 0; i < 16; ++i) X[i] *= iw;
#pragma unroll
            for (int ks = 0; ks < 4; ++ks) X = MFMA32(__builtin_shufflevector(vv[2 * ks], vv[2 * ks + 1], 0, 1, 2, 3, 4, 5, 6, 7), pb[1][ks], X);
            const float iv = inv[1];
#pragma unroll
            for (int i = 0; i < 16; ++i) H[i] += X[i] * iv;
        }
#pragma unroll
        for (int p = 0; p < 2; ++p) { const auto sx = __builtin_amdgcn_permlane32_swap(og[2 * p].x, og[2 * p + 1].x, false, false), sy = __builtin_amdgcn_permlane32_swap(og[2 * p].y, og[2 * p + 1].y, false, false);
            og[2 * p] = (u32x2){sx[0], sy[0]}; og[2 * p + 1] = (u32x2){sx[1], sy[1]}; }
#pragma unroll
        for (int g4 = 0; g4 < 4; ++g4) { const u32x2 oo = og[g4];
            H[4 * g4] *= sigm(bflo(oo.x)); H[4 * g4 + 1] *= sigm(bfhi(oo.x)); H[4 * g4 + 2] *= sigm(bflo(oo.y)); H[4 * g4 + 3] *= sigm(bfhi(oo.y)); }
        if (dt < 3) M3_LOADV(dt + 1);
#pragma unroll
        for (int i = 0; i < 16; ++i) { s1 += H[i]; s2 += H[i] * H[i]; hb[(dt * 16 + i) * 64 + lane] = H[i]; }
    }
#undef M3_LOADC
#undef M3_LOADV
    s1 += shx(s1, 32, lane); s2 += shx(s2, 32, lane);
    const float mean = s1 * (1.f / 128.f), var = fmaxf(s2 * (1.f / 128.f) - mean * mean, 0.f), rstd = __builtin_amdgcn_rsqf(var + LN_EPS);
    LDS_WAIT();
    int rz = r, hz = h; asm volatile("" : "+v"(rz), "+v"(hz)); const int tz = 32 * tt + rz;
    bf16* yp = F.yb + (size_t)(tok0 + tz) * DM + 768 + head * 128 + 8 * hz;
    const bf16* zp = F.unat + (size_t)(tok0 + tz) * LDN + N_BZ + head * 128 + 8 * hz; const float* ng = F.norm_g + l * 512 + head * 128 + 4 * hz;
#pragma unroll 1
    for (int half = 0; half < 2; ++half) {
        u32x4 zq[4]; u32x2 zz[8]; f32x4 gn[8];
#pragma unroll
        for (int p = 0; p < 4; ++p) zq[p] = *(const u32x4*)(zp + 16 * (4 * half + p));
#pragma unroll
        for (int i = 0; i < 8; ++i) gn[i] = *(const f32x4*)(ng + 8 * (8 * half + i));
#pragma unroll
        for (int p = 0; p < 4; ++p) { const auto sx = __builtin_amdgcn_permlane32_swap(zq[p].x, zq[p].z, false, false), sy = __builtin_amdgcn_permlane32_swap(zq[p].y, zq[p].w, false, false);
            zz[2 * p] = (u32x2){sx[0], sy[0]}; zz[2 * p + 1] = (u32x2){sx[1], sy[1]}; }
        u32x2 wy[8];
#pragma unroll
        for (int i = 0; i < 8; ++i) { const int ii = 8 * half + i;
            const float h0 = hb[(4 * ii) * 64 + lane], h1 = hb[(4 * ii + 1) * 64 + lane], h2 = hb[(4 * ii + 2) * 64 + lane], h3 = hb[(4 * ii + 3) * 64 + lane];
            const float y0 = (h0 - mean) * rstd * gn[i][0] * silu(bflo(zz[i].x)), y1 = (h1 - mean) * rstd * gn[i][1] * silu(bfhi(zz[i].x));
            const float y2 = (h2 - mean) * rstd * gn[i][2] * silu(bflo(zz[i].y)), y3 = (h3 - mean) * rstd * gn[i][3] * silu(bfhi(zz[i].y));
            wy[i].x = cvt_pk_bf16(y0, y1); wy[i].y = cvt_pk_bf16(y2, y3); }
#pragma unroll
        for (int p = 0; p < 4; ++p) { const auto sx = __builtin_amdgcn_permlane32_swap(wy[2 * p].x, wy[2 * p + 1].x, false, false), sy = __builtin_amdgcn_permlane32_swap(wy[2 * p].y, wy[2 * p + 1].y, false, false);
            u32x4 o; o.x = sx[0]; o.y = sy[0]; o.z = sx[1]; o.w = sy[1]; *(u32x4*)(yp + 16 * (4 * half + p)) = o; }
    }
    LDS_WAIT();
}

__global__ void __launch_bounds__(NTHR, 2) mega(Args args) {
    extern __shared__ __attribute__((aligned(16))) unsigned char lds_raw[];
    LAS unsigned char* const ldsb = (LAS unsigned char*)lds_raw;
    const int wave_s = __builtin_amdgcn_readfirstlane((int)threadIdx.x >> 6);
#define TID_NOW() ([&]() { unsigned z_ = 0u; asm volatile("" : "+v"(z_)); return wave_s * 64 + (int)__builtin_amdgcn_mbcnt_hi(~0u, __builtin_amdgcn_mbcnt_lo(~0u, z_)); }())
#define MAKE_CTX() MAKE_CTX_L(1)
#define MAKE_CTX_L(lyr) Ctx F; { const int l_ = (lyr); auto kp_ = __builtin_amdgcn_kernarg_segment_ptr(); asm volatile("" : "+s"(kp_)); \
    const __attribute__((address_space(4))) Args* ap_ = (const __attribute__((address_space(4))) Args*)kp_; \
    F.lds = ldsb; { int tid_ = TID_NOW(); asm volatile("" : "+v"(tid_)); F.tid = tid_; } F.lane = F.tid & 63; F.wave = wave_s; F.G = gridDim.x; F.bid = blockIdx.x; \
    F.x = ap_->in[0]; F.emb_g = ap_->in[1]; F.emb_b = ap_->in[2]; F.w_in = ap_->in[3]; F.b_in = ap_->in[4]; F.w_out = ap_->in[5]; F.b_out = ap_->in[6]; \
    F.ln_g = ap_->in[7]; F.ln_b = ap_->in[8]; F.t5 = ap_->in[9]; F.sink = ap_->in[10]; F.fbias = ap_->in[11]; F.norm_g = ap_->in[12]; F.rpb = ap_->in[13]; \
    F.out = ap_->out; F.ws = ap_->ws; \
    F.hby = (bf16*)(F.ws + WS_HBY); F.yb = l_ == 0 ? (bf16*)F.out : F.hby; F.unat = (bf16*)(F.ws + WS_UNAT); F.ut = (bf16*)(F.ws + WS_UT); F.cst = (bf16*)(F.ws + WS_CST); F.nst = (float*)(F.ws + WS_NST); \
    F.gs = (float*)(F.ws + WS_SCAL); F.ml = F.gs + 2048; F.mprev = F.gs + 4096; F.gate = (float*)(F.ws + WS_GATE); F.stat = (float*)(F.ws + WS_SCAL + 65536); }
    volatile LAS unsigned* MISC = (volatile LAS unsigned*)(ldsb + MISC_OFF);
    if (threadIdx.x < 32) MISC[threadIdx.x] = 0u;
    __syncthreads();
    XcdBarrier bar; bar.bar = (unsigned*)(args.ws + WS_CTL) + CW_BAR; bar.x = 0; bar.st = nullptr;
    if (!MK_PER_PHASE) bar = xcd_barrier_post((unsigned*)(args.ws + WS_CTL) + CW_BAR, MISC + 8, (int)threadIdx.x);
    const int lo = args.ph_lo, hi = args.ph_hi;
#define IN(k) (lo <= (k) && (k) < hi)
#define SEAM(k) do { if (IN(k) && IN((k) + 1)) { for (int rb_ = 0; rb_ < REP_BAR; ++rb_) xcd_barrier(bar, TID_NOW()); } } while (0)
    #ifndef NO_P0
    if (IN(0)) { MAKE_CTX(); for (int rep_ = 0, nrep_ = opaque_int(REP_P0); rep_ < nrep_; ++rep_) phase_prologue(F); }
#endif
    SEAM(0);
#pragma unroll 1
    for (int l = 0; l < 2; ++l) {
        const int pb = 1 + 6 * l;
        if (IN(pb)) {
#ifndef NO_G1
            {   MAKE_CTX_L(l);
                pg8::Sched1 S{(const char*)F.hby, (const char*)(F.ws + WS_WIN + l * WIN_STRIDE), F.G, F.bid};
                pg8::Epi1 E{F.unat, F.ut, (const float*)(F.ws + WS_BIAS) + l * WROWS};
                pg8::gemm_phase<pg8::Epi1, pg8::Sched1, true, true>(F.lds, S, E, F.tid); }
#endif
#ifndef NO_GATES
            {   MAKE_CTX_L(l);
                if (l == 0) { bool is_h; int hid, nh; helper_of(F, 0, is_h, hid, nh); if (is_h) { weights_job(F, 1, hid * NWAVES + F.wave, nh * NWAVES); } __syncthreads(); }
                gates_job(F, l); }
#endif
        }
        SEAM(pb);
        if (IN(pb + 1)) {
            MAKE_CTX_L(l);
#ifndef NO_M1
            for (int rep_ = 0, nrep_ = opaque_int(REP_M1); rep_ < nrep_; ++rep_) for (int wi = F.bid * NWAVES + F.wave; wi < 2048; wi += F.G * NWAVES) m1_wave(F, wi, l);
#endif
            __syncthreads();
#ifndef NO_WA
            for (int rep_ = 0, nrep_ = opaque_int(REP_WA); rep_ < nrep_; ++rep_) for (int it0 = F.bid; it0 < 256; it0 += F.G) wattn_item(F, (F.G == 256) ? ((it0 & 7) * 32 + (it0 >> 3)) : it0, l);
#endif
        }
        SEAM(pb + 1);
        if (IN(pb + 2)) {
            MAKE_CTX_L(l);
#ifndef NO_M2
            m2_scan(F);
#endif
#ifndef NO_NA
            for (int rep_ = 0, nrep_ = opaque_int(REP_NA); rep_ < nrep_; ++rep_) nattn_all(F, l);
#endif
        }
        SEAM(pb + 2);
        if (IN(pb + 3)) {
            MAKE_CTX_L(l);
#ifndef NO_M3
            for (int rep_ = 0, nrep_ = opaque_int(REP_M3); rep_ < nrep_; ++rep_) for (int wi = F.bid * NWAVES + F.wave; wi < 2048; wi += F.G * NWAVES) m3_wave(F, wi, l);
#endif
        }
        SEAM(pb + 3);
        if (IN(pb + 4)) {
            MAKE_CTX_L(l);
            pg8::Sched2 S{(const char*)F.yb, (const char*)(F.ws + WS_WOUT + l * WOUT_STRIDE), F.G, F.bid};
#ifndef NO_G2
            if (l == 0) { pg8::Epi2<0> E{(float*)nullptr, (bf16*)(F.ws + WS_WIN), F.b_out, F.x, (const bf16*)F.hby, F.stat, F.emb_g, F.emb_b, (bf16*)(F.ws + WS_T1B)};
                pg8::gemm_phase<pg8::Epi2<0>, pg8::Sched2, true, true>(F.lds, S, E, F.tid); }
            else { pg8::Epi2<1> E{(float*)nullptr, (bf16*)(F.ws + WS_UNAT), F.b_out + DM, (const float*)nullptr, (const bf16*)nullptr, (const float*)nullptr, (const float*)nullptr, (const float*)nullptr, (bf16*)nullptr};
                pg8::gemm_phase<pg8::Epi2<1>, pg8::Sched2, true, true>(F.lds, S, E, F.tid); }
#endif
        }
        SEAM(pb + 4);
        if (IN(pb + 5)) {
            MAKE_CTX_L(l);
            const int gw = F.bid * NWAVES + F.wave, NGW = F.G * NWAVES;
            if (l == 0) { for (int m = 2 * gw; m < M; m += 2 * NGW) ln_row2_b(t1_row(F.ws, m), t1_row(F.ws, m + 1), F.hby + (size_t)m * DM, F.hby + (size_t)(m + 1) * DM, F.stat + (size_t)(M + m) * 2, F.stat + (size_t)(M + m + 1) * 2, F.ln_g, F.ln_b, F.lane); }
            else { const bf16* O2 = (const bf16*)(F.ws + WS_UNAT);
                   for (int m = 2 * gw; m < M; m += 2 * NGW) fin_row2(t1_row(F.ws, m), O2 + (size_t)m * DM, F.stat + (size_t)(M + m) * 2, F.ln_g, F.ln_b, F.ln_g + DM, F.ln_b + DM, F.out + (size_t)m * DM, F.lane); }
        }
        if (l == 0) SEAM(pb + 5);
    }
#undef IN
#undef SEAM
}

extern "C" void kernel_launch(void* const* d_in, const int* in_sizes, int n_in, void* d_out, int out_size, void* d_ws, size_t ws_size, hipStream_t stream) {
    static int grid = 0;
    if (grid == 0) {
        if (n_in != 14 || out_size != M * DM || ws_size < WS_END) { fprintf(stderr, "kernel_launch: unexpected shapes (n_in %d out %d ws %zu)\n", n_in, out_size, ws_size); grid = -1; return; }
        int dev = 0, cus = 0, per_cu = 0;
        if (hipGetDevice(&dev) != hipSuccess || hipDeviceGetAttribute(&cus, hipDeviceAttributeMultiprocessorCount, dev) != hipSuccess) { grid = -1; return; }
        if (hipFuncSetAttribute((const void*)mega, hipFuncAttributeMaxDynamicSharedMemorySize, LDS_BYTES) != hipSuccess) { fprintf(stderr, "kernel_launch: hipFuncSetAttribute failed\n"); grid = -1; return; }
        if (hipOccupancyMaxActiveBlocksPerMultiprocessor(&per_cu, (const void*)mega, NTHR, LDS_BYTES) != hipSuccess || per_cu < 1) fprintf(stderr, "kernel_launch: occupancy query says %d\n", per_cu);
        (void)hipGetLastError();
        grid = cus;
    }
    if (grid < 0) return;
    (void)hipMemsetAsync((char*)d_ws + WS_CTL, 0, CTL_BYTES, stream);
    Args a{};
    for (int i = 0; i < 14; ++i) a.in[i] = (const float*)d_in[i];
    a.out = (float*)d_out; a.ws = (unsigned char*)d_ws;
#if MK_PER_PHASE
    for (int p = 0; p < 13; ++p) { a.ph_lo = p; a.ph_hi = p + 1; hipLaunchKernelGGL(mega, dim3(grid), dim3(NTHR), LDS_BYTES, stream, a); }
#else
    a.ph_lo = 0; a.ph_hi = 13;
    hipLaunchKernelGGL(mega, dim3(grid), dim3(NTHR), LDS_BYTES, stream, a);
#endif
}
```

```cpp
#include <hip/hip_runtime.h>
#include <cstdio>
#include <cstdint>

#ifndef REP_P0
#define REP_P0 1
#endif
#ifndef REP_G1
#define REP_G1 1
#endif
#ifndef REP_M1
#define REP_M1 1
#endif
#ifndef REP_WA
#define REP_WA 1
#endif
#ifndef REP_NA
#define REP_NA 1
#endif
#ifndef REP_M3
#define REP_M3 1
#endif
#ifndef REP_GATES
#define REP_GATES 1
#endif
#ifndef REP_BAR
#define REP_BAR 1
#endif
#ifndef MK_PER_PHASE
#define MK_PER_PHASE 0
#endif

#define LAS __attribute__((address_space(3)))
#define GAS __attribute__((address_space(1)))
typedef unsigned short bf16;
typedef short bf16x8 __attribute__((ext_vector_type(8)));
typedef short s16x4 __attribute__((ext_vector_type(4)));
typedef float f32x4 __attribute__((ext_vector_type(4)));
typedef float f32x16 __attribute__((ext_vector_type(16)));
typedef unsigned u32x4 __attribute__((ext_vector_type(4)));
typedef unsigned u32x2 __attribute__((ext_vector_type(2)));
typedef GAS unsigned gu32;

constexpr int M = 16384, DM = 2048, SEQ = 4096, IN_W = 7696, NWAVES = 8, NTHR = 512;
constexpr int LDN = 6144;
constexpr int N_AQ = 0, N_AK = 768, N_AZ = 1024, N_BQ = 1792, N_BK = 2304, N_BO = 2816, N_BZ = 3328, N_CQ = 3840, N_CK = 4608, N_CZ = 5376;
constexpr int T_AV = 0, T_BK = 256, T_BV = 768, T_CV = 1280;
constexpr int WROWS = 8192 + 16;
constexpr float LN_EPS = 1e-5f, LOG2E = 1.4426950408889634f, ALPHA = 1.4142135623730951f;
constexpr float C2A = 0.125f * LOG2E;
constexpr float QS = 0.08838834764831845f;

constexpr size_t MiB = 1u << 20;
constexpr size_t WS_CTL = 0, CTL_BYTES = 1 * MiB;
constexpr size_t WS_WIN = 2 * MiB, WIN_STRIDE = 33 * MiB;
constexpr size_t WS_WOUT = 68 * MiB, WOUT_STRIDE = 8 * MiB;
constexpr size_t WS_BIAS = 84 * MiB;
constexpr size_t WS_GATE = 85 * MiB;
constexpr size_t WS_HBY = 86 * MiB;
constexpr size_t WS_UNAT = 150 * MiB;
constexpr size_t WS_UT = 342 * MiB;
constexpr size_t WS_CST = 406 * MiB;
constexpr size_t WS_NST = 470 * MiB;
constexpr size_t WS_SCAL = 471 * MiB;
constexpr size_t WS_T1B = 472 * MiB;
constexpr size_t WS_END = 504 * MiB;
constexpr int CW_BAR = 4096;

constexpr int LDS_BYTES = 163840, MISC_OFF = LDS_BYTES - 128;

__device__ __forceinline__ int opaque_int(int v) { asm volatile("" : "+s"(v)); return v; }
#define LDS_WAIT() asm volatile("s_waitcnt lgkmcnt(0)" ::: "memory")
#define LDS_BARRIER() do { asm volatile("s_waitcnt lgkmcnt(0)" ::: "memory"); __builtin_amdgcn_s_barrier(); asm volatile("" ::: "memory"); } while (0)
#define VM_WAIT() asm volatile("s_waitcnt vmcnt(0)" ::: "memory")
__device__ __forceinline__ float bf2f(unsigned v) { return __uint_as_float(v << 16); }
__device__ __forceinline__ float bflo(unsigned v) { return __uint_as_float(v << 16); }
__device__ __forceinline__ float bfhi(unsigned v) { return __uint_as_float(v & 0xffff0000u); }
typedef float f32x2_t __attribute__((ext_vector_type(2)));
typedef __bf16 bf16x2_t __attribute__((ext_vector_type(2)));
__device__ __forceinline__ unsigned cvt_pk_bf16(float lo, float hi) { const f32x2_t v = {lo, hi}; const bf16x2_t b = __builtin_convertvector(v, bf16x2_t); return __builtin_bit_cast(unsigned, b); }
__device__ __forceinline__ float ex2(float x) { return __builtin_amdgcn_exp2f(x); }
__device__ __forceinline__ float fexp(float x) { return __builtin_amdgcn_exp2f(x * LOG2E); }
__device__ __forceinline__ float frcp(float x) { return __builtin_amdgcn_rcpf(x); }
__device__ __forceinline__ float silu(float x) { return x * frcp(1.f + fexp(-x)); }
__device__ __forceinline__ float sigm(float x) { return frcp(1.f + fexp(-x)); }
__device__ __forceinline__ float logsigmoid(float x) { return fminf(x, 0.f) - log1pf(expf(-fabsf(x))); }
__device__ __forceinline__ int crow(int reg, int h) { return (reg & 3) + 8 * (reg >> 2) + 4 * h; }
__device__ __forceinline__ float shx(float v, int mask, int lane) { return __int_as_float(__builtin_amdgcn_ds_bpermute((lane ^ mask) << 2, __float_as_int(v))); }
__device__ __forceinline__ float shi(float v, int src) { return __int_as_float(__builtin_amdgcn_ds_bpermute(src << 2, __float_as_int(v))); }
__device__ __forceinline__ float wave_sum(float v, int lane) {
#pragma unroll
    for (int o = 1; o < 64; o <<= 1) v += shx(v, o, lane);
    return v;
}
__device__ __forceinline__ float wave_max(float v, int lane) {
#pragma unroll
    for (int o = 1; o < 64; o <<= 1) v = fmaxf(v, shx(v, o, lane));
    return v;
}
__device__ __forceinline__ float scan_sum_up(float v, int lane) {
#pragma unroll
    for (int o = 1; o < 64; o <<= 1) { const float t = shi(v, lane - o); if (lane >= o) v += t; }
    return v;
}
__device__ __forceinline__ float scan_sum_down(float v, int lane) {
#pragma unroll
    for (int o = 1; o < 64; o <<= 1) { const float t = shi(v, lane + o); if (lane + o < 64) v += t; }
    return v;
}
__device__ __forceinline__ float scan_max_up(float v, int lane) {
#pragma unroll
    for (int o = 1; o < 64; o <<= 1) { const float t = shi(v, lane - o); if (lane >= o) v = fmaxf(v, t); }
    return v;
}
__device__ __forceinline__ float scan_max_down(float v, int lane) {
#pragma unroll
    for (int o = 1; o < 64; o <<= 1) { const float t = shi(v, lane + o); if (lane + o < 64) v = fmaxf(v, t); }
    return v;
}
__device__ __forceinline__ int t5_bucket(int rel) {
    const int n = rel < 0 ? -rel : rel; const int ret = rel > 0 ? 16 : 0;
    const int large = 8 + (n >= 12) + (n >= 16) + (n >= 23) + (n >= 32) + (n >= 46) + (n >= 64) + (n >= 91);
    return ret + (n < 8 ? n : large);
}
#define PIN16(a) asm volatile("" : "+v"(a[0]), "+v"(a[1]), "+v"(a[2]), "+v"(a[3]), "+v"(a[4]), "+v"(a[5]), "+v"(a[6]), "+v"(a[7]), "+v"(a[8]), "+v"(a[9]), "+v"(a[10]), "+v"(a[11]), "+v"(a[12]), "+v"(a[13]), "+v"(a[14]), "+v"(a[15]))
#define MFMA32(a, b, c) __builtin_amdgcn_mfma_f32_32x32x16_bf16((a), (b), (c), 0, 0, 0)
__device__ __forceinline__ bf16x8 pack8(const f32x16& x, int s) {
    u32x4 p; p.x = cvt_pk_bf16(x[8 * s], x[8 * s + 1]); p.y = cvt_pk_bf16(x[8 * s + 2], x[8 * s + 3]); p.z = cvt_pk_bf16(x[8 * s + 4], x[8 * s + 5]); p.w = cvt_pk_bf16(x[8 * s + 6], x[8 * s + 7]);
    return __builtin_bit_cast(bf16x8, p);
}
__device__ __forceinline__ f32x16 zero16() { f32x16 z;
#pragma unroll
    for (int i = 0; i < 16; ++i) z[i] = 0.f; return z; }

__device__ __forceinline__ size_t fm_off(int tok, int base, int sh, int col) { const int rho = col >> 3; return (size_t)((tok & ~31) + (rho >> sh)) * 6144 + base + (rho & ((1 << sh) - 1)) * 256 + (tok & 31) * 8; }
__device__ __forceinline__ size_t bqk_off(int tok, int col) { return fm_off(tok, 1792, 2, col); }
namespace pg8 {
constexpr int BM = 256, BK = 64, HALF = 128, HTB = HALF * BK * 2, STAGE_BYTES = 8 * HTB, NXCD = 8, WGM = 4;
__device__ __forceinline__ int lds_byte(int r, int c) { const int st = (r >> 4) * 2 + (c >> 5), rr = r & 15, cc = c & 31, ob = rr * 64 + cc * 2; return st * 1024 + (ob ^ (((ob >> 9) & 1) << 5)); }
__device__ __forceinline__ void stage_rc(int b, int& R, int& C) { const int st = b / 1024, sb = b % 1024, swz = sb ^ (((sb >> 9) & 1) << 5); R = (st >> 1) * 16 + swz / 64; C = (st & 1) * 32 + (swz % 64) / 2; }
__device__ __forceinline__ int perm32(int rho) { const int n = rho >> 4, i = rho & 15; return 8 * (i >> 2) + 4 * n + (i & 3); }

struct Unit { const char* a; const char* b; int pm, pn, kind; };

__device__ __forceinline__ bool tile_of(int i, int G, int c, int nM, int nN, int& pm, int& pn) {
    const int nwg = nM * nN; const long L = (long)i * G + c; if (L >= nwg) return false;
    int wgid = (int)L; { const int q = nwg / NXCD, r = nwg % NXCD, xcd = wgid % NXCD, off = wgid / NXCD; wgid = (xcd < r ? xcd * (q + 1) : r * (q + 1) + (xcd - r) * q) + off; }
    const int nig = WGM * nN, gid = wgid / nig, fm = gid * WGM, gsz = (nM - fm) < WGM ? (nM - fm) : WGM;
    pm = fm + ((wgid % nig) % gsz); pn = (wgid % nig) / gsz; return true;
}
constexpr size_t TSTEP = (size_t)256 * 2048 * 2;
struct Sched1 {
    const char* X; const char* W; int G, c;
    __device__ __forceinline__ bool next(int i, Unit& u) const {
        int pm, pn;
        if (G == 256) {
            if (i >= 8) return false;
            const int x = c & 7, k = c >> 3, j = i;
            if (i == 7) { if (c >= 128) return false; pm = 8 * x + (k & 7); pn = 28 + (k >> 3); }
            else if (j < 4) { pm = 16 * j + 4 * (x & 3) + (k & 3); pn = 8 * (x >> 2) + (k >> 2); }
            else if (j < 6) { pm = 32 * (j - 4) + 8 * (x & 3) + (k & 7); pn = 16 + 4 * (x >> 2) + (k >> 3); }
            else { pm = 8 * x + (k & 7); pn = 24 + (k >> 3); }
            if (pn >= 25) pn += 2;
        } else if (!tile_of(i, G, c, 64, 32, pm, pn)) return false;
        u.pm = pm; u.pn = pn;
        if (pn < 24) { u.kind = 0; u.a = X + (size_t)pm * TSTEP; u.b = W + (size_t)pn * TSTEP; }
        else { u.kind = 1; u.a = W + (size_t)pn * TSTEP; u.b = X + (size_t)pm * TSTEP; }
        return true;
    }
};
struct Sched2 {
    const char* Y; const char* W; int G, c;
    __device__ __forceinline__ bool next(int i, Unit& u) const {
        int pm, pn; if (!tile_of(i, G, c, 64, 8, pm, pn)) return false;
        u.pm = pm; u.pn = pn; u.kind = 2; u.a = Y + (size_t)pm * TSTEP; u.b = W + (size_t)pn * TSTEP; return true;
    }
};

struct Epi1 {
    static constexpr bool PERM = true;
    bf16* Unat; bf16* Ut; const float* bias;
    __device__ __forceinline__ void operator()(const f32x4 (&acc)[2][2][4][2], const Unit& u, int wr, int wc, int fr, int fq) const {
        if (u.kind == 0) {
            const bool fmaj = u.pn >= 7 && u.pn <= 14;
            const int fbase = u.pn <= 10 ? N_BQ : (u.pn <= 12 ? N_BO : N_BZ), frpr = u.pn <= 10 ? 2 : 1;
            const int row0 = u.pm * BM + wr * 64 + fr, col0 = u.pn * BM + wc * 32 + 8 * fq;
            f32x4 bv[2][2];
#pragma unroll
            for (int bj = 0; bj < 2; ++bj)
#pragma unroll
                for (int n = 0; n < 2; ++n) bv[bj][n] = *(const f32x4*)(bias + col0 + bj * HALF + 4 * n);
#pragma unroll
            for (int ai = 0; ai < 2; ++ai)
#pragma unroll
                for (int m = 0; m < 4; ++m) { const int row = row0 + ai * HALF + m * 16; bf16* rowp = Unat + (size_t)row * LDN + col0;
#pragma unroll
                    for (int bj = 0; bj < 2; ++bj) { const f32x4 v0 = acc[ai][bj][m][0] + bv[bj][0], v1 = acc[ai][bj][m][1] + bv[bj][1];
                        u32x4 w; w.x = cvt_pk_bf16(v0[0], v0[1]); w.y = cvt_pk_bf16(v0[2], v0[3]); w.z = cvt_pk_bf16(v1[0], v1[1]); w.w = cvt_pk_bf16(v1[2], v1[3]);
                        bf16* dst = fmaj ? Unat + fm_off(row, fbase, frpr, col0 + bj * HALF - fbase) : rowp + bj * HALF;
                        *(u32x4*)dst = w; } }
        } else {
            const int nrow0 = (u.pn - 24) * BM + wr * 64 + fr, tok0 = u.pm * BM + wc * 32 + 8 * fq;
#pragma unroll
            for (int ai = 0; ai < 2; ++ai)
#pragma unroll
                for (int m = 0; m < 4; ++m) { const int nr = nrow0 + ai * HALF + m * 16; const float bs = bias[6144 + nr]; bf16* rowp = Ut + (size_t)nr * M + tok0;
#pragma unroll
                    for (int bj = 0; bj < 2; ++bj) { const f32x4 v0 = acc[ai][bj][m][0] + bs, v1 = acc[ai][bj][m][1] + bs;
                        u32x4 w; w.x = cvt_pk_bf16(v0[0], v0[1]); w.y = cvt_pk_bf16(v0[2], v0[3]); w.z = cvt_pk_bf16(v1[0], v1[1]); w.w = cvt_pk_bf16(v1[2], v1[3]);
                        *(u32x4*)(rowp + bj * HALF) = w; } }
        }
    }
};
template <int L> struct Epi2 {
    static constexpr bool PERM = true;
    float* Tf; bf16* Tb; const float* bias; const float* srcf; const bf16* srcb; const float* stat; const float* gam; const float* bet; bf16* Tb_hi;
    __device__ __forceinline__ void operator()(const f32x4 (&acc)[2][2][4][2], const Unit& u, int wr, int wc, int fr, int fq) const {
        const int row0 = u.pm * BM + wr * 64 + fr, col0 = u.pn * BM + wc * 32 + 8 * fq;
        bf16* const Tbu = (Tb_hi && u.pm >= 32) ? Tb_hi - (size_t)8192 * DM : Tb;
        float mean[2][4], rs[2][4];
#pragma unroll
        for (int ai = 0; ai < 2; ++ai)
#pragma unroll
            for (int m = 0; m < 4; ++m) { mean[ai][m] = 0.f; rs[ai][m] = 0.f; }
#pragma unroll
        for (int bj = 0; bj < 2; ++bj) { const int c = col0 + bj * HALF;
            f32x4 g0 = {0.f, 0.f, 0.f, 0.f}, g1 = g0, b0 = *(const f32x4*)(bias + c), b1 = *(const f32x4*)(bias + c + 4);
#pragma unroll
            for (int ai = 0; ai < 2; ++ai)
#pragma unroll
                for (int m = 0; m < 4; ++m) { const size_t off = (size_t)(row0 + ai * HALF + m * 16) * DM + c;
                    f32x4 t0, t1;
                    if (L == 0) { const u32x4 hv = *(const u32x4*)(srcb + off);
                        const f32x4 o0 = {bflo(hv.x), bfhi(hv.x), bflo(hv.y), bfhi(hv.y)}, o1 = {bflo(hv.z), bfhi(hv.z), bflo(hv.w), bfhi(hv.w)};
                        t0 = o0 * ALPHA + b0 + acc[ai][bj][m][0]; t1 = o1 * ALPHA + b1 + acc[ai][bj][m][1]; }
                    else { t0 = acc[ai][bj][m][0] + b0; t1 = acc[ai][bj][m][1] + b1; }
                    u32x4 w; w.x = cvt_pk_bf16(t0[0], t0[1]); w.y = cvt_pk_bf16(t0[2], t0[3]); w.z = cvt_pk_bf16(t1[0], t1[1]); w.w = cvt_pk_bf16(t1[2], t1[3]); *(u32x4*)(Tbu + off) = w; } }
    }
};

template <class Epi, class Sched, bool ALIGN_EPI, bool SP2>
__device__ __forceinline__ void gemm_phase(LAS unsigned char* lds, const Sched& S, const Epi& E, const int tid) {
    const int wid = __builtin_amdgcn_readfirstlane(tid >> 6), lane = tid & 63, wr = wid >> 2, wc = wid & 3, fr = lane & 15, fq = lane >> 4;
    constexpr int K = 2048, nt = K / BK;
    unsigned voffA[2], voffB[2];
#pragma unroll
    for (int i = 0; i < 2; ++i) { int R, C; stage_rc(tid * 16 + i * 8192, R, C); const int Rb = Epi::PERM ? ((R & ~31) + perm32(R & 31)) : R;
        voffA[i] = (unsigned)(R * K + C) * 2u; voffB[i] = (unsigned)(Rb * K + C) * 2u; }
    const size_t kstep = (size_t)(BK * 2);
    const size_t hstep = (size_t)HALF * K * 2;
    const unsigned ldsw = (unsigned)wid * 1024u;
    const int aoff = lds_byte(wr * 64 + fr, fq * 8), boff = lds_byte(wc * 32 + fr, fq * 8);
#define PG8_SA(b, h) (((b) * 2 + (h)) * HTB)
#define PG8_SB(b, h) ((4 + (b) * 2 + (h)) * HTB)
#define PG8_STAGE(bufoff, gbase, voff) do { _Pragma("unroll") for (int _i = 0; _i < 2; ++_i) \
        __builtin_amdgcn_global_load_lds((const unsigned*)((const char*)(gbase) + (voff)[_i]), (LAS unsigned*)(lds + (bufoff) + ldsw + _i * 8192), 16, 0, 0); } while (0)
#define PG8_LDA(dst, b, h) do { _Pragma("unroll") for (int m = 0; m < 4; ++m) _Pragma("unroll") for (int k = 0; k < 2; ++k) dst[m][k] = *(const LAS bf16x8*)(lds + PG8_SA(b, h) + aoff + m * 2048 + k * 1024); } while (0)
#define PG8_LDB(dst, b, h) do { _Pragma("unroll") for (int n = 0; n < 2; ++n) _Pragma("unroll") for (int k = 0; k < 2; ++k) dst[n][k] = *(const LAS bf16x8*)(lds + PG8_SB(b, h) + boff + n * 2048 + k * 1024); } while (0)
#define PG8_MMA(ai, bj, At, Bt) do { __builtin_amdgcn_s_setprio(1); _Pragma("unroll") for (int m = 0; m < 4; ++m) _Pragma("unroll") for (int n = 0; n < 2; ++n) _Pragma("unroll") for (int k = 0; k < 2; ++k) \
        acc[ai][bj][m][n] = __builtin_amdgcn_mfma_f32_16x16x32_bf16(Bt[n][k], At[m][k], acc[ai][bj][m][n], 0, 0, 0); __builtin_amdgcn_s_setprio(0); } while (0)
#define PG8_WAIT_V(n) asm volatile("s_waitcnt vmcnt(" #n ")" ::: "memory")
#define PG8_WAIT_L(n) asm volatile("s_waitcnt lgkmcnt(" #n ")" ::: "memory")
#define PG8_BAR __builtin_amdgcn_s_barrier()
#define PG8_SCHED __builtin_amdgcn_sched_barrier(0)
    Unit cur, nxt; int ui = 0;
    if (!S.next(0, cur)) return;
    f32x4 acc[2][2][4][2];
#pragma unroll
    for (int a = 0; a < 2; ++a)
#pragma unroll
        for (int b = 0; b < 2; ++b)
#pragma unroll
            for (int m = 0; m < 4; ++m)
#pragma unroll
                for (int n = 0; n < 2; ++n) acc[a][b][m][n] = (f32x4){0.f, 0.f, 0.f, 0.f};
    bf16x8 At[4][2], B0[2][2], B1[2][2];
    const char* cA = cur.a; const char* cB = cur.b;
    if constexpr (SP2) {
        PG8_STAGE(PG8_SB(0, 0), cB, voffB); PG8_STAGE(PG8_SB(0, 1), cB + hstep, voffB); PG8_STAGE(PG8_SA(0, 0), cA, voffA); PG8_STAGE(PG8_SA(0, 1), cA + hstep, voffA);
        if (wr == 1) PG8_BAR;
        PG8_WAIT_V(2); PG8_BAR;
        PG8_STAGE(PG8_SB(1, 0), cB + kstep, voffB); PG8_STAGE(PG8_SA(1, 0), cA + kstep, voffA); PG8_STAGE(PG8_SB(1, 1), cB + hstep + kstep, voffB);
        PG8_WAIT_V(6); PG8_BAR;
    } else {
        PG8_STAGE(PG8_SB(0, 0), cB, voffB); PG8_STAGE(PG8_SA(0, 0), cA, voffA); PG8_STAGE(PG8_SB(0, 1), cB + hstep, voffB); PG8_STAGE(PG8_SA(0, 1), cA + hstep, voffA);
        if (wr == 1) PG8_BAR;
        PG8_WAIT_V(4); PG8_BAR;
        PG8_STAGE(PG8_SB(1, 0), cB + kstep, voffB); PG8_STAGE(PG8_SA(1, 0), cA + kstep, voffA); PG8_STAGE(PG8_SB(1, 1), cB + hstep + kstep, voffB);
        PG8_WAIT_V(6); PG8_BAR;
    }
    for (;;) {
        const bool has_next = S.next(ui + 1, nxt);
        const char* nA = has_next ? nxt.a : cA; const char* nB = has_next ? nxt.b : cB;
        for (int t = 0; t < nt; t += 2) {
            const bool last = (t == nt - 2);
            const char* a1 = cA + (size_t)(t + 1) * kstep;
            const char* a2 = last ? nA : cA + (size_t)(t + 2) * kstep; const char* b2 = last ? nB : cB + (size_t)(t + 2) * kstep;
            const char* a3 = a2 + kstep; const char* b3 = b2 + kstep;
            if constexpr (SP2) {
            PG8_LDB(B0, 0, 0); PG8_LDB(B1, 0, 1); PG8_SCHED; PG8_LDA(At, 0, 0); PG8_STAGE(PG8_SA(1, 1), a1 + hstep, voffA);
            PG8_WAIT_V(8); PG8_WAIT_L(0); PG8_BAR; PG8_MMA(0, 0, At, B0); PG8_MMA(0, 1, At, B1); PG8_BAR; PG8_SCHED;
            PG8_LDA(At, 0, 1); PG8_STAGE(PG8_SB(0, 0), b2, voffB); PG8_STAGE(PG8_SB(0, 1), b2 + hstep, voffB); PG8_STAGE(PG8_SA(0, 0), a2, voffA);
            PG8_WAIT_V(8); PG8_WAIT_L(0); PG8_BAR; PG8_MMA(1, 0, At, B0); PG8_MMA(1, 1, At, B1); PG8_BAR; PG8_SCHED;
            PG8_LDB(B0, 1, 0); PG8_LDB(B1, 1, 1); PG8_SCHED; PG8_LDA(At, 1, 0); PG8_STAGE(PG8_SA(0, 1), a2 + hstep, voffA);
            PG8_WAIT_V(8); PG8_WAIT_L(0); PG8_BAR; PG8_MMA(0, 0, At, B0); PG8_MMA(0, 1, At, B1); PG8_BAR; PG8_SCHED;
            PG8_LDA(At, 1, 1); PG8_STAGE(PG8_SB(1, 0), b3, voffB); PG8_STAGE(PG8_SB(1, 1), b3 + hstep, voffB); PG8_STAGE(PG8_SA(1, 0), a3, voffA);
            PG8_WAIT_V(8); PG8_WAIT_L(0); PG8_BAR; PG8_MMA(1, 0, At, B0); PG8_MMA(1, 1, At, B1); PG8_BAR; PG8_SCHED;
            } else {
            PG8_LDB(B0, 0, 0); PG8_SCHED; PG8_LDA(At, 0, 0); PG8_STAGE(PG8_SA(1, 1), a1 + hstep, voffA);
            PG8_WAIT_L(8); PG8_BAR; PG8_WAIT_L(0); PG8_MMA(0, 0, At, B0); PG8_BAR; PG8_SCHED;
            PG8_LDB(B1, 0, 1); PG8_STAGE(PG8_SB(0, 0), b2, voffB);
            PG8_BAR; PG8_WAIT_L(0); PG8_MMA(0, 1, At, B1); PG8_BAR;
            PG8_LDA(At, 0, 1); PG8_STAGE(PG8_SA(0, 0), a2, voffA);
            PG8_BAR; PG8_WAIT_L(0); PG8_MMA(1, 0, At, B0); PG8_BAR; PG8_SCHED;
            PG8_STAGE(PG8_SB(0, 1), b2 + hstep, voffB);
            PG8_WAIT_V(6); PG8_BAR; PG8_MMA(1, 1, At, B1); PG8_BAR;
            PG8_LDB(B0, 1, 0); PG8_SCHED; PG8_LDA(At, 1, 0); PG8_STAGE(PG8_SA(0, 1), a2 + hstep, voffA);
            PG8_WAIT_L(8); PG8_BAR; PG8_WAIT_L(0); PG8_MMA(0, 0, At, B0); PG8_BAR; PG8_SCHED;
            PG8_LDB(B1, 1, 1); PG8_STAGE(PG8_SB(1, 0), b3, voffB);
            PG8_BAR; PG8_WAIT_L(0); PG8_MMA(0, 1, At, B1); PG8_BAR;
            PG8_LDA(At, 1, 1); PG8_STAGE(PG8_SA(1, 0), a3, voffA);
            PG8_BAR; PG8_WAIT_L(0); PG8_MMA(1, 0, At, B0); PG8_BAR; PG8_SCHED;
            PG8_STAGE(PG8_SB(1, 1), b3 + hstep, voffB);
            PG8_WAIT_V(6); PG8_BAR; PG8_MMA(1, 1, At, B1); PG8_BAR;
            }
        }
        if constexpr (ALIGN_EPI) { if (wr == 0) PG8_BAR; }
        int fr_ = fr, fq_ = fq; asm volatile("" : "+v"(fr_), "+v"(fq_));
        E(acc, cur, wr, wc, fr_, fq_);
        if (!has_next) break;
#pragma unroll
        for (int a = 0; a < 2; ++a)
#pragma unroll
            for (int b = 0; b < 2; ++b)
#pragma unroll
                for (int m = 0; m < 4; ++m)
#pragma unroll
                    for (int n = 0; n < 2; ++n) acc[a][b][m][n] = (f32x4){0.f, 0.f, 0.f, 0.f};
        cur = nxt; cA = nA; cB = nB; ++ui;
        if constexpr (ALIGN_EPI) { if (wr == 1) PG8_BAR; }
    }
    PG8_WAIT_V(0);
    if constexpr (!ALIGN_EPI) { if (wr == 0) PG8_BAR; }
    PG8_BAR;
#undef PG8_SA
#undef PG8_SB
#undef PG8_STAGE
#undef PG8_LDA
#undef PG8_LDB
#undef PG8_MMA
#undef PG8_WAIT_V
#undef PG8_WAIT_L
#undef PG8_BAR
#undef PG8_SCHED
}
}

#define XB_TMO      128
#define XB_XCNT(j)  (256  + 64 * (j))
#define XB_XSUB(j)  (1280 + 64 * (j))
#define XB_XGEN(j)  (2304 + 64 * (j))
#define XB_TOP      3328
#define XB_TOPGEN   3392
#define XCD_BAR_WORDS 3456
#define XB_SPIN_CAP (1u << 22)
__device__ __forceinline__ unsigned xb_ld(unsigned* p)              { return __hip_atomic_load(p, __ATOMIC_RELAXED, __HIP_MEMORY_SCOPE_AGENT); }
__device__ __forceinline__ unsigned xb_add(unsigned* p, unsigned v) { return __hip_atomic_fetch_add(p, v, __ATOMIC_RELAXED, __HIP_MEMORY_SCOPE_AGENT); }
__device__ __forceinline__ unsigned xb_xcc_id() { return (unsigned)__builtin_amdgcn_s_getreg((3 << 11) | 20) & 0xFu; }
#define XB_SPIN(cond, bar) do { unsigned _sp = 0; while (cond) { __builtin_amdgcn_s_sleep(1); \
    if ((++_sp & 255u) == 0u) { if (xb_ld(&(bar)[XB_TMO])) break; if (_sp > XB_SPIN_CAP) { atomicAdd(&(bar)[XB_TMO], 1u); break; } } } } while (0)
struct XcdBarrier { unsigned* bar; unsigned x; volatile LAS unsigned* st; };
__device__ __forceinline__ XcdBarrier xcd_barrier_post(unsigned* bar, volatile LAS unsigned* st, int tid) {
    XcdBarrier b; b.bar = bar; b.x = xb_xcc_id(); b.st = st;
    if (tid == 0) (void)xb_add(&bar[XB_XCNT(b.x)], 1u);
    return b;
}
__device__ __forceinline__ void xcd_barrier_complete(unsigned* bar, unsigned x, unsigned& nloc, unsigned& nx) {
    const unsigned G = gridDim.x * gridDim.y * gridDim.z;
    unsigned sum, cnt, mine, sp = 0u;
    for (;;) {
        sum = 0u; cnt = 0u; mine = 0u;
#pragma unroll
        for (unsigned j = 0; j < 16; ++j) { const unsigned c = xb_ld(&bar[XB_XCNT(j)]); sum += c; cnt += (c > 0u) ? 1u : 0u; mine = (j == x) ? c : mine; }
        if (sum == G) break;
        __builtin_amdgcn_s_sleep(1);
        if ((++sp & 255u) == 0u) { if (xb_ld(&bar[XB_TMO])) break; if (sp > XB_SPIN_CAP) { atomicAdd(&bar[XB_TMO], 1u); break; } }
    }
    nloc = mine > 0u ? mine : 1u; nx = cnt > 0u ? cnt : 1u;
}
__device__ __forceinline__ void xcd_barrier(const XcdBarrier& b, int tid) {
    asm volatile("s_waitcnt vmcnt(0)" ::: "memory");
    __syncthreads();
    if (tid == 0) {
        unsigned* bar = b.bar; asm volatile("" : "+s"(bar));
        __builtin_amdgcn_s_waitcnt(0);
        unsigned nloc = b.st[0], nx = b.st[1];
        if (nloc == 0u) { xcd_barrier_complete(bar, b.x, nloc, nx); b.st[0] = nloc; b.st[1] = nx; }
        const unsigned old = xb_add(&bar[XB_XSUB(b.x)], 1u);
        const unsigned gen = old / nloc;
        if (old + 1u == (gen + 1u) * nloc) {
            __builtin_amdgcn_fence(__ATOMIC_RELEASE, "agent");
            asm volatile("s_waitcnt vmcnt(0)" ::: "memory");
            const unsigned og = xb_add(&bar[XB_TOP], 1u);
            const unsigned tg = og / nx;
            if (og + 1u == (tg + 1u) * nx) xb_add(&bar[XB_TOPGEN], 1u);
            else XB_SPIN(xb_ld(&bar[XB_TOPGEN]) == tg, bar);
            __builtin_amdgcn_fence(__ATOMIC_ACQUIRE, "agent");
            xb_add(&bar[XB_XGEN(b.x)], 1u);
            asm volatile("s_waitcnt vmcnt(0)" ::: "memory");
        } else {
            XB_SPIN(xb_ld(&bar[XB_XGEN(b.x)]) == gen, bar);
            __builtin_amdgcn_fence(__ATOMIC_ACQUIRE, "agent");
            asm volatile("s_waitcnt vmcnt(0)" ::: "memory");
        }
    }
    __syncthreads();
}

struct Args { const float* in[14]; float* out; unsigned char* ws; int ph_lo, ph_hi; };

struct Ctx {
    LAS unsigned char* lds; int tid, lane, wave, G, bid;
    const float *x, *emb_g, *emb_b, *w_in, *b_in, *w_out, *b_out, *ln_g, *ln_b, *t5, *sink, *fbias, *norm_g, *rpb;
    float* out; unsigned char* ws;
    bf16* hby; bf16* yb; bf16* unat; bf16* ut; bf16* cst; float* nst; float* gs; float* ml; float* mprev; float* gate; float* stat;
};

__device__ __forceinline__ int src_col_of_row(int r) {
    if (r < 768) return r;
    if (r < 1024) return r - 768 + 768;
    if (r < 1792) return r - 1024 + 1280;
    if (r < 2304) return r - 1792 + 2048;
    if (r < 2816) return r - 2304 + 2560;
    if (r < 3328) return r - 2816 + 3584;
    if (r < 3840) return r - 3328 + 4096;
    if (r < 4608) return r - 3840 + 4624;
    if (r < 5376) return r - 4608 + 5392;
    if (r < 6144) return r - 5376 + 6928;
    if (r < 6400) return r - 6144 + 1024;
    if (r < 6912) return r - 6400 + 2560;
    if (r < 7424) return r - 6912 + 3072;
    if (r < 8192) return r - 7424 + 6160;
    return r - 8192 + 4608;
}
__device__ __forceinline__ void ln_row(const float* xrow, float* orow, bf16* brow, float* stat, const float* g, const float* b, int lane) {
    f32x4 v[8]; float s = 0.f;
#pragma unroll
    for (int j = 0; j < 8; ++j) { v[j] = *(const f32x4*)(xrow + 4 * (lane + 64 * j)); s += (v[j][0] + v[j][1]) + (v[j][2] + v[j][3]); }
    const float mean = wave_sum(s, lane) * (1.f / DM); float q = 0.f;
#pragma unroll
    for (int j = 0; j < 8; ++j) { v[j] = v[j] - mean; q += (v[j][0] * v[j][0] + v[j][1] * v[j][1]) + (v[j][2] * v[j][2] + v[j][3] * v[j][3]); }
    const float rstd = 1.f / sqrtf(wave_sum(q, lane) * (1.f / DM) + LN_EPS);
    if (stat && lane == 0) { stat[0] = mean; stat[1] = rstd; }
#pragma unroll
    for (int j = 0; j < 8; ++j) { const int c = 4 * (lane + 64 * j); const f32x4 gg = *(const f32x4*)(g + c), bb = *(const f32x4*)(b + c);
        const f32x4 o = v[j] * rstd * gg + bb;
        if (orow) *(f32x4*)(orow + c) = o;
        if (brow) { u32x2 w; w.x = cvt_pk_bf16(o[0], o[1]); w.y = cvt_pk_bf16(o[2], o[3]); *(u32x2*)(brow + c) = w; } }
}

__device__ __forceinline__ void ln_row2(const float* x0, const float* x1, float* o0, float* o1, bf16* b0, bf16* b1, float* st0, float* st1, const float* g, const float* b, int lane) {
    f32x4 v[8], u[8]; float s = 0.f, s_ = 0.f;
#pragma unroll
    for (int j = 0; j < 8; ++j) { v[j] = *(const f32x4*)(x0 + 4 * (lane + 64 * j)); u[j] = *(const f32x4*)(x1 + 4 * (lane + 64 * j)); }
#pragma unroll
    for (int j = 0; j < 8; ++j) { s += (v[j][0] + v[j][1]) + (v[j][2] + v[j][3]); s_ += (u[j][0] + u[j][1]) + (u[j][2] + u[j][3]); }
#pragma unroll
    for (int o = 1; o < 64; o <<= 1) { s += shx(s, o, lane); s_ += shx(s_, o, lane); }
    const float mean = s * (1.f / DM), mean_ = s_ * (1.f / DM); float q = 0.f, q_ = 0.f;
#pragma unroll
    for (int j = 0; j < 8; ++j) { v[j] = v[j] - mean; u[j] = u[j] - mean_; q += (v[j][0] * v[j][0] + v[j][1] * v[j][1]) + (v[j][2] * v[j][2] + v[j][3] * v[j][3]); q_ += (u[j][0] * u[j][0] + u[j][1] * u[j][1]) + (u[j][2] * u[j][2] + u[j][3] * u[j][3]); }
#pragma unroll
    for (int o = 1; o < 64; o <<= 1) { q += shx(q, o, lane); q_ += shx(q_, o, lane); }
    const float rstd = 1.f / sqrtf(q * (1.f / DM) + LN_EPS), rstd_ = 1.f / sqrtf(q_ * (1.f / DM) + LN_EPS);
    if (st0 && lane == 0) { st0[0] = mean; st0[1] = rstd; st1[0] = mean_; st1[1] = rstd_; }
#pragma unroll
    for (int j = 0; j < 8; ++j) { const int c = 4 * (lane + 64 * j); const f32x4 gg = *(const f32x4*)(g + c), bb = *(const f32x4*)(b + c);
        const f32x4 o = v[j] * rstd * gg + bb, p = u[j] * rstd_ * gg + bb;
        if (o0) { *(f32x4*)(o0 + c) = o; *(f32x4*)(o1 + c) = p; }
        if (b0) { u32x2 w; w.x = cvt_pk_bf16(o[0], o[1]); w.y = cvt_pk_bf16(o[2], o[3]); *(u32x2*)(b0 + c) = w; u32x2 w2; w2.x = cvt_pk_bf16(p[0], p[1]); w2.y = cvt_pk_bf16(p[2], p[3]); *(u32x2*)(b1 + c) = w2; } }
}

__device__ __forceinline__ void ln_row2_b(const bf16* x0, const bf16* x1, bf16* b0, bf16* b1, float* st0, float* st1, const float* g, const float* b, int lane) {
    f32x4 v[8], u[8]; float s = 0.f, s_ = 0.f;
#pragma unroll
    for (int j = 0; j < 4; ++j) { const u32x4 p = *(const u32x4*)(x0 + 8 * (lane + 64 * j)), q = *(const u32x4*)(x1 + 8 * (lane + 64 * j));
        v[2 * j] = (f32x4){bflo(p.x), bfhi(p.x), bflo(p.y), bfhi(p.y)}; v[2 * j + 1] = (f32x4){bflo(p.z), bfhi(p.z), bflo(p.w), bfhi(p.w)};
        u[2 * j] = (f32x4){bflo(q.x), bfhi(q.x), bflo(q.y), bfhi(q.y)}; u[2 * j + 1] = (f32x4){bflo(q.z), bfhi(q.z), bflo(q.w), bfhi(q.w)}; }
#pragma unroll
    for (int j = 0; j < 8; ++j) { s += (v[j][0] + v[j][1]) + (v[j][2] + v[j][3]); s_ += (u[j][0] + u[j][1]) + (u[j][2] + u[j][3]); }
#pragma unroll
    for (int o = 1; o < 64; o <<= 1) { s += shx(s, o, lane); s_ += shx(s_, o, lane); }
    const float mean = s * (1.f / DM), mean_ = s_ * (1.f / DM); float q = 0.f, q_ = 0.f;
#pragma unroll
    for (int j = 0; j < 8; ++j) { v[j] = v[j] - mean; u[j] = u[j] - mean_; q += (v[j][0] * v[j][0] + v[j][1] * v[j][1]) + (v[j][2] * v[j][2] + v[j][3] * v[j][3]); q_ += (u[j][0] * u[j][0] + u[j][1] * u[j][1]) + (u[j][2] * u[j][2] + u[j][3] * u[j][3]); }
#pragma unroll
    for (int o = 1; o < 64; o <<= 1) { q += shx(q, o, lane); q_ += shx(q_, o, lane); }
    const float rstd = 1.f / sqrtf(q * (1.f / DM) + LN_EPS), rstd_ = 1.f / sqrtf(q_ * (1.f / DM) + LN_EPS);
    if (lane == 0) { st0[0] = mean; st0[1] = rstd; st1[0] = mean_; st1[1] = rstd_; }
#pragma unroll
    for (int j = 0; j < 4; ++j) { const int c = 8 * (lane + 64 * j);
        const f32x4 g0 = *(const f32x4*)(g + c), g1 = *(const f32x4*)(g + c + 4), bb0 = *(const f32x4*)(b + c), bb1 = *(const f32x4*)(b + c + 4);
        const f32x4 o0 = v[2 * j] * rstd * g0 + bb0, o1 = v[2 * j + 1] * rstd * g1 + bb1, p0 = u[2 * j] * rstd_ * g0 + bb0, p1 = u[2 * j + 1] * rstd_ * g1 + bb1;
        u32x4 w; w.x = cvt_pk_bf16(o0[0], o0[1]); w.y = cvt_pk_bf16(o0[2], o0[3]); w.z = cvt_pk_bf16(o1[0], o1[1]); w.w = cvt_pk_bf16(o1[2], o1[3]); *(u32x4*)(b0 + c) = w;
        u32x4 w2; w2.x = cvt_pk_bf16(p0[0], p0[1]); w2.y = cvt_pk_bf16(p0[2], p0[3]); w2.z = cvt_pk_bf16(p1[0], p1[1]); w2.w = cvt_pk_bf16(p1[2], p1[3]); *(u32x4*)(b1 + c) = w2; }
}

__device__ __forceinline__ void fin_row2(const bf16* t1, const bf16* o2, const float* st, const float* g0, const float* b0, const float* g1, const float* b1, float* out, int lane) {
    f32x4 v[8], u[8]; float s = 0.f, s_ = 0.f;
    const float mA = st[0], rA = st[1] * ALPHA, mB = st[2], rB = st[3] * ALPHA;
#pragma unroll
    for (int j = 0; j < 4; ++j) { const int c = 8 * (lane + 64 * j);
        const u32x4 p = *(const u32x4*)(t1 + c), q = *(const u32x4*)(t1 + DM + c), x = *(const u32x4*)(o2 + c), y = *(const u32x4*)(o2 + DM + c);
        const f32x4 ga = *(const f32x4*)(g0 + c), gb = *(const f32x4*)(g0 + c + 4), ba = *(const f32x4*)(b0 + c) * ALPHA, bb = *(const f32x4*)(b0 + c + 4) * ALPHA;
        v[2 * j] = ((f32x4){bflo(p.x), bfhi(p.x), bflo(p.y), bfhi(p.y)} - mA) * rA * ga + ba + (f32x4){bflo(x.x), bfhi(x.x), bflo(x.y), bfhi(x.y)};
        v[2 * j + 1] = ((f32x4){bflo(p.z), bfhi(p.z), bflo(p.w), bfhi(p.w)} - mA) * rA * gb + bb + (f32x4){bflo(x.z), bfhi(x.z), bflo(x.w), bfhi(x.w)};
        u[2 * j] = ((f32x4){bflo(q.x), bfhi(q.x), bflo(q.y), bfhi(q.y)} - mB) * rB * ga + ba + (f32x4){bflo(y.x), bfhi(y.x), bflo(y.y), bfhi(y.y)};
        u[2 * j + 1] = ((f32x4){bflo(q.z), bfhi(q.z), bflo(q.w), bfhi(q.w)} - mB) * rB * gb + bb + (f32x4){bflo(y.z), bfhi(y.z), bflo(y.w), bfhi(y.w)}; }
#pragma unroll
    for (int j = 0; j < 8; ++j) { s += (v[j][0] + v[j][1]) + (v[j][2] + v[j][3]); s_ += (u[j][0] + u[j][1]) + (u[j][2] + u[j][3]); }
#pragma unroll
    for (int o = 1; o < 64; o <<= 1) { s += shx(s, o, lane); s_ += shx(s_, o, lane); }
    const float mean = s * (1.f / DM), mean_ = s_ * (1.f / DM); float q2 = 0.f, q2_ = 0.f;
#pragma unroll
    for (int j = 0; j < 8; ++j) { v[j] = v[j] - mean; u[j] = u[j] - mean_; q2 += (v[j][0] * v[j][0] + v[j][1] * v[j][1]) + (v[j][2] * v[j][2] + v[j][3] * v[j][3]); q2_ += (u[j][0] * u[j][0] + u[j][1] * u[j][1]) + (u[j][2] * u[j][2] + u[j][3] * u[j][3]); }
#pragma unroll
    for (int o = 1; o < 64; o <<= 1) { q2 += shx(q2, o, lane); q2_ += shx(q2_, o, lane); }
    const float rstd = 1.f / sqrtf(q2 * (1.f / DM) + LN_EPS), rstd_ = 1.f / sqrtf(q2_ * (1.f / DM) + LN_EPS);
#pragma unroll
    for (int j = 0; j < 4; ++j) { const int c = 8 * (lane + 64 * j);
        const f32x4 ga = *(const f32x4*)(g1 + c), gb = *(const f32x4*)(g1 + c + 4), ba = *(const f32x4*)(b1 + c), bb = *(const f32x4*)(b1 + c + 4);
        *(f32x4*)(out + c) = v[2 * j] * rstd * ga + ba; *(f32x4*)(out + c + 4) = v[2 * j + 1] * rstd * gb + bb;
        *(f32x4*)(out + DM + c) = u[2 * j] * rstd_ * ga + ba; *(f32x4*)(out + DM + c + 4) = u[2 * j + 1] * rstd_ * gb + bb; }
}

__device__ __forceinline__ bf16* t1_row(unsigned char* ws, int m) { return m < 8192 ? (bf16*)(ws + WS_WIN) + (size_t)m * DM : (bf16*)(ws + WS_T1B) + (size_t)(m - 8192) * DM; }
struct TrItem { const float* src; bf16* dst; int ldw, nvalid; };
__device__ __forceinline__ void tr_load(const TrItem& t, float (&wv)[32], int lane) {
#pragma unroll
    for (int i = 0; i < 8; ++i) { const int kk = 8 * i + (lane >> 3); const f32x4 v = *(const f32x4*)(t.src + (size_t)kk * t.ldw + 4 * (lane & 7));
        wv[4 * i] = v[0]; wv[4 * i + 1] = v[1]; wv[4 * i + 2] = v[2]; wv[4 * i + 3] = v[3]; }
}
__device__ __forceinline__ void tr_store(const TrItem& t, const float (&wv)[32], LAS float* scr, int lane) {
#pragma unroll
    for (int i = 0; i < 8; ++i) { const int kk = 8 * i + (lane >> 3); LAS float* d = scr + kk * 33 + 4 * (lane & 7); d[0] = wv[4 * i]; d[1] = wv[4 * i + 1]; d[2] = wv[4 * i + 2]; d[3] = wv[4 * i + 3]; }
    LDS_WAIT();
    const int c = lane & 7;
#pragma unroll
    for (int j = 0; j < 4; ++j) { const int n = (lane >> 3) + 8 * j; const LAS float* sp = scr + (8 * c) * 33 + n;
        u32x4 o; o.x = cvt_pk_bf16(sp[0 * 33], sp[1 * 33]); o.y = cvt_pk_bf16(sp[2 * 33], sp[3 * 33]); o.z = cvt_pk_bf16(sp[4 * 33], sp[5 * 33]); o.w = cvt_pk_bf16(sp[6 * 33], sp[7 * 33]);
        if (n < t.nvalid) *(u32x4*)(t.dst + (size_t)n * 2048 + 8 * c) = o; }
    LDS_WAIT();
}
__device__ __forceinline__ bool tr_item(const Ctx& F, int l, int it, TrItem& t) {
    constexpr int I_IN = 241 * 32, I_OUT = 64 * 32;
    if (it >= I_IN + I_OUT) return false;
    if (it < I_IN) { int rb = it >> 5; const int kb = it & 31; rb = rb < 200 ? rb : rb + 16;
        t.ldw = IN_W; t.nvalid = rb == 256 ? 16 : 32; t.src = F.w_in + (size_t)l * DM * IN_W + (size_t)(kb * 64) * IN_W + src_col_of_row(rb * 32);
        t.dst = (bf16*)(F.ws + WS_WIN + l * WIN_STRIDE) + (size_t)rb * 32 * 2048 + kb * 64; }
    else { const int r = it - I_IN, rb = r >> 5, kb = r & 31;
        t.ldw = DM; t.nvalid = 32; t.src = F.w_out + (size_t)l * DM * DM + (size_t)(kb * 64) * DM + rb * 32;
        t.dst = (bf16*)(F.ws + WS_WOUT + l * WOUT_STRIDE) + (size_t)rb * 32 * 2048 + kb * 64; }
    return true;
}
__device__ __forceinline__ void weights_job(Ctx& F, int l, int gw, int ngw) {
    LAS float* scr = (LAS float*)(F.lds + F.wave * 16384);
    TrItem ta, tb; float wa[32], wb[32];
    int it = gw; bool ha = tr_item(F, l, it, ta), hb;
    if (ha) tr_load(ta, wa, F.lane);
    while (ha) {
        it += ngw; hb = tr_item(F, l, it, tb); if (hb) tr_load(tb, wb, F.lane);
        tr_store(ta, wa, scr, F.lane);
        if (!hb) break;
        it += ngw; ha = tr_item(F, l, it, ta); if (ha) tr_load(ta, wa, F.lane);
        tr_store(tb, wb, scr, F.lane);
    }
}
__device__ __forceinline__ void helper_of(const Ctx& F, int l, bool& is_h, int& hid, int& nh) { (void)l; if (F.G == 256) { is_h = F.bid >= 128; hid = F.bid - 128; nh = 128; } else { is_h = true; hid = F.bid; nh = F.G; } }
__device__ __forceinline__ void phase_prologue(Ctx& F) {
    const int gw = F.bid * NWAVES + F.wave, NGW = F.G * NWAVES;
    weights_job(F, 0, gw, NGW);
    for (int i = F.bid * NTHR + F.tid; i < 2 * WROWS; i += F.G * NTHR) { const int l = i / WROWS, r = i % WROWS; ((float*)(F.ws + WS_BIAS))[i] = F.b_in[l * IN_W + src_col_of_row(r)]; }
    for (int m = 2 * gw; m < M; m += 2 * NGW) ln_row2(F.x + (size_t)m * DM, F.x + (size_t)(m + 1) * DM, (float*)nullptr, (float*)nullptr, F.hby + (size_t)m * DM, F.hby + (size_t)(m + 1) * DM, F.stat + (size_t)m * 2, F.stat + (size_t)(m + 1) * 2, F.emb_g, F.emb_b, F.lane);
}

__device__ __forceinline__ void gates_job(Ctx& F, int l) {
    const bf16* Wg = (const bf16*)(F.ws + WS_WIN + l * WIN_STRIDE) + (size_t)8192 * 2048;
    const float* bg = (const float*)(F.ws + WS_BIAS) + l * WROWS + 8192;
    LAS f32x4* red = (LAS f32x4*)F.lds;
    const int w = F.wave, fr = F.lane & 15, fq = F.lane >> 4;
    bool is_h; int hid, nh; helper_of(F, l, is_h, hid, nh); if (!is_h) return;
    for (int rb = hid; rb < M / 64; rb += nh) {
        const bf16* bp = Wg + (size_t)fr * 2048 + w * 256 + 8 * fq;
        f32x4 acc[4];
#pragma unroll
        for (int tt = 0; tt < 4; ++tt) acc[tt] = (f32x4){0.f, 0.f, 0.f, 0.f};
        bf16x8 bfr[8], afr[4][8];
#pragma unroll
        for (int i = 0; i < 8; ++i) bfr[i] = *(const bf16x8*)(bp + 32 * i);
#pragma unroll
        for (int tt = 0; tt < 4; ++tt)
#pragma unroll
            for (int i = 0; i < 8; ++i) afr[tt][i] = *(const bf16x8*)(F.hby + (size_t)(rb * 64 + tt * 16 + fr) * DM + w * 256 + 8 * fq + 32 * i);
#pragma unroll
        for (int i = 0; i < 8; ++i)
#pragma unroll
            for (int tt = 0; tt < 4; ++tt) acc[tt] = __builtin_amdgcn_mfma_f32_16x16x32_bf16(afr[tt][i], bfr[i], acc[tt], 0, 0, 0);
#pragma unroll
        for (int tt = 0; tt < 4; ++tt) red[(w * 4 + tt) * 64 + F.lane] = acc[tt];
        __syncthreads();
        if (w < 4) { f32x4 o = red[w * 64 + F.lane];
#pragma unroll
            for (int ww = 1; ww < 8; ++ww) o = o + red[(ww * 4 + w) * 64 + F.lane];
            const float bb = bg[fr];
#pragma unroll
            for (int j = 0; j < 4; ++j) F.gate[(size_t)(rb * 64 + w * 16 + 4 * fq + j) * 16 + fr] = o[j] + bb; }
        __syncthreads();
    }
}

constexpr int WA_K = 0, WA_V = 65536, WA_VSTR = 1032, WA_TB = WA_V + 64 * WA_VSTR  , WA_TBS = 320, WA_END = WA_TB + 3 * WA_TBS * 4;
static_assert(WA_END <= MISC_OFF, "WA LDS map");
__device__ __forceinline__ void wattn_item(Ctx& F, int item, int l) {
    const int b = item >> 6, kvh = (item >> 4) & 3, p = item & 15;
    const int tokb = b * SEQ, kpos0 = 256 * p - 128;
    LAS unsigned char* lds = F.lds;
    {
        u32x4 kr[8], vr[8];
        const int kc0 = F.tid >> 3, c = F.tid & 7;
#pragma unroll
        for (int j = 0; j < 8; ++j) { const int kk = kc0 + 64 * j; int pos = kpos0 + kk; pos = pos < 0 ? 0 : (pos > SEQ - 1 ? SEQ - 1 : pos);
            kr[j] = *(const u32x4*)(F.unat + (size_t)(tokb + pos) * LDN + N_AK + kvh * 64 + c * 8); }
        const int d0 = F.tid >> 6, cc = F.tid & 63;
        int vpos = kpos0 + cc * 8; vpos = vpos < 0 ? 0 : (vpos > SEQ - 8 ? SEQ - 8 : vpos);
#pragma unroll
        for (int j = 0; j < 8; ++j) vr[j] = *(const u32x4*)(F.ut + (size_t)(T_AV + kvh * 64 + d0 + 8 * j) * M + tokb + vpos);
#pragma unroll
        for (int j = 0; j < 8; ++j) { const int kk = kc0 + 64 * j; *(LAS u32x4*)(lds + WA_K + kk * 128 + ((c ^ ((kk >> 1) & 7)) << 4)) = kr[j]; }
#pragma unroll
        for (int j = 0; j < 8; ++j) { LAS unsigned char* dst = lds + WA_V + (d0 + 8 * j) * WA_VSTR + cc * 16;
            *(LAS u32x2*)dst = (u32x2){vr[j].x, vr[j].y}; *(LAS u32x2*)(dst + 8) = (u32x2){vr[j].z, vr[j].w}; }
    }
    LAS float* tbw = (LAS float*)(lds + WA_TB);
    for (int i = F.tid; i < 3 * WA_TBS; i += NTHR) { const int g = i / WA_TBS, idx = i % WA_TBS - 31; tbw[i] = (idx >= 0 && idx <= 256) ? F.t5[t5_bucket(idx - 128) * 12 + kvh * 3 + g] * LOG2E : -INFINITY; }
    const int qt = F.wave, r = F.lane & 31, h = F.lane >> 5, ql = 32 * qt + r;
    const int tokq = tokb + 256 * p + ql;
    unsigned bad[16];
#pragma unroll
    for (int i = 0; i < 16; ++i) bad[i] = (unsigned)(WA_TB + (crow(i, h) - r + 31) * 4);
    bf16x8 qf[4];
#pragma unroll
    for (int s = 0; s < 4; ++s) qf[s] = *(const bf16x8*)(F.unat + (size_t)tokq * LDN + N_AQ + (kvh * 3) * 64 + 16 * s + 8 * h);
    __syncthreads();
    const int dlo = (p == 0) ? ((4 - qt) > 0 ? (4 - qt) : 0) : 0;
    const int dhi = (p == 15) ? ((12 - qt) < 9 ? (12 - qt) : 9) : 9;
#pragma unroll 1
    for (int g = 0; g < 3; ++g) {
        const int head = kvh * 3 + g;
        bf16x8 qn[4];
        if (g < 2) {
#pragma unroll
            for (int s = 0; s < 4; ++s) qn[s] = *(const bf16x8*)(F.unat + (size_t)tokq * LDN + N_AQ + (head + 1) * 64 + 16 * s + 8 * h);
        } else {
#pragma unroll
            for (int s = 0; s < 4; ++s) qn[s] = qf[s];
        }
        const bf16* zp = F.unat + (size_t)tokq * LDN + N_AZ + head * 64 + 8 * h;
        u32x2 zz[8];
#pragma unroll
        for (int p = 0; p < 4; ++p) { const u32x4 q_ = *(const u32x4*)(zp + 16 * p); zz[2 * p] = (u32x2){q_.x, q_.y}; zz[2 * p + 1] = (u32x2){q_.z, q_.w}; }
        float m = F.sink[l * 12 + head] * LOG2E, lsum = h ? 0.f : 1.f;
        f32x16 O0 = zero16(), O1 = zero16();
        const unsigned goff = (unsigned)(g * WA_TBS * 4);
#pragma unroll
        for (int dt_ = 0; dt_ < 9; ++dt_) {
            if (dt_ >= dlo && dt_ < dhi) {
                const int kt = qt + dt_;
                f32x16 S = zero16();
                const int krow_ = kt * 32 + r;
#pragma unroll
                for (int s = 0; s < 4; ++s) { const bf16x8 kf = *(const LAS bf16x8*)(lds + WA_K + krow_ * 128 + (((2 * s + h) ^ ((krow_ >> 1) & 7)) << 4)); S = MFMA32(kf, qf[s], S); }
                float bs[16];
#pragma unroll
                for (int i = 0; i < 16; ++i) bs[i] = *(const LAS float*)(lds + (bad[i] + goff) + dt_ * 128);
                float mx = -INFINITY;
#pragma unroll
                for (int i = 0; i < 16; ++i) { const float sv = fmaf(S[i], C2A, bs[i]); S[i] = sv; mx = fmaxf(mx, sv); }
                if (__builtin_amdgcn_ballot_w64(mx > m + 6.f) != 0ull) {
                    mx = fmaxf(mx, shx(mx, 32, F.lane));
                    const float mn = fmaxf(m, mx), al = ex2(m - mn); m = mn; lsum *= al;
#pragma unroll
                    for (int i = 0; i < 16; ++i) { O0[i] *= al; O1[i] *= al; }
                }
#pragma unroll
                for (int i = 0; i < 16; ++i) { const float pv = ex2(S[i] - m); S[i] = pv; lsum += pv; }
                const bf16x8 pb0 = pack8(S, 0), pb1 = pack8(S, 1);
#pragma unroll
                for (int s2 = 0; s2 < 2; ++s2) {
                    const int kof = (kt * 32 + 16 * s2 + 4 * h) * 2;
                    const s16x4 a0 = *(const LAS s16x4*)(lds + WA_V + r * WA_VSTR + kof), a1 = *(const LAS s16x4*)(lds + WA_V + r * WA_VSTR + kof + 16);
                    const s16x4 c0 = *(const LAS s16x4*)(lds + WA_V + (32 + r) * WA_VSTR + kof), c1 = *(const LAS s16x4*)(lds + WA_V + (32 + r) * WA_VSTR + kof + 16);
                    const bf16x8 v0 = __builtin_shufflevector(a0, a1, 0, 1, 2, 3, 4, 5, 6, 7), v1 = __builtin_shufflevector(c0, c1, 0, 1, 2, 3, 4, 5, 6, 7);
                    O0 = MFMA32(v0, s2 ? pb1 : pb0, O0); O1 = MFMA32(v1, s2 ? pb1 : pb0, O1);
                }
            }
        }
        lsum += shx(lsum, 32, F.lane);
        const float inv = frcp(lsum);
        bf16* yp = F.yb + (size_t)tokq * DM + head * 64 + 8 * h;
#pragma unroll
        for (int p = 0; p < 4; ++p) { const auto sx = __builtin_amdgcn_permlane32_swap(zz[2 * p].x, zz[2 * p + 1].x, false, false), sy = __builtin_amdgcn_permlane32_swap(zz[2 * p].y, zz[2 * p + 1].y, false, false);
            zz[2 * p] = (u32x2){sx[0], sy[0]}; zz[2 * p + 1] = (u32x2){sx[1], sy[1]}; }
#pragma unroll
        for (int dt = 0; dt < 2; ++dt) {
            u32x2 wy[4];
#pragma unroll
            for (int g4 = 0; g4 < 4; ++g4) { const u32x2 z2 = zz[dt * 4 + g4];
                const f32x16& O = dt ? O1 : O0;
                const float y0 = O[4 * g4] * inv * silu(bflo(z2.x)), y1 = O[4 * g4 + 1] * inv * silu(bfhi(z2.x)), y2 = O[4 * g4 + 2] * inv * silu(bflo(z2.y)), y3 = O[4 * g4 + 3] * inv * silu(bfhi(z2.y));
                wy[g4].x = cvt_pk_bf16(y0, y1); wy[g4].y = cvt_pk_bf16(y2, y3); }
#pragma unroll
            for (int p = 0; p < 2; ++p) { const auto sx = __builtin_amdgcn_permlane32_swap(wy[2 * p].x, wy[2 * p + 1].x, false, false), sy = __builtin_amdgcn_permlane32_swap(wy[2 * p].y, wy[2 * p + 1].y, false, false);
                u32x4 o; o.x = sx[0]; o.y = sy[0]; o.z = sx[1]; o.w = sy[1]; *(u32x4*)(yp + 32 * dt + 16 * p) = o; }
        }
#pragma unroll
        for (int s = 0; s < 4; ++s) qf[s] = qn[s];
    }
    __syncthreads();
}

constexpr int NA_K = 0, NA_V = 73728, NA_VSTR = 1160, NA_TB = NA_V + 64 * NA_VSTR  , NA_TI = NA_TB + 480 * 4  , NA_X = NA_TI + 2048, NA_XQ = 2560, NA_END = NA_X + 4 * NA_XQ;
static_assert(NA_END <= MISC_OFF, "NA LDS map");
struct NaRegs { u32x4 k[9]; u32x4 v[9]; };
__device__ __forceinline__ void na_decode(int item, int& b, int& head, int& r0, int& rs0) { b = item / 384; head = (item / 32) % 12; r0 = 2 * (item & 31); int t = r0 - 4; rs0 = t < 0 ? 0 : (t > 56 ? 56 : t); }
__device__ __forceinline__ void na_row_issue(Ctx& F, int b, int head, int gr, u32x4& kreg, u32x4& vreg) {
    const int kc = F.tid >> 3, c = F.tid & 7;
    kreg = *(const u32x4*)(F.unat + (size_t)(b * SEQ + gr * 64 + kc) * LDN + N_CK + head * 64 + c * 8);
    vreg = *(const u32x4*)(F.ut + (size_t)(T_CV + head * 64 + kc) * M + b * SEQ + gr * 64 + c * 8);
}
__device__ __forceinline__ void na_row_commit(Ctx& F, int gr, const u32x4& kreg, const u32x4& vreg) {
    const int kc = F.tid >> 3, c = F.tid & 7, slot = gr % 9, kk = slot * 64 + kc;
    *(LAS u32x4*)(F.lds + NA_K + kk * 128 + ((c ^ ((kk >> 1) & 7)) << 4)) = kreg;
    LAS unsigned char* dst = F.lds + NA_V + kc * NA_VSTR + (slot * 64 + c * 8) * 2;
    *(LAS u32x2*)dst = (u32x2){vreg.x, vreg.y}; *(LAS u32x2*)(dst + 8) = (u32x2){vreg.z, vreg.w};
}
#define SCHED_FENCE() __builtin_amdgcn_sched_barrier(0)
template <int CH>
__device__ __forceinline__ void na_tiles(LAS unsigned char* lds, const bf16x8 (&qf)[4], const unsigned (&badf)[16], const unsigned (&badc)[4], int rsj, int khalf, int r, int h,
                                         float& m, float& lsum, f32x16& O0, f32x16& O1) {
    bf16x8 kc[4];
    { const int kb0 = ((rsj + 4 * khalf) % 9) * 64, krow_ = kb0 + r;
#pragma unroll
      for (int s = 0; s < 4; ++s) kc[s] = *(const LAS bf16x8*)(lds + NA_K + krow_ * 128 + (((2 * s + h) ^ ((krow_ >> 1) & 7)) << 4)); }
#pragma unroll
    for (int it = 0; it < 8; ++it) {
        const int kri = it >> 1, kct = it & 1;
        const bool full = (kct == CH);
        const int kbase = ((rsj + 4 * khalf + kri) % 9) * 64 + kct * 32;
        s16x4 va[2][2], vc[2][2]; float bs[16];
#pragma unroll
        for (int s2 = 0; s2 < 2; ++s2) if (full || s2 == (kct ? 0 : 1)) {
            const int kof = (kbase + 16 * s2 + 4 * h) * 2;
            va[s2][0] = *(const LAS s16x4*)(lds + NA_V + r * NA_VSTR + kof); va[s2][1] = *(const LAS s16x4*)(lds + NA_V + r * NA_VSTR + kof + 16);
            vc[s2][0] = *(const LAS s16x4*)(lds + NA_V + (32 + r) * NA_VSTR + kof); vc[s2][1] = *(const LAS s16x4*)(lds + NA_V + (32 + r) * NA_VSTR + kof + 16);
        }
        if (full) {
#pragma unroll
            for (int i = 0; i < 16; ++i) bs[i] = *(const LAS float*)(lds + badf[i] + kri * 128);
        } else {
#pragma unroll
            for (int i = 0; i < 4; ++i) bs[i] = *(const LAS float*)(lds + badc[i] + kri * 128);
        }
        SCHED_FENCE();
        f32x16 S = zero16();
#pragma unroll
        for (int s = 0; s < 4; ++s) S = MFMA32(kc[s], qf[s], S);
        if (it < 7) { const int nb = ((rsj + 4 * khalf + ((it + 1) >> 1)) % 9) * 64 + ((it + 1) & 1) * 32, krow_ = nb + r;
#pragma unroll
            for (int s = 0; s < 4; ++s) kc[s] = *(const LAS bf16x8*)(lds + NA_K + krow_ * 128 + (((2 * s + h) ^ ((krow_ >> 1) & 7)) << 4)); }
        SCHED_FENCE();
        constexpr int NV = 16;
        const int i0 = full ? 0 : (kct ? 0 : 12), nv = full ? NV : 4;
        float mx = -INFINITY;
#pragma unroll
        for (int i = 0; i < NV; ++i) if (i < nv) { const float sv = fmaf(S[i0 + i], C2A, bs[i]); bs[i] = sv; mx = fmaxf(mx, sv); }
        { const auto sw = __builtin_amdgcn_permlane32_swap(__float_as_uint(mx), __float_as_uint(mx), false, false); mx = fmaxf(__uint_as_float(sw[0]), __uint_as_float(sw[1])); }
        const float mn = fmaxf(m, mx), al = ex2(m - mn); m = mn; lsum *= al;
#pragma unroll
        for (int i = 0; i < 16; ++i) { O0[i] *= al; O1[i] *= al; }
#pragma unroll
        for (int i = 0; i < NV; ++i) if (i < nv) { const float pv = ex2(bs[i] - mn); bs[i] = pv; lsum += pv; }
        if (full) {
            u32x4 p0, p1;
            p0.x = cvt_pk_bf16(bs[0], bs[1]); p0.y = cvt_pk_bf16(bs[2], bs[3]); p0.z = cvt_pk_bf16(bs[4], bs[5]); p0.w = cvt_pk_bf16(bs[6], bs[7]);
            p1.x = cvt_pk_bf16(bs[8], bs[9]); p1.y = cvt_pk_bf16(bs[10], bs[11]); p1.z = cvt_pk_bf16(bs[12], bs[13]); p1.w = cvt_pk_bf16(bs[14], bs[15]);
            const bf16x8 pb0 = __builtin_bit_cast(bf16x8, p0), pb1 = __builtin_bit_cast(bf16x8, p1);
            O0 = MFMA32(__builtin_shufflevector(va[0][0], va[0][1], 0, 1, 2, 3, 4, 5, 6, 7), pb0, O0); O1 = MFMA32(__builtin_shufflevector(vc[0][0], vc[0][1], 0, 1, 2, 3, 4, 5, 6, 7), pb0, O1);
            O0 = MFMA32(__builtin_shufflevector(va[1][0], va[1][1], 0, 1, 2, 3, 4, 5, 6, 7), pb1, O0); O1 = MFMA32(__builtin_shufflevector(vc[1][0], vc[1][1], 0, 1, 2, 3, 4, 5, 6, 7), pb1, O1);
        } else {
            u32x4 pw; const unsigned p01 = cvt_pk_bf16(bs[0], bs[1]), p23 = cvt_pk_bf16(bs[2], bs[3]);
            if (kct) { pw.x = p01; pw.y = p23; pw.z = 0u; pw.w = 0u; } else { pw.x = 0u; pw.y = 0u; pw.z = p01; pw.w = p23; }
            const bf16x8 pbx = __builtin_bit_cast(bf16x8, pw);
            const int s2 = kct ? 0 : 1;
            O0 = MFMA32(__builtin_shufflevector(va[s2][0], va[s2][1], 0, 1, 2, 3, 4, 5, 6, 7), pbx, O0); O1 = MFMA32(__builtin_shufflevector(vc[s2][0], vc[s2][1], 0, 1, 2, 3, 4, 5, 6, 7), pbx, O1);
        }
    }
}

__device__ __forceinline__ void nattn_all(Ctx& F, int l) {
    LAS unsigned char* lds = F.lds;
    const int vb = (F.G == 256) ? ((F.bid & 7) * 32 + (F.bid >> 3)) : F.bid;
    const int per = (1536 + F.G - 1) / F.G, it0 = vb * per, it1 = (it0 + per) < 1536 ? (it0 + per) : 1536;
    if (F.wave >= 4) __builtin_amdgcn_s_setprio(1);
    const int qt = F.wave & 3, khalf = F.wave >> 2, j = qt >> 1, ch = qt & 1, r = F.lane & 31, h = F.lane >> 5;
    const int qc = 32 * ch + r; int cs = qc - 8; cs = cs < 0 ? 0 : (cs > 48 ? 48 : cs);
    unsigned badf[16], badc[4];
#pragma unroll
    for (int i = 0; i < 16; ++i) { const int kc = ch * 32 + crow(i, h); const bool ok = (kc >= cs) && (kc < cs + 16); int dc = kc - qc; dc = dc < -15 ? -15 : (dc > 15 ? 15 : dc);
        badf[i] = (unsigned)(NA_TI + ((j * 8 + khalf * 4) * 32 + (ok ? dc + 15 : 31)) * 4); }
#pragma unroll
    for (int i = 0; i < 4; ++i) { const int kct = 1 - ch, ii = (kct ? 0 : 12) + i; const int kc = kct * 32 + crow(ii, h); const bool ok = (kc >= cs) && (kc < cs + 16); int dc = kc - qc; dc = dc < -15 ? -15 : (dc > 15 ? 15 : dc);
        badc[i] = (unsigned)(NA_TI + ((j * 8 + khalf * 4) * 32 + (ok ? dc + 15 : 31)) * 4); }
    int have_bh = -1, have_hi = -1, pf_lo = 0, pf_n = 0, tb_bh = -1;
    u32x4 pk0, pv0, pk1, pv1; bf16x8 qn[4]; bool have_qn = false;
    pk0 = pv0 = pk1 = pv1 = (u32x4){0u, 0u, 0u, 0u};
#pragma unroll
    for (int s = 0; s < 4; ++s) qn[s] = (bf16x8){0, 0, 0, 0, 0, 0, 0, 0};
#pragma unroll 1
    for (int item = it0; item < it1; ++item) {
        int b, head, r0, rs0; na_decode(item, b, head, r0, rs0);
        const int bh = b * 12 + head, need_hi = (rs0 + 8) < 63 ? (rs0 + 8) : 63, tokb = b * SEQ;
        if (bh != have_bh) {
            NaRegs R;
#pragma unroll
            for (int jj = 0; jj < 9; ++jj) { const int gr = (rs0 + jj) < 63 ? (rs0 + jj) : 63; na_row_issue(F, b, head, gr, R.k[jj], R.v[jj]); }
#pragma unroll
            for (int jj = 0; jj < 9; ++jj) { if (rs0 + jj <= 63) na_row_commit(F, rs0 + jj, R.k[jj], R.v[jj]); }
            LAS float* tbw = (LAS float*)(lds + NA_TB);
            for (int i = F.tid; i < 465; i += NTHR) tbw[i] = F.rpb[(size_t)(l * 12 + head) * 465 + i] * LOG2E;
            have_bh = bh;
        } else {
            if (pf_n > 0) na_row_commit(F, pf_lo, pk0, pv0);
            if (pf_n > 1) na_row_commit(F, pf_lo + 1, pk1, pv1);
        }
        have_hi = need_hi;
        if (bh != tb_bh) { LDS_BARRIER(); tb_bh = bh; }
        { const LAS float* tb = (const LAS float*)(lds + NA_TB); const int jj = F.tid >> 8, kidx = (F.tid >> 5) & 7, dci = F.tid & 31;
          int rsq = r0 + jj - 4; rsq = rsq < 0 ? 0 : (rsq > 56 ? 56 : rsq); const int dr = rsq + kidx - (r0 + jj) + 7;
          ((LAS float*)(lds + NA_TI))[F.tid] = dci < 31 ? tb[dr * 31 + dci] : -INFINITY; }
        const int qrow = r0 + j; int rsj = qrow - 4; rsj = rsj < 0 ? 0 : (rsj > 56 ? 56 : rsj);
        const int tokq = tokb + qrow * 64 + qc;
        bf16x8 qf[4];
        if (have_qn) {
#pragma unroll
            for (int s = 0; s < 4; ++s) qf[s] = qn[s];
        } else {
#pragma unroll
            for (int s = 0; s < 4; ++s) qf[s] = *(const bf16x8*)(F.unat + (size_t)tokq * LDN + N_CQ + head * 64 + 16 * s + 8 * h);
        }
        const bf16* zp = F.unat + (size_t)tokq * LDN + N_CZ + head * 64 + 32 * khalf + 4 * h;
        u32x2 zz[4];
#pragma unroll
        for (int g4 = 0; g4 < 4; ++g4) zz[g4] = *(const u32x2*)(zp + 8 * g4);
        LDS_BARRIER();
        pf_n = 0; have_qn = false;
        if (item + 1 < it1) {
            int nb, nhead, nr0, nrs0; na_decode(item + 1, nb, nhead, nr0, nrs0);
            if (nb * 12 + nhead == bh) {
                const int nhi = (nrs0 + 8) < 63 ? (nrs0 + 8) : 63;
                pf_lo = have_hi + 1; pf_n = nhi - have_hi;
                if (pf_n > 0) na_row_issue(F, b, head, pf_lo, pk0, pv0);
                if (pf_n > 1) na_row_issue(F, b, head, pf_lo + 1, pk1, pv1);
            }
            const int ntokq = nb * SEQ + (nr0 + j) * 64 + qc;
#pragma unroll
            for (int s = 0; s < 4; ++s) qn[s] = *(const bf16x8*)(F.unat + (size_t)ntokq * LDN + N_CQ + nhead * 64 + 16 * s + 8 * h);
            have_qn = true;
        }
        float m = -1e30f, lsum = 0.f;
        f32x16 O0 = zero16(), O1 = zero16();
        if (ch == 0) na_tiles<0>(lds, qf, badf, badc, rsj, khalf, r, h, m, lsum, O0, O1); else na_tiles<1>(lds, qf, badf, badc, rsj, khalf, r, h, m, lsum, O0, O1);
        lsum += shx(lsum, 32, F.lane);
        LAS unsigned* xq = (LAS unsigned*)(lds + NA_X + qt * NA_XQ);
        LAS float* xf = (LAS float*)(lds + NA_X + qt * NA_XQ + 2048);
        bf16* yp = F.yb + (size_t)tokq * DM + 1280 + head * 64 + 32 * khalf + 4 * h;
        if (khalf == 1) {
#pragma unroll
            for (int i = 0; i < 8; ++i) xq[i * 64 + F.lane] = cvt_pk_bf16(O0[2 * i], O0[2 * i + 1]);
            xf[F.lane] = m; xf[64 + F.lane] = lsum;
        }
        LDS_BARRIER();
        float m2 = 0.f, l2 = 0.f; unsigned ox[8];
        if (khalf == 0) {
            m2 = xf[F.lane]; l2 = xf[64 + F.lane];
#pragma unroll
            for (int i = 0; i < 8; ++i) ox[i] = xq[i * 64 + F.lane];
        }
        LDS_BARRIER();
        if (khalf == 0) {
#pragma unroll
            for (int i = 0; i < 8; ++i) xq[i * 64 + F.lane] = cvt_pk_bf16(O1[2 * i], O1[2 * i + 1]);
            xf[F.lane] = m; xf[64 + F.lane] = lsum;
        }
        LDS_BARRIER();
        if (khalf == 1) {
            m2 = xf[F.lane]; l2 = xf[64 + F.lane];
#pragma unroll
            for (int i = 0; i < 8; ++i) ox[i] = xq[i * 64 + F.lane];
        }
        {
            const float mn = fmaxf(m, m2), a1 = ex2(m - mn), a2 = ex2(m2 - mn);
            const float inv = frcp(lsum * a1 + l2 * a2);
#pragma unroll
            for (int g4 = 0; g4 < 4; ++g4) {
                float o[4];
#pragma unroll
                for (int e = 0; e < 4; ++e) { const float mine = khalf ? O1[4 * g4 + e] : O0[4 * g4 + e]; const unsigned pw = ox[2 * g4 + (e >> 1)]; const float oth = (e & 1) ? bfhi(pw) : bflo(pw);
                    o[e] = (mine * a1 + oth * a2) * inv; }
                const u32x2 z2 = zz[g4];
                const float y0 = o[0] * silu(bflo(z2.x)), y1 = o[1] * silu(bfhi(z2.x)), y2 = o[2] * silu(bflo(z2.y)), y3 = o[3] * silu(bfhi(z2.y));
                u32x2 w; w.x = cvt_pk_bf16(y0, y1); w.y = cvt_pk_bf16(y2, y3); *(u32x2*)(yp + 8 * g4) = w; }
        }
    }
    __builtin_amdgcn_s_setprio(0);
    LDS_BARRIER();
}

__device__ __forceinline__ size_t cst_chunk(int cid, int c, int dt, int k, int r) { const int L = ((dt * 16 + k) * 32 + r) * 8; return ((size_t)((cid * 8 + (L >> 11)) * 64 + c)) * 2048 + (size_t)(L & 2047); }
__device__ __forceinline__ void m1_wave(Ctx& F, int wi, int l) {
    const int b = wi >> 9, head = (wi >> 7) & 3, c = (wi >> 1) & 63, dir = wi & 1;
    const int tok0 = b * SEQ + c * 64;
    const int lane = F.lane, r = lane & 31, h = lane >> 5;
    LAS float* wtab = (LAS float*)(F.lds + F.wave * 256);
    const float ig = F.gate[(size_t)(tok0 + lane) * 16 + (2 * dir) * 4 + head];
    const float fg = F.gate[(size_t)(tok0 + lane) * 16 + (2 * dir + 1) * 4 + head] + F.fbias[l * 8 + dir * 4 + head];
    const float lf = logsigmoid(fg);
    const float cs = dir == 0 ? scan_sum_up(lf, lane) : scan_sum_down(lf, lane);
    const float g = shi(cs, dir == 0 ? 63 : 0);
    const float a = g - cs + ig;
    const float mloc = wave_max(a, lane);
    const float w = fexp(a - mloc);
    wtab[lane] = w;
    LDS_WAIT();
    const int cid = dir * 16 + b * 4 + head;
    if (lane == 0) { F.gs[cid * 64 + c] = g; F.ml[cid * 64 + c] = mloc; }
    f32x4 wv[8];
#pragma unroll
    for (int s = 0; s < 4; ++s) { wv[2 * s] = *(const LAS f32x4*)(wtab + 16 * s + 4 * h); wv[2 * s + 1] = *(const LAS f32x4*)(wtab + 16 * s + 8 + 4 * h); }
    bf16x8 af[4][4];
    {
        bf16x8 kn[2][8];
#pragma unroll
        for (int T = 0; T < 2; ++T)
#pragma unroll
            for (int j = 0; j < 8; ++j) kn[T][j] = *(const bf16x8*)(F.unat + bqk_off(tok0 + 32 * T + r, 512 + head * 128 + 16 * j + 8 * h));
        u32x4 i0, i1;
        { const unsigned one_lo = 0x3F80u, one_hi = 0x3F800000u; const int d0 = r - 8 * h, d1 = r - 16 - 8 * h;
          i0.x = d0 == 0 ? one_lo : d0 == 1 ? one_hi : 0u; i0.y = d0 == 2 ? one_lo : d0 == 3 ? one_hi : 0u; i0.z = d0 == 4 ? one_lo : d0 == 5 ? one_hi : 0u; i0.w = d0 == 6 ? one_lo : d0 == 7 ? one_hi : 0u;
          i1.x = d1 == 0 ? one_lo : d1 == 1 ? one_hi : 0u; i1.y = d1 == 2 ? one_lo : d1 == 3 ? one_hi : 0u; i1.z = d1 == 4 ? one_lo : d1 == 5 ? one_hi : 0u; i1.w = d1 == 6 ? one_lo : d1 == 7 ? one_hi : 0u; }
        const bf16x8 I0 = __builtin_bit_cast(bf16x8, i0), I1 = __builtin_bit_cast(bf16x8, i1);
#pragma unroll
        for (int et = 0; et < 4; ++et)
#pragma unroll
            for (int T = 0; T < 2; ++T) {
                f32x16 d = zero16();
                d = MFMA32(kn[T][2 * et], I0, d); d = MFMA32(kn[T][2 * et + 1], I1, d);
                af[et][2 * T] = pack8(d, 0); af[et][2 * T + 1] = pack8(d, 1);
            }
    }
#pragma unroll
    for (int et = 0; et < 4; ++et) { float ns = 0.f;
#pragma unroll
        for (int s = 0; s < 4; ++s) { const u32x4 raw = __builtin_bit_cast(u32x4, af[et][s]); const f32x4 w0 = wv[2 * s], w1 = wv[2 * s + 1];
            ns += bflo(raw.x) * w0[0] + bfhi(raw.x) * w0[1] + bflo(raw.y) * w0[2] + bfhi(raw.y) * w0[3] + bflo(raw.z) * w1[0] + bfhi(raw.z) * w1[1] + bflo(raw.w) * w1[2] + bfhi(raw.w) * w1[3]; }
        ns += shx(ns, 32, lane);
        if (h == 0) F.nst[(size_t)(cid * 64 + c) * 128 + 32 * et + r] = ns; }
#pragma unroll 1
    for (int dt = 0; dt < 4; ++dt) {
        bf16x8 bfr[4];
#pragma unroll
        for (int s = 0; s < 4; ++s) {
            const u32x4 q = *(const u32x4*)(F.ut + (size_t)(T_BV + head * 128 + 32 * dt + r) * M + tok0 + 16 * s + 8 * h);
            const auto sx = __builtin_amdgcn_permlane32_swap(q.x, q.z, false, false), sy = __builtin_amdgcn_permlane32_swap(q.y, q.w, false, false);
            u32x4 raw; raw.x = sx[0]; raw.y = sy[0]; raw.z = sx[1]; raw.w = sy[1];
            const f32x4 w0 = wv[2 * s], w1 = wv[2 * s + 1];
            u32x4 o; o.x = cvt_pk_bf16(bflo(raw.x) * w0[0], bfhi(raw.x) * w0[1]); o.y = cvt_pk_bf16(bflo(raw.y) * w0[2], bfhi(raw.y) * w0[3]);
            o.z = cvt_pk_bf16(bflo(raw.z) * w1[0], bfhi(raw.z) * w1[1]); o.w = cvt_pk_bf16(bflo(raw.w) * w1[2], bfhi(raw.w) * w1[3]);
            bfr[s] = __builtin_bit_cast(bf16x8, o);
        }
#pragma unroll
        for (int et = 0; et < 4; ++et) {
            f32x16 acc = zero16();
#pragma unroll
            for (int s = 0; s < 4; ++s) acc = MFMA32(af[et][s], bfr[s], acc);
#pragma unroll
            for (int p = 0; p < 2; ++p) {
                const unsigned a0 = cvt_pk_bf16(acc[8 * p], acc[8 * p + 1]), a1 = cvt_pk_bf16(acc[8 * p + 2], acc[8 * p + 3]);
                const unsigned b0 = cvt_pk_bf16(acc[8 * p + 4], acc[8 * p + 5]), b1 = cvt_pk_bf16(acc[8 * p + 6], acc[8 * p + 7]);
                const auto s0 = __builtin_amdgcn_permlane32_swap(a0, b0, false, false), s1 = __builtin_amdgcn_permlane32_swap(a1, b1, false, false);
                u32x4 o; o.x = s0[0]; o.y = s1[0]; o.z = s0[1]; o.w = s1[1];
                *(u32x4*)(F.cst + cst_chunk(cid, c, dt, 4 * et + 2 * p + h, r)) = o; }
        }
    }
    LDS_WAIT();
}

__device__ __forceinline__ void m2_scan(Ctx& F) {
    LAS float* sps = (LAS float*)F.lds; LAS float* sls = sps + 64;
    for (int blk = F.bid; blk < 256; blk += F.G) {
        const int cid = blk >> 3, dir = cid >> 4, e4 = (blk & 7) * 512 + F.tid;
        if (F.wave == 0) {
            const int sidx = F.lane, c = dir ? 63 - sidx : sidx;
            const float g = F.gs[cid * 64 + c], mloc = F.ml[cid * 64 + c];
            const float Gs = scan_sum_up(g, sidx);
            const float ma = Gs + fmaxf(0.f, scan_max_up(mloc - Gs, sidx));
            const float mb0 = shi(ma, sidx - 1); const float mb = sidx == 0 ? 0.f : mb0;
            sps[sidx] = fexp(g + mb - ma); sls[sidx] = fexp(mloc - ma); F.mprev[cid * 64 + c] = mb;
        }
        __syncthreads();
        float C0 = 0.f, C1 = 0.f, C2 = 0.f, C3 = 0.f;
        f32x4 nn = {0.f, 0.f, 0.f, 0.f};
        const bool do_n = e4 < 32;
        bf16* cb = F.cst + (size_t)(cid * 8 + (blk & 7)) * 64 * 2048 + F.tid * 4;
        float* nb = F.nst + (size_t)cid * 64 * 128 + (e4 & 31) * 4;
#pragma unroll 1
        for (int s0 = 0; s0 < 64; s0 += 16) {
            u32x2 cl[16]; f32x4 nl[16];
#pragma unroll
            for (int j = 0; j < 16; ++j) { const int c = dir ? 63 - (s0 + j) : (s0 + j); cl[j] = *(const u32x2*)(cb + (size_t)c * 2048); }
            if (do_n) {
#pragma unroll
                for (int j = 0; j < 16; ++j) { const int c = dir ? 63 - (s0 + j) : (s0 + j); nl[j] = *(const f32x4*)(nb + (size_t)c * 128); }
            }
#pragma unroll
            for (int j = 0; j < 16; ++j) {
                const int c = dir ? 63 - (s0 + j) : (s0 + j);
                u32x2 o; o.x = cvt_pk_bf16(C0, C1); o.y = cvt_pk_bf16(C2, C3); *(u32x2*)(cb + (size_t)c * 2048) = o;
                const float sp = sps[s0 + j], sl = sls[s0 + j];
                C0 = sp * C0 + sl * bflo(cl[j].x); C1 = sp * C1 + sl * bfhi(cl[j].x); C2 = sp * C2 + sl * bflo(cl[j].y); C3 = sp * C3 + sl * bfhi(cl[j].y);
                if (do_n) { *(f32x4*)(nb + (size_t)c * 128) = nn; nn = nn * sp + nl[j] * sl; }
            }
        }
        __syncthreads();
    }
}

constexpr int M3_TABW = 2560, M3_HB = 8 * M3_TABW  , M3_HW = 16384;
static_assert(M3_HB + 8 * M3_HW <= MISC_OFF, "M3 LDS map");
__device__ __forceinline__ void m3_wave(Ctx& F, int wi, int l) {
    const int b = wi >> 9, head = (wi >> 7) & 3, c = (wi >> 1) & 63, tt = wi & 1;
    const int tok0 = b * SEQ + c * 64;
    int lane_ = 0; asm volatile("" : "+v"(lane_)); lane_ = (int)__builtin_amdgcn_mbcnt_hi(~0u, __builtin_amdgcn_mbcnt_lo(~0u, (unsigned)lane_));
    const int lane = lane_, r = lane & 31, h = lane >> 5;
    LAS float* tab = (LAS float*)(F.lds + F.wave * M3_TABW);
    LAS float* hb = (LAS float*)(F.lds + M3_HB + F.wave * M3_HW);
    const int cidf = b * 4 + head, cidb = 16 + b * 4 + head;
    const int t = 32 * tt + r;
    const float* gp = F.gate + (size_t)(tok0 + lane) * 16;
    const float g_if = gp[head], g_ff = gp[4 + head], g_ib = gp[8 + head], g_fb = gp[12 + head];
    const float mpf = F.mprev[cidf * 64 + c], mpb = F.mprev[cidb * 64 + c];
    const float* nf = F.nst + (size_t)(cidf * 64 + c) * 128; const float* nbw = F.nst + (size_t)(cidb * 64 + c) * 128;
    const float n0_ = nf[lane], n1_ = nf[64 + lane], n2_ = nbw[lane], n3_ = nbw[64 + lane];
    bf16x8 qf[8], kf0[8];
#pragma unroll
    for (int s = 0; s < 8; ++s) qf[s] = *(const bf16x8*)(F.unat + bqk_off(tok0 + t, head * 128 + 16 * s + 8 * h));
#pragma unroll
    for (int s = 0; s < 8; ++s) kf0[s] = *(const bf16x8*)(F.unat + bqk_off(tok0 + r, 512 + head * 128 + 16 * s + 8 * h));
    SCHED_FENCE();
    {
        const float f_f = g_ff + F.fbias[l * 8 + head], f_b = g_fb + F.fbias[l * 8 + 4 + head];
        const float bf_ = scan_sum_up(logsigmoid(f_f), lane), bb_ = scan_sum_down(logsigmoid(f_b), lane);
        const float uf = g_if - bf_, ub = g_ib - bb_;
        const float MF = fmaxf(mpf, scan_max_up(uf, lane)), MB = fmaxf(mpb, scan_max_down(ub, lane));
        tab[lane] = uf; tab[64 + lane] = ub; tab[128 + lane] = MF; tab[192 + lane] = MB; tab[256 + lane] = bf_; tab[320 + lane] = bb_;
        tab[384 + lane] = n0_; tab[448 + lane] = n1_; tab[512 + lane] = n2_; tab[576 + lane] = n3_;
        LDS_WAIT();
    }
    f32x16 S0 = zero16(), S1 = zero16();
    {
        bf16x8 kf1[8];
#pragma unroll
        for (int s = 0; s < 8; ++s) kf1[s] = *(const bf16x8*)(F.unat + bqk_off(tok0 + 32 + r, 512 + head * 128 + 16 * s + 8 * h));
        SCHED_FENCE();
#pragma unroll
        for (int s = 0; s < 8; ++s) S0 = MFMA32(kf0[s], qf[s], S0);
#pragma unroll
        for (int s = 0; s < 8; ++s) S1 = MFMA32(kf1[s], qf[s], S1);
    }
    bf16x8 pb[2][4]; float interw[2], inv[2];
#pragma unroll
    for (int dir = 0; dir < 2; ++dir) {
        const LAS float* U = tab + dir * 64;
        const float Mt = tab[128 + dir * 64 + t], Bt = tab[256 + dir * 64 + t], mp = dir ? mpb : mpf;
        const LAS float* np = tab + 384 + dir * 128 + 8 * h;
        float nq = 0.f;
#pragma unroll
        for (int s = 0; s < 8; ++s) { const f32x4 n0 = *(const LAS f32x4*)(np + 16 * s), n1 = *(const LAS f32x4*)(np + 16 * s + 4); const u32x4 qq = __builtin_bit_cast(u32x4, qf[s]);
            nq += n0[0] * bflo(qq.x) + n0[1] * bfhi(qq.x) + n0[2] * bflo(qq.y) + n0[3] * bfhi(qq.y) + n1[0] * bflo(qq.z) + n1[1] * bfhi(qq.z) + n1[2] * bflo(qq.w) + n1[3] * bfhi(qq.w); }
        nq += shx(nq, 32, lane);
        interw[dir] = fexp(mp - Mt) * QS;
        float den = 0.f;
#pragma unroll
        for (int st = 0; st < 2; ++st) {
            f32x16 P;
#pragma unroll
            for (int g4 = 0; g4 < 4; ++g4) { const f32x4 uu = *(const LAS f32x4*)(U + 32 * st + 8 * g4 + 4 * h);
#pragma unroll
                for (int e = 0; e < 4; ++e) { const int sp = 32 * st + 8 * g4 + 4 * h + e; const bool ok = dir ? (sp >= t) : (sp <= t);
                    const float wgt = ok ? fexp(uu[e] - Mt) : 0.f; const float pv = (st ? S1[4 * g4 + e] : S0[4 * g4 + e]) * QS * wgt; P[4 * g4 + e] = pv; den += pv; } }
            pb[dir][2 * st] = pack8(P, 0); pb[dir][2 * st + 1] = pack8(P, 1);
        }
        den += shx(den, 32, lane);
        den += nq * interw[dir];
        inv[dir] = frcp(fmaxf(fabsf(den), fexp(-(Bt + Mt))));
    }
    bf16x8 cfa[8], cfb[8]; s16x4 vv[8]; u32x2 og[4];
    int ro = r, ho = h; asm volatile("" : "+v"(ro), "+v"(ho));
    const int to = 32 * tt + ro;
#define M3_LOADC(dst, dir, dt) do { SCHED_FENCE(); { const bf16* cp = F.cst + cst_chunk((dir ? cidb : cidf), c, (dt), ho, ro); \
        _Pragma("unroll") for (int s = 0; s < 8; ++s) dst[s] = *(const bf16x8*)(cp + ((s & 3) * 2 * 256) + (s >> 2) * ((size_t)64 * 2048)); } SCHED_FENCE(); } while (0)
#define M3_LOADV(dt) do { SCHED_FENCE(); { const bf16* vp = F.ut + (size_t)(T_BV + head * 128 + 32 * (dt) + ro) * M + tok0 + 8 * ho; \
        _Pragma("unroll") for (int ks = 0; ks < 4; ++ks) { const u32x4 q_ = *(const u32x4*)(vp + 16 * ks); vv[2 * ks] = __builtin_bit_cast(s16x4, (u32x2){q_.x, q_.y}); vv[2 * ks + 1] = __builtin_bit_cast(s16x4, (u32x2){q_.z, q_.w}); } } \
        { _Pragma("unroll") for (int p = 0; p < 2; ++p) { const u32x4 q_ = *(const u32x4*)(F.unat + fm_off(tok0 + to, N_BO, 1, head * 128 + 32 * (dt) + 16 * p + 8 * ho)); og[2 * p] = (u32x2){q_.x, q_.y}; og[2 * p + 1] = (u32x2){q_.z, q_.w}; } } SCHED_FENCE(); } while (0)
    M3_LOADC(cfa, 0, 0); M3_LOADV(0);
    float s1 = 0.f, s2 = 0.f;
#pragma unroll 1
    for (int dt = 0; dt < 4; ++dt) {
        f32x16 H;
#pragma unroll
        for (int ks = 0; ks < 4; ++ks) {
            const u32x2 lo = __builtin_bit_cast(u32x2, vv[2 * ks]), hi = __builtin_bit_cast(u32x2, vv[2 * ks + 1]);
            const auto sx = __builtin_amdgcn_permlane32_swap(lo.x, hi.x, false, false), sy = __builtin_amdgcn_permlane32_swap(lo.y, hi.y, false, false);
            vv[2 * ks] = __builtin_bit_cast(s16x4, (u32x2){sx[0], sy[0]}); vv[2 * ks + 1] = __builtin_bit_cast(s16x4, (u32x2){sx[1], sy[1]}); }
        {
            f32x16 X = zero16();
#pragma unroll
            for (int s = 0; s < 8; ++s) X = MFMA32(cfa[s], qf[s], X);
            M3_LOADC(cfb, 1, dt);
            const float iw = interw[0];
#pragma unroll
            for (int i = 0; i < 16; ++i) X[i] *= iw;
#pragma unroll
            for (int ks = 0; ks < 4; ++ks) X = MFMA32(__builtin_shufflevector(vv[2 * ks], vv[2 * ks + 1], 0, 1, 2, 3, 4, 5, 6, 7), pb[0][ks], X);
            const float iv = inv[0];
#pragma unroll
            for (int i = 0; i < 16; ++i) H[i] = X[i] * iv;
        }
        {
            f32x16 X = zero16();
#pragma unroll
            for (int s = 0; s < 8; ++s) X = MFMA32(cfb[s], qf[s], X);
            if (dt < 3) M3_LOADC(cfa, 0, dt + 1);
            const float iw = interw[1];
#pragma unroll
            for (int i = 0; i < 16; ++i) X[i] *= iw;
#pragma unroll
            for (int ks = 0; ks < 4; ++ks) X = MFMA32(__builtin_shufflevector(vv[2 * ks], vv[2 * ks + 1], 0, 1, 2, 3, 4, 5, 6, 7), pb[1][ks], X);
            const float iv = inv[1];
#pragma unroll
            for (int i = 0; i < 16; ++i) H[i] += X[i] * iv;
        }
#pragma unroll
        for (int p = 0; p < 2; ++p) { const auto sx = __builtin_amdgcn_permlane32_swap(og[2 * p].x, og[2 * p + 1].x, false, false), sy = __builtin_amdgcn_permlane32_swap(og[2 * p].y, og[2 * p + 1].y, false, false);
            og[2 * p] = (u32x2){sx[0], sy[0]}; og[2 * p + 1] = (u32x2){sx[1], sy[1]}; }
#pragma unroll
        for (int g4 = 0; g4 < 4; ++g4) { const u32x2 oo = og[g4];
            H[4 * g4] *= sigm(bflo(oo.x)); H[4 * g4 + 1] *= sigm(bfhi(oo.x)); H[4 * g4 + 2] *= sigm(bflo(oo.y)); H[4 * g4 + 3] *= sigm(bfhi(oo.y)); }
        if (dt < 3) M3_LOADV(dt + 1);
#pragma unroll
        for (int i = 0; i < 16; ++i) { s1 += H[i]; s2 += H[i] * H[i]; hb[(dt * 16 + i) * 64 + lane] = H[i]; }
    }
#undef M3_LOADC
#undef M3_LOADV
    s1 += shx(s1, 32, lane); s2 += shx(s2, 32, lane);
    const float mean = s1 * (1.f / 128.f), var = fmaxf(s2 * (1.f / 128.f) - mean * mean, 0.f), rstd = __builtin_amdgcn_rsqf(var + LN_EPS);
    LDS_WAIT();
    int rz = r, hz = h; asm volatile("" : "+v"(rz), "+v"(hz)); const int tz = 32 * tt + rz;
    bf16* yp = F.yb + (size_t)(tok0 + tz) * DM + 768 + head * 128 + 8 * hz;
    const float* ng = F.norm_g + l * 512 + head * 128 + 4 * hz;
#pragma unroll 1
    for (int half = 0; half < 2; ++half) {
        u32x4 zq[4]; u32x2 zz[8]; f32x4 gn[8];
#pragma unroll
        for (int p = 0; p < 4; ++p) zq[p] = *(const u32x4*)(F.unat + fm_off(tok0 + tz, N_BZ, 1, head * 128 + 16 * (4 * half + p) + 8 * hz));
#pragma unroll
        for (int i = 0; i < 8; ++i) gn[i] = *(const f32x4*)(ng + 8 * (8 * half + i));
#pragma unroll
        for (int p = 0; p < 4; ++p) { const auto sx = __builtin_amdgcn_permlane32_swap(zq[p].x, zq[p].z, false, false), sy = __builtin_amdgcn_permlane32_swap(zq[p].y, zq[p].w, false, false);
            zz[2 * p] = (u32x2){sx[0], sy[0]}; zz[2 * p + 1] = (u32x2){sx[1], sy[1]}; }
        u32x2 wy[8];
#pragma unroll
        for (int i = 0; i < 8; ++i) { const int ii = 8 * half + i;
            const float h0 = hb[(4 * ii) * 64 + lane], h1 = hb[(4 * ii + 1) * 64 + lane], h2 = hb[(4 * ii + 2) * 64 + lane], h3 = hb[(4 * ii + 3) * 64 + lane];
            const float y0 = (h0 - mean) * rstd * gn[i][0] * silu(bflo(zz[i].x)), y1 = (h1 - mean) * rstd * gn[i][1] * silu(bfhi(zz[i].x));
            const float y2 = (h2 - mean) * rstd * gn[i][2] * silu(bflo(zz[i].y)), y3 = (h3 - mean) * rstd * gn[i][3] * silu(bfhi(zz[i].y));
            wy[i].x = cvt_pk_bf16(y0, y1); wy[i].y = cvt_pk_bf16(y2, y3); }
#pragma unroll
        for (int p = 0; p < 4; ++p) { const auto sx = __builtin_amdgcn_permlane32_swap(wy[2 * p].x, wy[2 * p + 1].x, false, false), sy = __builtin_amdgcn_permlane32_swap(wy[2 * p].y, wy[2 * p + 1].y, false, false);
            u32x4 o; o.x = sx[0]; o.y = sy[0]; o.z = sx[1]; o.w = sy[1]; *(u32x4*)(yp + 16 * (4 * half + p)) = o; }
    }
    LDS_WAIT();
}

__global__ void __launch_bounds__(NTHR, 2) mega(Args args) {
    extern __shared__ __attribute__((aligned(16))) unsigned char lds_raw[];
    LAS unsigned char* const ldsb = (LAS unsigned char*)lds_raw;
    const int wave_s = __builtin_amdgcn_readfirstlane((int)threadIdx.x >> 6);
#define TID_NOW() ([&]() { unsigned z_ = 0u; asm volatile("" : "+v"(z_)); return wave_s * 64 + (int)__builtin_amdgcn_mbcnt_hi(~0u, __builtin_amdgcn_mbcnt_lo(~0u, z_)); }())
#define MAKE_CTX() MAKE_CTX_L(1)
#define MAKE_CTX_L(lyr) Ctx F; { const int l_ = (lyr); auto kp_ = __builtin_amdgcn_kernarg_segment_ptr(); asm volatile("" : "+s"(kp_)); \
    const __attribute__((address_space(4))) Args* ap_ = (const __attribute__((address_space(4))) Args*)kp_; \
    F.lds = ldsb; { int tid_ = TID_NOW(); asm volatile("" : "+v"(tid_)); F.tid = tid_; } F.lane = F.tid & 63; F.wave = wave_s; F.G = gridDim.x; F.bid = blockIdx.x; \
    F.x = ap_->in[0]; F.emb_g = ap_->in[1]; F.emb_b = ap_->in[2]; F.w_in = ap_->in[3]; F.b_in = ap_->in[4]; F.w_out = ap_->in[5]; F.b_out = ap_->in[6]; \
    F.ln_g = ap_->in[7]; F.ln_b = ap_->in[8]; F.t5 = ap_->in[9]; F.sink = ap_->in[10]; F.fbias = ap_->in[11]; F.norm_g = ap_->in[12]; F.rpb = ap_->in[13]; \
    F.out = ap_->out; F.ws = ap_->ws; \
    F.hby = (bf16*)(F.ws + WS_HBY); F.yb = l_ == 0 ? (bf16*)F.out : F.hby; F.unat = (bf16*)(F.ws + WS_UNAT); F.ut = (bf16*)(F.ws + WS_UT); F.cst = (bf16*)(F.ws + WS_CST); F.nst = (float*)(F.ws + WS_NST); \
    F.gs = (float*)(F.ws + WS_SCAL); F.ml = F.gs + 2048; F.mprev = F.gs + 4096; F.gate = (float*)(F.ws + WS_GATE); F.stat = (float*)(F.ws + WS_SCAL + 65536); }
    volatile LAS unsigned* MISC = (volatile LAS unsigned*)(ldsb + MISC_OFF);
    if (threadIdx.x < 32) MISC[threadIdx.x] = 0u;
    __syncthreads();
    XcdBarrier bar; bar.bar = (unsigned*)(args.ws + WS_CTL) + CW_BAR; bar.x = 0; bar.st = nullptr;
    if (!MK_PER_PHASE) bar = xcd_barrier_post((unsigned*)(args.ws + WS_CTL) + CW_BAR, MISC + 8, (int)threadIdx.x);
    const int lo = args.ph_lo, hi = args.ph_hi;
#define IN(k) (lo <= (k) && (k) < hi)
#define SEAM(k) do { if (IN(k) && IN((k) + 1)) { for (int rb_ = 0; rb_ < REP_BAR; ++rb_) xcd_barrier(bar, TID_NOW()); } } while (0)
    #ifndef NO_P0
    if (IN(0)) { MAKE_CTX(); for (int rep_ = 0, nrep_ = opaque_int(REP_P0); rep_ < nrep_; ++rep_) phase_prologue(F); }
#endif
    SEAM(0);
#pragma unroll 1
    for (int l = 0; l < 2; ++l) {
        const int pb = 1 + 6 * l;
        if (IN(pb)) {
#ifndef NO_G1
            {   MAKE_CTX_L(l);
                pg8::Sched1 S{(const char*)F.hby, (const char*)(F.ws + WS_WIN + l * WIN_STRIDE), F.G, F.bid};
                pg8::Epi1 E{F.unat, F.ut, (const float*)(F.ws + WS_BIAS) + l * WROWS};
                pg8::gemm_phase<pg8::Epi1, pg8::Sched1, true, true>(F.lds, S, E, F.tid); }
#endif
#ifndef NO_GATES
            {   MAKE_CTX_L(l);
                if (l == 0) { bool is_h; int hid, nh; helper_of(F, 0, is_h, hid, nh); if (is_h) { weights_job(F, 1, hid * NWAVES + F.wave, nh * NWAVES); } __syncthreads(); }
                gates_job(F, l); }
#endif
        }
        SEAM(pb);
        if (IN(pb + 1)) {
            MAKE_CTX_L(l);
#ifndef NO_M1
            for (int rep_ = 0, nrep_ = opaque_int(REP_M1); rep_ < nrep_; ++rep_) for (int wi = F.bid * NWAVES + F.wave; wi < 2048; wi += F.G * NWAVES) m1_wave(F, wi, l);
#endif
            __syncthreads();
#ifndef NO_WA
            for (int rep_ = 0, nrep_ = opaque_int(REP_WA); rep_ < nrep_; ++rep_) for (int it0 = F.bid; it0 < 256; it0 += F.G) wattn_item(F, (F.G == 256) ? ((it0 & 7) * 32 + (it0 >> 3)) : it0, l);
#endif
        }
        SEAM(pb + 1);
        if (IN(pb + 2)) {
            MAKE_CTX_L(l);
#ifndef NO_M2
            m2_scan(F);
#endif
#ifndef NO_NA
            for (int rep_ = 0, nrep_ = opaque_int(REP_NA); rep_ < nrep_; ++rep_) nattn_all(F, l);
#endif
        }
        SEAM(pb + 2);
        if (IN(pb + 3)) {
            MAKE_CTX_L(l);
#ifndef NO_M3
            for (int rep_ = 0, nrep_ = opaque_int(REP_M3); rep_ < nrep_; ++rep_) for (int wi = F.bid * NWAVES + F.wave; wi < 2048; wi += F.G * NWAVES) m3_wave(F, wi, l);
#endif
        }
        SEAM(pb + 3);
        if (IN(pb + 4)) {
            MAKE_CTX_L(l);
            pg8::Sched2 S{(const char*)F.yb, (const char*)(F.ws + WS_WOUT + l * WOUT_STRIDE), F.G, F.bid};
#ifndef NO_G2
            if (l == 0) { pg8::Epi2<0> E{(float*)nullptr, (bf16*)(F.ws + WS_WIN), F.b_out, F.x, (const bf16*)F.hby, F.stat, F.emb_g, F.emb_b, (bf16*)(F.ws + WS_T1B)};
                pg8::gemm_phase<pg8::Epi2<0>, pg8::Sched2, true, true>(F.lds, S, E, F.tid); }
            else { pg8::Epi2<1> E{(float*)nullptr, (bf16*)(F.ws + WS_UNAT), F.b_out + DM, (const float*)nullptr, (const bf16*)nullptr, (const float*)nullptr, (const float*)nullptr, (const float*)nullptr, (bf16*)nullptr};
                pg8::gemm_phase<pg8::Epi2<1>, pg8::Sched2, true, true>(F.lds, S, E, F.tid); }
#endif
        }
        SEAM(pb + 4);
        if (IN(pb + 5)) {
            MAKE_CTX_L(l);
            const int gw = F.bid * NWAVES + F.wave, NGW = F.G * NWAVES;
            if (l == 0) { for (int m = 2 * gw; m < M; m += 2 * NGW) ln_row2_b(t1_row(F.ws, m), t1_row(F.ws, m + 1), F.hby + (size_t)m * DM, F.hby + (size_t)(m + 1) * DM, F.stat + (size_t)(M + m) * 2, F.stat + (size_t)(M + m + 1) * 2, F.ln_g, F.ln_b, F.lane); }
            else { const bf16* O2 = (const bf16*)(F.ws + WS_UNAT);
                   for (int m = 2 * gw; m < M; m += 2 * NGW) fin_row2(t1_row(F.ws, m), O2 + (size_t)m * DM, F.stat + (size_t)(M + m) * 2, F.ln_g, F.ln_b, F.ln_g + DM, F.ln_b + DM, F.out + (size_t)m * DM, F.lane); }
        }
        if (l == 0) SEAM(pb + 5);
    }
#undef IN
#undef SEAM
}

extern "C" void kernel_launch(void* const* d_in, const int* in_sizes, int n_in, void* d_out, int out_size, void* d_ws, size_t ws_size, hipStream_t stream) {
    static int grid = 0;
    if (grid == 0) {
        if (n_in != 14 || out_size != M * DM || ws_size < WS_END) { fprintf(stderr, "kernel_launch: unexpected shapes (n_in %d out %d ws %zu)\n", n_in, out_size, ws_size); grid = -1; return; }
        int dev = 0, cus = 0, per_cu = 0;
        if (hipGetDevice(&dev) != hipSuccess || hipDeviceGetAttribute(&cus, hipDeviceAttributeMultiprocessorCount, dev) != hipSuccess) { grid = -1; return; }
        if (hipFuncSetAttribute((const void*)mega, hipFuncAttributeMaxDynamicSharedMemorySize, LDS_BYTES) != hipSuccess) { fprintf(stderr, "kernel_launch: hipFuncSetAttribute failed\n"); grid = -1; return; }
        if (hipOccupancyMaxActiveBlocksPerMultiprocessor(&per_cu, (const void*)mega, NTHR, LDS_BYTES) != hipSuccess || per_cu < 1) fprintf(stderr, "kernel_launch: occupancy query says %d\n", per_cu);
        (void)hipGetLastError();
        grid = cus;
    }
    if (grid < 0) return;
    (void)hipMemsetAsync((char*)d_ws + WS_CTL, 0, CTL_BYTES, stream);
    Args a{};
    for (int i = 0; i < 14; ++i) a.in[i] = (const float*)d_in[i];
    a.out = (float*)d_out; a.ws = (unsigned char*)d_ws;
#if MK_PER_PHASE
    for (int p = 0; p < 13; ++p) { a.ph_lo = p; a.ph_hi = p + 1; hipLaunchKernelGGL(mega, dim3(grid), dim3(NTHR), LDS_BYTES, stream, a); }
#else
    a.ph_lo = 0; a.ph_hi = 13;
    hipLaunchKernelGGL(mega, dim3(grid), dim3(NTHR), LDS_BYTES, stream, a);
#endif
}
```

```cpp
#include <hip/hip_runtime.h>
#include <cstdio>
#include <cstdint>

#ifndef REP_P0
#define REP_P0 1
#endif
#ifndef REP_G1
#define REP_G1 1
#endif
#ifndef REP_M1
#define REP_M1 1
#endif
#ifndef REP_WA
#define REP_WA 1
#endif
#ifndef REP_NA
#define REP_NA 1
#endif
#ifndef REP_M3
#define REP_M3 1
#endif
#ifndef REP_GATES
#define REP_GATES 1
#endif
#ifndef REP_BAR
#define REP_BAR 1
#endif
#ifndef MK_PER_PHASE
#define MK_PER_PHASE 0
#endif

#define LAS __attribute__((address_space(3)))
#define GAS __attribute__((address_space(1)))
typedef unsigned short bf16;
typedef short bf16x8 __attribute__((ext_vector_type(8)));
typedef short s16x4 __attribute__((ext_vector_type(4)));
typedef float f32x4 __attribute__((ext_vector_type(4)));
typedef float f32x16 __attribute__((ext_vector_type(16)));
typedef unsigned u32x4 __attribute__((ext_vector_type(4)));
typedef unsigned u32x2 __attribute__((ext_vector_type(2)));
typedef GAS unsigned gu32;

constexpr int M = 16384, DM = 2048, SEQ = 4096, IN_W = 7696, NWAVES = 8, NTHR = 512;
constexpr int LDN = 6144;
constexpr int N_AQ = 0, N_AK = 768, N_AZ = 1024, N_BQ = 1792, N_BK = 2304, N_BO = 2816, N_BZ = 3328, N_CQ = 3840, N_CK = 4608, N_CZ = 5376;
constexpr int T_AV = 0, T_BK = 256, T_BV = 768, T_CV = 1280;
constexpr int WROWS = 8192 + 16;
constexpr float LN_EPS = 1e-5f, LOG2E = 1.4426950408889634f, ALPHA = 1.4142135623730951f;
constexpr float C2A = 0.125f * LOG2E;
constexpr float QS = 0.08838834764831845f;

constexpr size_t MiB = 1u << 20;
constexpr size_t WS_CTL = 0, CTL_BYTES = 1 * MiB;
constexpr size_t WS_WIN = 2 * MiB, WIN_STRIDE = 33 * MiB;
constexpr size_t WS_WOUT = 68 * MiB, WOUT_STRIDE = 8 * MiB;
constexpr size_t WS_BIAS = 84 * MiB;
constexpr size_t WS_GATE = 85 * MiB;
constexpr size_t WS_HBY = 86 * MiB;
constexpr size_t WS_UNAT = 150 * MiB;
constexpr size_t WS_UT = 342 * MiB;
constexpr size_t WS_CST = 406 * MiB;
constexpr size_t WS_NST = 470 * MiB;
constexpr size_t WS_SCAL = 471 * MiB;
constexpr size_t WS_T1B = 472 * MiB;
constexpr size_t WS_END = 504 * MiB;
constexpr int CW_BAR = 4096;

constexpr int LDS_BYTES = 163840, MISC_OFF = LDS_BYTES - 128;

__device__ __forceinline__ int opaque_int(int v) { asm volatile("" : "+s"(v)); return v; }
#define LDS_WAIT() asm volatile("s_waitcnt lgkmcnt(0)" ::: "memory")
#define LDS_BARRIER() do { asm volatile("s_waitcnt lgkmcnt(0)" ::: "memory"); __builtin_amdgcn_s_barrier(); asm volatile("" ::: "memory"); } while (0)
#define VM_WAIT() asm volatile("s_waitcnt vmcnt(0)" ::: "memory")
__device__ __forceinline__ float bf2f(unsigned v) { return __uint_as_float(v << 16); }
__device__ __forceinline__ float bflo(unsigned v) { return __uint_as_float(v << 16); }
__device__ __forceinline__ float bfhi(unsigned v) { return __uint_as_float(v & 0xffff0000u); }
typedef float f32x2_t __attribute__((ext_vector_type(2)));
typedef __bf16 bf16x2_t __attribute__((ext_vector_type(2)));
__device__ __forceinline__ unsigned cvt_pk_bf16(float lo, float hi) { const f32x2_t v = {lo, hi}; const bf16x2_t b = __builtin_convertvector(v, bf16x2_t); return __builtin_bit_cast(unsigned, b); }
__device__ __forceinline__ float ex2(float x) { return __builtin_amdgcn_exp2f(x); }
__device__ __forceinline__ float fexp(float x) { return __builtin_amdgcn_exp2f(x * LOG2E); }
__device__ __forceinline__ float frcp(float x) { return __builtin_amdgcn_rcpf(x); }
__device__ __forceinline__ float silu(float x) { return x * frcp(1.f + fexp(-x)); }
__device__ __forceinline__ float sigm(float x) { return frcp(1.f + fexp(-x)); }
__device__ __forceinline__ float logsigmoid(float x) { return fminf(x, 0.f) - log1pf(expf(-fabsf(x))); }
__device__ __forceinline__ int crow(int reg, int h) { return (reg & 3) + 8 * (reg >> 2) + 4 * h; }
__device__ __forceinline__ float shx(float v, int mask, int lane) { return __int_as_float(__builtin_amdgcn_ds_bpermute((lane ^ mask) << 2, __float_as_int(v))); }
__device__ __forceinline__ float shi(float v, int src) { return __int_as_float(__builtin_amdgcn_ds_bpermute(src << 2, __float_as_int(v))); }
__device__ __forceinline__ float wave_sum(float v, int lane) {
#pragma unroll
    for (int o = 1; o < 64; o <<= 1) v += shx(v, o, lane);
    return v;
}
__device__ __forceinline__ float wave_max(float v, int lane) {
#pragma unroll
    for (int o = 1; o < 64; o <<= 1) v = fmaxf(v, shx(v, o, lane));
    return v;
}
__device__ __forceinline__ float scan_sum_up(float v, int lane) {
#pragma unroll
    for (int o = 1; o < 64; o <<= 1) { const float t = shi(v, lane - o); if (lane >= o) v += t; }
    return v;
}
__device__ __forceinline__ float scan_sum_down(float v, int lane) {
#pragma unroll
    for (int o = 1; o < 64; o <<= 1) { const float t = shi(v, lane + o); if (lane + o < 64) v += t; }
    return v;
}
__device__ __forceinline__ float scan_max_up(float v, int lane) {
#pragma unroll
    for (int o = 1; o < 64; o <<= 1) { const float t = shi(v, lane - o); if (lane >= o) v = fmaxf(v, t); }
    return v;
}
__device__ __forceinline__ float scan_max_down(float v, int lane) {
#pragma unroll
    for (int o = 1; o < 64; o <<= 1) { const float t = shi(v, lane + o); if (lane + o < 64) v = fmaxf(v, t); }
    return v;
}
__device__ __forceinline__ int t5_bucket(int rel) {
    const int n = rel < 0 ? -rel : rel; const int ret = rel > 0 ? 16 : 0;
    const int large = 8 + (n >= 12) + (n >= 16) + (n >= 23) + (n >= 32) + (n >= 46) + (n >= 64) + (n >= 91);
    return ret + (n < 8 ? n : large);
}
#define PIN16(a) asm volatile("" : "+v"(a[0]), "+v"(a[1]), "+v"(a[2]), "+v"(a[3]), "+v"(a[4]), "+v"(a[5]), "+v"(a[6]), "+v"(a[7]), "+v"(a[8]), "+v"(a[9]), "+v"(a[10]), "+v"(a[11]), "+v"(a[12]), "+v"(a[13]), "+v"(a[14]), "+v"(a[15]))
#define MFMA32(a, b, c) __builtin_amdgcn_mfma_f32_32x32x16_bf16((a), (b), (c), 0, 0, 0)
__device__ __forceinline__ bf16x8 pack8(const f32x16& x, int s) {
    u32x4 p; p.x = cvt_pk_bf16(x[8 * s], x[8 * s + 1]); p.y = cvt_pk_bf16(x[8 * s + 2], x[8 * s + 3]); p.z = cvt_pk_bf16(x[8 * s + 4], x[8 * s + 5]); p.w = cvt_pk_bf16(x[8 * s + 6], x[8 * s + 7]);
    return __builtin_bit_cast(bf16x8, p);
}
__device__ __forceinline__ f32x16 zero16() { f32x16 z;
#pragma unroll
    for (int i = 0; i < 16; ++i) z[i] = 0.f; return z; }

template <int RPR> __device__ __forceinline__ size_t fm_off(int tok, int base, int col) { const int rho = col >> 3; return (size_t)((tok & ~31) + rho / RPR) * 6144 + base + (rho % RPR) * 256 + (tok & 31) * 8; }
__device__ __forceinline__ size_t bqk_off(int tok, int col) { return fm_off<4>(tok, 1792, col); }
namespace pg8 {
constexpr int BM = 256, BK = 64, HALF = 128, HTB = HALF * BK * 2, STAGE_BYTES = 8 * HTB, NXCD = 8, WGM = 4;
__device__ __forceinline__ int lds_byte(int r, int c) { const int st = (r >> 4) * 2 + (c >> 5), rr = r & 15, cc = c & 31, ob = rr * 64 + cc * 2; return st * 1024 + (ob ^ (((ob >> 9) & 1) << 5)); }
__device__ __forceinline__ void stage_rc(int b, int& R, int& C) { const int st = b / 1024, sb = b % 1024, swz = sb ^ (((sb >> 9) & 1) << 5); R = (st >> 1) * 16 + swz / 64; C = (st & 1) * 32 + (swz % 64) / 2; }
__device__ __forceinline__ int perm32(int rho) { const int n = rho >> 4, i = rho & 15; return 8 * (i >> 2) + 4 * n + (i & 3); }

struct Unit { const char* a; const char* b; int pm, pn, kind; };

__device__ __forceinline__ bool tile_of(int i, int G, int c, int nM, int nN, int& pm, int& pn) {
    const int nwg = nM * nN; const long L = (long)i * G + c; if (L >= nwg) return false;
    int wgid = (int)L; { const int q = nwg / NXCD, r = nwg % NXCD, xcd = wgid % NXCD, off = wgid / NXCD; wgid = (xcd < r ? xcd * (q + 1) : r * (q + 1) + (xcd - r) * q) + off; }
    const int nig = WGM * nN, gid = wgid / nig, fm = gid * WGM, gsz = (nM - fm) < WGM ? (nM - fm) : WGM;
    pm = fm + ((wgid % nig) % gsz); pn = (wgid % nig) / gsz; return true;
}
constexpr size_t TSTEP = (size_t)256 * 2048 * 2;
struct Sched1 {
    const char* X; const char* W; int G, c;
    __device__ __forceinline__ bool next(int i, Unit& u) const {
        int pm, pn;
        if (G == 256) {
            if (i >= 8) return false;
            const int x = c & 7, k = c >> 3, j = i;
            if (i == 7) { if (c >= 128) return false; pm = 8 * x + (k & 7); pn = 28 + (k >> 3); }
            else if (j < 4) { pm = 16 * j + 4 * (x & 3) + (k & 3); pn = 8 * (x >> 2) + (k >> 2); }
            else if (j < 6) { pm = 32 * (j - 4) + 8 * (x & 3) + (k & 7); pn = 16 + 4 * (x >> 2) + (k >> 3); }
            else { pm = 8 * x + (k & 7); pn = 24 + (k >> 3); }
            if (pn >= 25) pn += 2;
        } else if (!tile_of(i, G, c, 64, 32, pm, pn)) return false;
        u.pm = pm; u.pn = pn;
        if (pn < 24) { u.kind = 0; u.a = X + (size_t)pm * TSTEP; u.b = W + (size_t)pn * TSTEP; }
        else { u.kind = 1; u.a = W + (size_t)pn * TSTEP; u.b = X + (size_t)pm * TSTEP; }
        return true;
    }
};
struct Sched2 {
    const char* Y; const char* W; int G, c;
    __device__ __forceinline__ bool next(int i, Unit& u) const {
        int pm, pn; if (!tile_of(i, G, c, 64, 8, pm, pn)) return false;
        u.pm = pm; u.pn = pn; u.kind = 2; u.a = Y + (size_t)pm * TSTEP; u.b = W + (size_t)pn * TSTEP; return true;
    }
};

struct Epi1 {
    static constexpr bool PERM = true;
    bf16* Unat; bf16* Ut; const float* bias;
    __device__ __forceinline__ void operator()(const f32x4 (&acc)[2][2][4][2], const Unit& u, int wr, int wc, int fr, int fq) const {
        if (u.kind == 0) {
            const bool fmaj = u.pn != 3 && !(u.pn >= 18 && u.pn <= 20);
            int fbase, frpr;
            if (u.pn < 3) { fbase = N_AQ; frpr = 3; } else if (u.pn < 7) { fbase = N_AZ; frpr = 3; } else if (u.pn < 11) { fbase = N_BQ; frpr = 4; } else if (u.pn < 13) { fbase = N_BO; frpr = 2; }
            else if (u.pn < 15) { fbase = N_BZ; frpr = 2; } else if (u.pn < 18) { fbase = N_CQ; frpr = 3; } else { fbase = N_CZ; frpr = 3; }
            const int row0 = u.pm * BM + wr * 64 + fr, col0 = u.pn * BM + wc * 32 + 8 * fq;
            f32x4 bv[2][2];
#pragma unroll
            for (int bj = 0; bj < 2; ++bj)
#pragma unroll
                for (int n = 0; n < 2; ++n) bv[bj][n] = *(const f32x4*)(bias + col0 + bj * HALF + 4 * n);
#pragma unroll
            for (int ai = 0; ai < 2; ++ai)
#pragma unroll
                for (int m = 0; m < 4; ++m) { const int row = row0 + ai * HALF + m * 16; bf16* rowp = Unat + (size_t)row * LDN + col0;
#pragma unroll
                    for (int bj = 0; bj < 2; ++bj) { const f32x4 v0 = acc[ai][bj][m][0] + bv[bj][0], v1 = acc[ai][bj][m][1] + bv[bj][1];
                        u32x4 w; w.x = cvt_pk_bf16(v0[0], v0[1]); w.y = cvt_pk_bf16(v0[2], v0[3]); w.z = cvt_pk_bf16(v1[0], v1[1]); w.w = cvt_pk_bf16(v1[2], v1[3]);
                        const int fc = col0 + bj * HALF - fbase;
                        bf16* dst = !fmaj ? rowp + bj * HALF : Unat + (frpr == 3 ? fm_off<3>(row, fbase, fc) : frpr == 4 ? fm_off<4>(row, fbase, fc) : fm_off<2>(row, fbase, fc));
                        *(u32x4*)dst = w; } }
        } else {
            const int nrow0 = (u.pn - 24) * BM + wr * 64 + fr, tok0 = u.pm * BM + wc * 32 + 8 * fq;
#pragma unroll
            for (int ai = 0; ai < 2; ++ai)
#pragma unroll
                for (int m = 0; m < 4; ++m) { const int nr = nrow0 + ai * HALF + m * 16; const float bs = bias[6144 + nr]; bf16* rowp = Ut + (size_t)nr * M + tok0;
#pragma unroll
                    for (int bj = 0; bj < 2; ++bj) { const f32x4 v0 = acc[ai][bj][m][0] + bs, v1 = acc[ai][bj][m][1] + bs;
                        u32x4 w; w.x = cvt_pk_bf16(v0[0], v0[1]); w.y = cvt_pk_bf16(v0[2], v0[3]); w.z = cvt_pk_bf16(v1[0], v1[1]); w.w = cvt_pk_bf16(v1[2], v1[3]);
                        *(u32x4*)(rowp + bj * HALF) = w; } }
        }
    }
};
template <int L> struct Epi2 {
    static constexpr bool PERM = true;
    float* Tf; bf16* Tb; const float* bias; const float* srcf; const bf16* srcb; const float* stat; const float* gam; const float* bet; bf16* Tb_hi;
    __device__ __forceinline__ void operator()(const f32x4 (&acc)[2][2][4][2], const Unit& u, int wr, int wc, int fr, int fq) const {
        const int row0 = u.pm * BM + wr * 64 + fr, col0 = u.pn * BM + wc * 32 + 8 * fq;
        bf16* const Tbu = (Tb_hi && u.pm >= 32) ? Tb_hi - (size_t)8192 * DM : Tb;
        float mean[2][4], rs[2][4];
#pragma unroll
        for (int ai = 0; ai < 2; ++ai)
#pragma unroll
            for (int m = 0; m < 4; ++m) { mean[ai][m] = 0.f; rs[ai][m] = 0.f; }
#pragma unroll
        for (int bj = 0; bj < 2; ++bj) { const int c = col0 + bj * HALF;
            f32x4 g0 = {0.f, 0.f, 0.f, 0.f}, g1 = g0, b0 = *(const f32x4*)(bias + c), b1 = *(const f32x4*)(bias + c + 4);
#pragma unroll
            for (int ai = 0; ai < 2; ++ai)
#pragma unroll
                for (int m = 0; m < 4; ++m) { const size_t off = (size_t)(row0 + ai * HALF + m * 16) * DM + c;
                    f32x4 t0, t1;
                    if (L == 0) { const u32x4 hv = *(const u32x4*)(srcb + off);
                        const f32x4 o0 = {bflo(hv.x), bfhi(hv.x), bflo(hv.y), bfhi(hv.y)}, o1 = {bflo(hv.z), bfhi(hv.z), bflo(hv.w), bfhi(hv.w)};
                        t0 = o0 * ALPHA + b0 + acc[ai][bj][m][0]; t1 = o1 * ALPHA + b1 + acc[ai][bj][m][1]; }
                    else { t0 = acc[ai][bj][m][0] + b0; t1 = acc[ai][bj][m][1] + b1; }
                    u32x4 w; w.x = cvt_pk_bf16(t0[0], t0[1]); w.y = cvt_pk_bf16(t0[2], t0[3]); w.z = cvt_pk_bf16(t1[0], t1[1]); w.w = cvt_pk_bf16(t1[2], t1[3]); *(u32x4*)(Tbu + off) = w; } }
    }
};

template <class Epi, class Sched, bool ALIGN_EPI, bool SP2>
__device__ __forceinline__ void gemm_phase(LAS unsigned char* lds, const Sched& S, const Epi& E, const int tid) {
    const int wid = __builtin_amdgcn_readfirstlane(tid >> 6), lane = tid & 63, wr = wid >> 2, wc = wid & 3, fr = lane & 15, fq = lane >> 4;
    constexpr int K = 2048, nt = K / BK;
    unsigned voffA[2], voffB[2];
#pragma unroll
    for (int i = 0; i < 2; ++i) { int R, C; stage_rc(tid * 16 + i * 8192, R, C); const int Rb = Epi::PERM ? ((R & ~31) + perm32(R & 31)) : R;
        voffA[i] = (unsigned)(R * K + C) * 2u; voffB[i] = (unsigned)(Rb * K + C) * 2u; }
    const size_t kstep = (size_t)(BK * 2);
    const size_t hstep = (size_t)HALF * K * 2;
    const unsigned ldsw = (unsigned)wid * 1024u;
    const int aoff = lds_byte(wr * 64 + fr, fq * 8), boff = lds_byte(wc * 32 + fr, fq * 8);
#define PG8_SA(b, h) (((b) * 2 + (h)) * HTB)
#define PG8_SB(b, h) ((4 + (b) * 2 + (h)) * HTB)
#define PG8_STAGE(bufoff, gbase, voff) do { _Pragma("unroll") for (int _i = 0; _i < 2; ++_i) \
        __builtin_amdgcn_global_load_lds((const unsigned*)((const char*)(gbase) + (voff)[_i]), (LAS unsigned*)(lds + (bufoff) + ldsw + _i * 8192), 16, 0, 0); } while (0)
#define PG8_LDA(dst, b, h) do { _Pragma("unroll") for (int m = 0; m < 4; ++m) _Pragma("unroll") for (int k = 0; k < 2; ++k) dst[m][k] = *(const LAS bf16x8*)(lds + PG8_SA(b, h) + aoff + m * 2048 + k * 1024); } while (0)
#define PG8_LDB(dst, b, h) do { _Pragma("unroll") for (int n = 0; n < 2; ++n) _Pragma("unroll") for (int k = 0; k < 2; ++k) dst[n][k] = *(const LAS bf16x8*)(lds + PG8_SB(b, h) + boff + n * 2048 + k * 1024); } while (0)
#define PG8_MMA(ai, bj, At, Bt) do { __builtin_amdgcn_s_setprio(1); _Pragma("unroll") for (int m = 0; m < 4; ++m) _Pragma("unroll") for (int n = 0; n < 2; ++n) _Pragma("unroll") for (int k = 0; k < 2; ++k) \
        acc[ai][bj][m][n] = __builtin_amdgcn_mfma_f32_16x16x32_bf16(Bt[n][k], At[m][k], acc[ai][bj][m][n], 0, 0, 0); __builtin_amdgcn_s_setprio(0); } while (0)
#define PG8_WAIT_V(n) asm volatile("s_waitcnt vmcnt(" #n ")" ::: "memory")
#define PG8_WAIT_L(n) asm volatile("s_waitcnt lgkmcnt(" #n ")" ::: "memory")
#define PG8_BAR __builtin_amdgcn_s_barrier()
#define PG8_SCHED __builtin_amdgcn_sched_barrier(0)
    Unit cur, nxt; int ui = 0;
    if (!S.next(0, cur)) return;
    f32x4 acc[2][2][4][2];
#pragma unroll
    for (int a = 0; a < 2; ++a)
#pragma unroll
        for (int b = 0; b < 2; ++b)
#pragma unroll
            for (int m = 0; m < 4; ++m)
#pragma unroll
                for (int n = 0; n < 2; ++n) acc[a][b][m][n] = (f32x4){0.f, 0.f, 0.f, 0.f};
    bf16x8 At[4][2], B0[2][2], B1[2][2];
    const char* cA = cur.a; const char* cB = cur.b;
    if constexpr (SP2) {
        PG8_STAGE(PG8_SB(0, 0), cB, voffB); PG8_STAGE(PG8_SB(0, 1), cB + hstep, voffB); PG8_STAGE(PG8_SA(0, 0), cA, voffA); PG8_STAGE(PG8_SA(0, 1), cA + hstep, voffA);
        if (wr == 1) PG8_BAR;
        PG8_WAIT_V(2); PG8_BAR;
        PG8_STAGE(PG8_SB(1, 0), cB + kstep, voffB); PG8_STAGE(PG8_SA(1, 0), cA + kstep, voffA); PG8_STAGE(PG8_SB(1, 1), cB + hstep + kstep, voffB);
        PG8_WAIT_V(6); PG8_BAR;
    } else {
        PG8_STAGE(PG8_SB(0, 0), cB, voffB); PG8_STAGE(PG8_SA(0, 0), cA, voffA); PG8_STAGE(PG8_SB(0, 1), cB + hstep, voffB); PG8_STAGE(PG8_SA(0, 1), cA + hstep, voffA);
        if (wr == 1) PG8_BAR;
        PG8_WAIT_V(4); PG8_BAR;
        PG8_STAGE(PG8_SB(1, 0), cB + kstep, voffB); PG8_STAGE(PG8_SA(1, 0), cA + kstep, voffA); PG8_STAGE(PG8_SB(1, 1), cB + hstep + kstep, voffB);
        PG8_WAIT_V(6); PG8_BAR;
    }
    for (;;) {
        const bool has_next = S.next(ui + 1, nxt);
        const char* nA = has_next ? nxt.a : cA; const char* nB = has_next ? nxt.b : cB;
        for (int t = 0; t < nt; t += 2) {
            const bool last = (t == nt - 2);
            const char* a1 = cA + (size_t)(t + 1) * kstep;
            const char* a2 = last ? nA : cA + (size_t)(t + 2) * kstep; const char* b2 = last ? nB : cB + (size_t)(t + 2) * kstep;
            const char* a3 = a2 + kstep; const char* b3 = b2 + kstep;
            if constexpr (SP2) {
            PG8_LDB(B0, 0, 0); PG8_LDB(B1, 0, 1); PG8_SCHED; PG8_LDA(At, 0, 0); PG8_STAGE(PG8_SA(1, 1), a1 + hstep, voffA);
            PG8_WAIT_V(8); PG8_WAIT_L(0); PG8_BAR; PG8_MMA(0, 0, At, B0); PG8_MMA(0, 1, At, B1); PG8_BAR; PG8_SCHED;
            PG8_LDA(At, 0, 1); PG8_STAGE(PG8_SB(0, 0), b2, voffB); PG8_STAGE(PG8_SB(0, 1), b2 + hstep, voffB); PG8_STAGE(PG8_SA(0, 0), a2, voffA);
            PG8_WAIT_V(8); PG8_WAIT_L(0); PG8_BAR; PG8_MMA(1, 0, At, B0); PG8_MMA(1, 1, At, B1); PG8_BAR; PG8_SCHED;
            PG8_LDB(B0, 1, 0); PG8_LDB(B1, 1, 1); PG8_SCHED; PG8_LDA(At, 1, 0); PG8_STAGE(PG8_SA(0, 1), a2 + hstep, voffA);
            PG8_WAIT_V(8); PG8_WAIT_L(0); PG8_BAR; PG8_MMA(0, 0, At, B0); PG8_MMA(0, 1, At, B1); PG8_BAR; PG8_SCHED;
            PG8_LDA(At, 1, 1); PG8_STAGE(PG8_SB(1, 0), b3, voffB); PG8_STAGE(PG8_SB(1, 1), b3 + hstep, voffB); PG8_STAGE(PG8_SA(1, 0), a3, voffA);
            PG8_WAIT_V(8); PG8_WAIT_L(0); PG8_BAR; PG8_MMA(1, 0, At, B0); PG8_MMA(1, 1, At, B1); PG8_BAR; PG8_SCHED;
            } else {
            PG8_LDB(B0, 0, 0); PG8_SCHED; PG8_LDA(At, 0, 0); PG8_STAGE(PG8_SA(1, 1), a1 + hstep, voffA);
            PG8_WAIT_L(8); PG8_BAR; PG8_WAIT_L(0); PG8_MMA(0, 0, At, B0); PG8_BAR; PG8_SCHED;
            PG8_LDB(B1, 0, 1); PG8_STAGE(PG8_SB(0, 0), b2, voffB);
            PG8_BAR; PG8_WAIT_L(0); PG8_MMA(0, 1, At, B1); PG8_BAR;
            PG8_LDA(At, 0, 1); PG8_STAGE(PG8_SA(0, 0), a2, voffA);
            PG8_BAR; PG8_WAIT_L(0); PG8_MMA(1, 0, At, B0); PG8_BAR; PG8_SCHED;
            PG8_STAGE(PG8_SB(0, 1), b2 + hstep, voffB);
            PG8_WAIT_V(6); PG8_BAR; PG8_MMA(1, 1, At, B1); PG8_BAR;
            PG8_LDB(B0, 1, 0); PG8_SCHED; PG8_LDA(At, 1, 0); PG8_STAGE(PG8_SA(0, 1), a2 + hstep, voffA);
            PG8_WAIT_L(8); PG8_BAR; PG8_WAIT_L(0); PG8_MMA(0, 0, At, B0); PG8_BAR; PG8_SCHED;
            PG8_LDB(B1, 1, 1); PG8_STAGE(PG8_SB(1, 0), b3, voffB);
            PG8_BAR; PG8_WAIT_L(0); PG8_MMA(0, 1, At, B1); PG8_BAR;
            PG8_LDA(At, 1, 1); PG8_STAGE(PG8_SA(1, 0), a3, voffA);
            PG8_BAR; PG8_WAIT_L(0); PG8_MMA(1, 0, At, B0); PG8_BAR; PG8_SCHED;
            PG8_STAGE(PG8_SB(1, 1), b3 + hstep, voffB);
            PG8_WAIT_V(6); PG8_BAR; PG8_MMA(1, 1, At, B1); PG8_BAR;
            }
        }
        if constexpr (ALIGN_EPI) { if (wr == 0) PG8_BAR; }
        int fr_ = fr, fq_ = fq; asm volatile("" : "+v"(fr_), "+v"(fq_));
        E(acc, cur, wr, wc, fr_, fq_);
        if (!has_next) break;
#pragma unroll
        for (int a = 0; a < 2; ++a)
#pragma unroll
            for (int b = 0; b < 2; ++b)
#pragma unroll
                for (int m = 0; m < 4; ++m)
#pragma unroll
                    for (int n = 0; n < 2; ++n) acc[a][b][m][n] = (f32x4){0.f, 0.f, 0.f, 0.f};
        cur = nxt; cA = nA; cB = nB; ++ui;
        if constexpr (ALIGN_EPI) { if (wr == 1) PG8_BAR; }
    }
    PG8_WAIT_V(0);
    if constexpr (!ALIGN_EPI) { if (wr == 0) PG8_BAR; }
    PG8_BAR;
#undef PG8_SA
#undef PG8_SB
#undef PG8_STAGE
#undef PG8_LDA
#undef PG8_LDB
#undef PG8_MMA
#undef PG8_WAIT_V
#undef PG8_WAIT_L
#undef PG8_BAR
#undef PG8_SCHED
}
}

#define XB_TMO      128
#define XB_XCNT(j)  (256  + 64 * (j))
#define XB_XSUB(j)  (1280 + 64 * (j))
#define XB_XGEN(j)  (2304 + 64 * (j))
#define XB_TOP      3328
#define XB_TOPGEN   3392
#define XCD_BAR_WORDS 3456
#define XB_SPIN_CAP (1u << 22)
__device__ __forceinline__ unsigned xb_ld(unsigned* p)              { return __hip_atomic_load(p, __ATOMIC_RELAXED, __HIP_MEMORY_SCOPE_AGENT); }
__device__ __forceinline__ unsigned xb_add(unsigned* p, unsigned v) { return __hip_atomic_fetch_add(p, v, __ATOMIC_RELAXED, __HIP_MEMORY_SCOPE_AGENT); }
__device__ __forceinline__ unsigned xb_xcc_id() { return (unsigned)__builtin_amdgcn_s_getreg((3 << 11) | 20) & 0xFu; }
#define XB_SPIN(cond, bar) do { unsigned _sp = 0; while (cond) { __builtin_amdgcn_s_sleep(1); \
    if ((++_sp & 255u) == 0u) { if (xb_ld(&(bar)[XB_TMO])) break; if (_sp > XB_SPIN_CAP) { atomicAdd(&(bar)[XB_TMO], 1u); break; } } } } while (0)
struct XcdBarrier { unsigned* bar; unsigned x; volatile LAS unsigned* st; };
__device__ __forceinline__ XcdBarrier xcd_barrier_post(unsigned* bar, volatile LAS unsigned* st, int tid) {
    XcdBarrier b; b.bar = bar; b.x = xb_xcc_id(); b.st = st;
    if (tid == 0) (void)xb_add(&bar[XB_XCNT(b.x)], 1u);
    return b;
}
__device__ __forceinline__ void xcd_barrier_complete(unsigned* bar, unsigned x, unsigned& nloc, unsigned& nx) {
    const unsigned G = gridDim.x * gridDim.y * gridDim.z;
    unsigned sum, cnt, mine, sp = 0u;
    for (;;) {
        sum = 0u; cnt = 0u; mine = 0u;
#pragma unroll
        for (unsigned j = 0; j < 16; ++j) { const unsigned c = xb_ld(&bar[XB_XCNT(j)]); sum += c; cnt += (c > 0u) ? 1u : 0u; mine = (j == x) ? c : mine; }
        if (sum == G) break;
        __builtin_amdgcn_s_sleep(1);
        if ((++sp & 255u) == 0u) { if (xb_ld(&bar[XB_TMO])) break; if (sp > XB_SPIN_CAP) { atomicAdd(&bar[XB_TMO], 1u); break; } }
    }
    nloc = mine > 0u ? mine : 1u; nx = cnt > 0u ? cnt : 1u;
}
__device__ __forceinline__ void xcd_barrier(const XcdBarrier& b, int tid) {
    asm volatile("s_waitcnt vmcnt(0)" ::: "memory");
    __syncthreads();
    if (tid == 0) {
        unsigned* bar = b.bar; asm volatile("" : "+s"(bar));
        __builtin_amdgcn_s_waitcnt(0);
        unsigned nloc = b.st[0], nx = b.st[1];
        if (nloc == 0u) { xcd_barrier_complete(bar, b.x, nloc, nx); b.st[0] = nloc; b.st[1] = nx; }
        const unsigned old = xb_add(&bar[XB_XSUB(b.x)], 1u);
        const unsigned gen = old / nloc;
        if (old + 1u == (gen + 1u) * nloc) {
            __builtin_amdgcn_fence(__ATOMIC_RELEASE, "agent");
            asm volatile("s_waitcnt vmcnt(0)" ::: "memory");
            const unsigned og = xb_add(&bar[XB_TOP], 1u);
            const unsigned tg = og / nx;
            if (og + 1u == (tg + 1u) * nx) xb_add(&bar[XB_TOPGEN], 1u);
            else XB_SPIN(xb_ld(&bar[XB_TOPGEN]) == tg, bar);
            __builtin_amdgcn_fence(__ATOMIC_ACQUIRE, "agent");
            xb_add(&bar[XB_XGEN(b.x)], 1u);
            asm volatile("s_waitcnt vmcnt(0)" ::: "memory");
        } else {
            XB_SPIN(xb_ld(&bar[XB_XGEN(b.x)]) == gen, bar);
            __builtin_amdgcn_fence(__ATOMIC_ACQUIRE, "agent");
            asm volatile("s_waitcnt vmcnt(0)" ::: "memory");
        }
    }
    __syncthreads();
}

struct Args { const float* in[14]; float* out; unsigned char* ws; int ph_lo, ph_hi; };

struct Ctx {
    LAS unsigned char* lds; int tid, lane, wave, G, bid;
    const float *x, *emb_g, *emb_b, *w_in, *b_in, *w_out, *b_out, *ln_g, *ln_b, *t5, *sink, *fbias, *norm_g, *rpb;
    float* out; unsigned char* ws;
    bf16* hby; bf16* yb; bf16* unat; bf16* ut; bf16* cst; float* nst; float* gs; float* ml; float* mprev; float* gate; float* stat;
};

__device__ __forceinline__ int src_col_of_row(int r) {
    if (r < 768) return r;
    if (r < 1024) return r - 768 + 768;
    if (r < 1792) return r - 1024 + 1280;
    if (r < 2304) return r - 1792 + 2048;
    if (r < 2816) return r - 2304 + 2560;
    if (r < 3328) return r - 2816 + 3584;
    if (r < 3840) return r - 3328 + 4096;
    if (r < 4608) return r - 3840 + 4624;
    if (r < 5376) return r - 4608 + 5392;
    if (r < 6144) return r - 5376 + 6928;
    if (r < 6400) return r - 6144 + 1024;
    if (r < 6912) return r - 6400 + 2560;
    if (r < 7424) return r - 6912 + 3072;
    if (r < 8192) return r - 7424 + 6160;
    return r - 8192 + 4608;
}
__device__ __forceinline__ void ln_row(const float* xrow, float* orow, bf16* brow, float* stat, const float* g, const float* b, int lane) {
    f32x4 v[8]; float s = 0.f;
#pragma unroll
    for (int j = 0; j < 8; ++j) { v[j] = *(const f32x4*)(xrow + 4 * (lane + 64 * j)); s += (v[j][0] + v[j][1]) + (v[j][2] + v[j][3]); }
    const float mean = wave_sum(s, lane) * (1.f / DM); float q = 0.f;
#pragma unroll
    for (int j = 0; j < 8; ++j) { v[j] = v[j] - mean; q += (v[j][0] * v[j][0] + v[j][1] * v[j][1]) + (v[j][2] * v[j][2] + v[j][3] * v[j][3]); }
    const float rstd = 1.f / sqrtf(wave_sum(q, lane) * (1.f / DM) + LN_EPS);
    if (stat && lane == 0) { stat[0] = mean; stat[1] = rstd; }
#pragma unroll
    for (int j = 0; j < 8; ++j) { const int c = 4 * (lane + 64 * j); const f32x4 gg = *(const f32x4*)(g + c), bb = *(const f32x4*)(b + c);
        const f32x4 o = v[j] * rstd * gg + bb;
        if (orow) *(f32x4*)(orow + c) = o;
        if (brow) { u32x2 w; w.x = cvt_pk_bf16(o[0], o[1]); w.y = cvt_pk_bf16(o[2], o[3]); *(u32x2*)(brow + c) = w; } }
}

__device__ __forceinline__ void ln_row2(const float* x0, const float* x1, float* o0, float* o1, bf16* b0, bf16* b1, float* st0, float* st1, const float* g, const float* b, int lane) {
    f32x4 v[8], u[8]; float s = 0.f, s_ = 0.f;
#pragma unroll
    for (int j = 0; j < 8; ++j) { v[j] = *(const f32x4*)(x0 + 4 * (lane + 64 * j)); u[j] = *(const f32x4*)(x1 + 4 * (lane + 64 * j)); }
#pragma unroll
    for (int j = 0; j < 8; ++j) { s += (v[j][0] + v[j][1]) + (v[j][2] + v[j][3]); s_ += (u[j][0] + u[j][1]) + (u[j][2] + u[j][3]); }
#pragma unroll
    for (int o = 1; o < 64; o <<= 1) { s += shx(s, o, lane); s_ += shx(s_, o, lane); }
    const float mean = s * (1.f / DM), mean_ = s_ * (1.f / DM); float q = 0.f, q_ = 0.f;
#pragma unroll
    for (int j = 0; j < 8; ++j) { v[j] = v[j] - mean; u[j] = u[j] - mean_; q += (v[j][0] * v[j][0] + v[j][1] * v[j][1]) + (v[j][2] * v[j][2] + v[j][3] * v[j][3]); q_ += (u[j][0] * u[j][0] + u[j][1] * u[j][1]) + (u[j][2] * u[j][2] + u[j][3] * u[j][3]); }
#pragma unroll
    for (int o = 1; o < 64; o <<= 1) { q += shx(q, o, lane); q_ += shx(q_, o, lane); }
    const float rstd = 1.f / sqrtf(q * (1.f / DM) + LN_EPS), rstd_ = 1.f / sqrtf(q_ * (1.f / DM) + LN_EPS);
    if (st0 && lane == 0) { st0[0] = mean; st0[1] = rstd; st1[0] = mean_; st1[1] = rstd_; }
#pragma unroll
    for (int j = 0; j < 8; ++j) { const int c = 4 * (lane + 64 * j); const f32x4 gg = *(const f32x4*)(g + c), bb = *(const f32x4*)(b + c);
        const f32x4 o = v[j] * rstd * gg + bb, p = u[j] * rstd_ * gg + bb;
        if (o0) { *(f32x4*)(o0 + c) = o; *(f32x4*)(o1 + c) = p; }
        if (b0) { u32x2 w; w.x = cvt_pk_bf16(o[0], o[1]); w.y = cvt_pk_bf16(o[2], o[3]); *(u32x2*)(b0 + c) = w; u32x2 w2; w2.x = cvt_pk_bf16(p[0], p[1]); w2.y = cvt_pk_bf16(p[2], p[3]); *(u32x2*)(b1 + c) = w2; } }
}

__device__ __forceinline__ void ln_row2_b(const bf16* x0, const bf16* x1, bf16* b0, bf16* b1, float* st0, float* st1, const float* g, const float* b, int lane) {
    f32x4 v[8], u[8]; float s = 0.f, s_ = 0.f;
#pragma unroll
    for (int j = 0; j < 4; ++j) { const u32x4 p = *(const u32x4*)(x0 + 8 * (lane + 64 * j)), q = *(const u32x4*)(x1 + 8 * (lane + 64 * j));
        v[2 * j] = (f32x4){bflo(p.x), bfhi(p.x), bflo(p.y), bfhi(p.y)}; v[2 * j + 1] = (f32x4){bflo(p.z), bfhi(p.z), bflo(p.w), bfhi(p.w)};
        u[2 * j] = (f32x4){bflo(q.x), bfhi(q.x), bflo(q.y), bfhi(q.y)}; u[2 * j + 1] = (f32x4){bflo(q.z), bfhi(q.z), bflo(q.w), bfhi(q.w)}; }
#pragma unroll
    for (int j = 0; j < 8; ++j) { s += (v[j][0] + v[j][1]) + (v[j][2] + v[j][3]); s_ += (u[j][0] + u[j][1]) + (u[j][2] + u[j][3]); }
#pragma unroll
    for (int o = 1; o < 64; o <<= 1) { s += shx(s, o, lane); s_ += shx(s_, o, lane); }
    const float mean = s * (1.f / DM), mean_ = s_ * (1.f / DM); float q = 0.f, q_ = 0.f;
#pragma unroll
    for (int j = 0; j < 8; ++j) { v[j] = v[j] - mean; u[j] = u[j] - mean_; q += (v[j][0] * v[j][0] + v[j][1] * v[j][1]) + (v[j][2] * v[j][2] + v[j][3] * v[j][3]); q_ += (u[j][0] * u[j][0] + u[j][1] * u[j][1]) + (u[j][2] * u[j][2] + u[j][3] * u[j][3]); }
#pragma unroll
    for (int o = 1; o < 64; o <<= 1) { q += shx(q, o, lane); q_ += shx(q_, o, lane); }
    const float rstd = 1.f / sqrtf(q * (1.f / DM) + LN_EPS), rstd_ = 1.f / sqrtf(q_ * (1.f / DM) + LN_EPS);
    if (lane == 0) { st0[0] = mean; st0[1] = rstd; st1[0] = mean_; st1[1] = rstd_; }
#pragma unroll
    for (int j = 0; j < 4; ++j) { const int c = 8 * (lane + 64 * j);
        const f32x4 g0 = *(const f32x4*)(g + c), g1 = *(const f32x4*)(g + c + 4), bb0 = *(const f32x4*)(b + c), bb1 = *(const f32x4*)(b + c + 4);
        const f32x4 o0 = v[2 * j] * rstd * g0 + bb0, o1 = v[2 * j + 1] * rstd * g1 + bb1, p0 = u[2 * j] * rstd_ * g0 + bb0, p1 = u[2 * j + 1] * rstd_ * g1 + bb1;
        u32x4 w; w.x = cvt_pk_bf16(o0[0], o0[1]); w.y = cvt_pk_bf16(o0[2], o0[3]); w.z = cvt_pk_bf16(o1[0], o1[1]); w.w = cvt_pk_bf16(o1[2], o1[3]); *(u32x4*)(b0 + c) = w;
        u32x4 w2; w2.x = cvt_pk_bf16(p0[0], p0[1]); w2.y = cvt_pk_bf16(p0[2], p0[3]); w2.z = cvt_pk_bf16(p1[0], p1[1]); w2.w = cvt_pk_bf16(p1[2], p1[3]); *(u32x4*)(b1 + c) = w2; }
}

__device__ __forceinline__ void fin_row2(const bf16* t1, const bf16* o2, const float* st, const float* g0, const float* b0, const float* g1, const float* b1, float* out, int lane) {
    f32x4 v[8], u[8]; float s = 0.f, s_ = 0.f;
    const float mA = st[0], rA = st[1] * ALPHA, mB = st[2], rB = st[3] * ALPHA;
#pragma unroll
    for (int j = 0; j < 4; ++j) { const int c = 8 * (lane + 64 * j);
        const u32x4 p = *(const u32x4*)(t1 + c), q = *(const u32x4*)(t1 + DM + c), x = *(const u32x4*)(o2 + c), y = *(const u32x4*)(o2 + DM + c);
        const f32x4 ga = *(const f32x4*)(g0 + c), gb = *(const f32x4*)(g0 + c + 4), ba = *(const f32x4*)(b0 + c) * ALPHA, bb = *(const f32x4*)(b0 + c + 4) * ALPHA;
        v[2 * j] = ((f32x4){bflo(p.x), bfhi(p.x), bflo(p.y), bfhi(p.y)} - mA) * rA * ga + ba + (f32x4){bflo(x.x), bfhi(x.x), bflo(x.y), bfhi(x.y)};
        v[2 * j + 1] = ((f32x4){bflo(p.z), bfhi(p.z), bflo(p.w), bfhi(p.w)} - mA) * rA * gb + bb + (f32x4){bflo(x.z), bfhi(x.z), bflo(x.w), bfhi(x.w)};
        u[2 * j] = ((f32x4){bflo(q.x), bfhi(q.x), bflo(q.y), bfhi(q.y)} - mB) * rB * ga + ba + (f32x4){bflo(y.x), bfhi(y.x), bflo(y.y), bfhi(y.y)};
        u[2 * j + 1] = ((f32x4){bflo(q.z), bfhi(q.z), bflo(q.w), bfhi(q.w)} - mB) * rB * gb + bb + (f32x4){bflo(y.z), bfhi(y.z), bflo(y.w), bfhi(y.w)}; }
#pragma unroll
    for (int j = 0; j < 8; ++j) { s += (v[j][0] + v[j][1]) + (v[j][2] + v[j][3]); s_ += (u[j][0] + u[j][1]) + (u[j][2] + u[j][3]); }
#pragma unroll
    for (int o = 1; o < 64; o <<= 1) { s += shx(s, o, lane); s_ += shx(s_, o, lane); }
    const float mean = s * (1.f / DM), mean_ = s_ * (1.f / DM); float q2 = 0.f, q2_ = 0.f;
#pragma unroll
    for (int j = 0; j < 8; ++j) { v[j] = v[j] - mean; u[j] = u[j] - mean_; q2 += (v[j][0] * v[j][0] + v[j][1] * v[j][1]) + (v[j][2] * v[j][2] + v[j][3] * v[j][3]); q2_ += (u[j][0] * u[j][0] + u[j][1] * u[j][1]) + (u[j][2] * u[j][2] + u[j][3] * u[j][3]); }
#pragma unroll
    for (int o = 1; o < 64; o <<= 1) { q2 += shx(q2, o, lane); q2_ += shx(q2_, o, lane); }
    const float rstd = 1.f / sqrtf(q2 * (1.f / DM) + LN_EPS), rstd_ = 1.f / sqrtf(q2_ * (1.f / DM) + LN_EPS);
#pragma unroll
    for (int j = 0; j < 4; ++j) { const int c = 8 * (lane + 64 * j);
        const f32x4 ga = *(const f32x4*)(g1 + c), gb = *(const f32x4*)(g1 + c + 4), ba = *(const f32x4*)(b1 + c), bb = *(const f32x4*)(b1 + c + 4);
        *(f32x4*)(out + c) = v[2 * j] * rstd * ga + ba; *(f32x4*)(out + c + 4) = v[2 * j + 1] * rstd * gb + bb;
        *(f32x4*)(out + DM + c) = u[2 * j] * rstd_ * ga + ba; *(f32x4*)(out + DM + c + 4) = u[2 * j + 1] * rstd_ * gb + bb; }
}

__device__ __forceinline__ bf16* t1_row(unsigned char* ws, int m) { return m < 8192 ? (bf16*)(ws + WS_WIN) + (size_t)m * DM : (bf16*)(ws + WS_T1B) + (size_t)(m - 8192) * DM; }
struct TrItem { const float* src; bf16* dst; int ldw, nvalid; };
__device__ __forceinline__ void tr_load(const TrItem& t, float (&wv)[32], int lane) {
#pragma unroll
    for (int i = 0; i < 8; ++i) { const int kk = 8 * i + (lane >> 3); const f32x4 v = *(const f32x4*)(t.src + (size_t)kk * t.ldw + 4 * (lane & 7));
        wv[4 * i] = v[0]; wv[4 * i + 1] = v[1]; wv[4 * i + 2] = v[2]; wv[4 * i + 3] = v[3]; }
}
__device__ __forceinline__ void tr_store(const TrItem& t, const float (&wv)[32], LAS float* scr, int lane) {
#pragma unroll
    for (int i = 0; i < 8; ++i) { const int kk = 8 * i + (lane >> 3); LAS float* d = scr + kk * 33 + 4 * (lane & 7); d[0] = wv[4 * i]; d[1] = wv[4 * i + 1]; d[2] = wv[4 * i + 2]; d[3] = wv[4 * i + 3]; }
    LDS_WAIT();
    const int c = lane & 7;
#pragma unroll
    for (int j = 0; j < 4; ++j) { const int n = (lane >> 3) + 8 * j; const LAS float* sp = scr + (8 * c) * 33 + n;
        u32x4 o; o.x = cvt_pk_bf16(sp[0 * 33], sp[1 * 33]); o.y = cvt_pk_bf16(sp[2 * 33], sp[3 * 33]); o.z = cvt_pk_bf16(sp[4 * 33], sp[5 * 33]); o.w = cvt_pk_bf16(sp[6 * 33], sp[7 * 33]);
        if (n < t.nvalid) *(u32x4*)(t.dst + (size_t)n * 2048 + 8 * c) = o; }
    LDS_WAIT();
}
__device__ __forceinline__ bool tr_item(const Ctx& F, int l, int it, TrItem& t) {
    constexpr int I_IN = 241 * 32, I_OUT = 64 * 32;
    if (it >= I_IN + I_OUT) return false;
    if (it < I_IN) { int rb = it >> 5; const int kb = it & 31; rb = rb < 200 ? rb : rb + 16;
        t.ldw = IN_W; t.nvalid = rb == 256 ? 16 : 32; t.src = F.w_in + (size_t)l * DM * IN_W + (size_t)(kb * 64) * IN_W + src_col_of_row(rb * 32);
        t.dst = (bf16*)(F.ws + WS_WIN + l * WIN_STRIDE) + (size_t)rb * 32 * 2048 + kb * 64; }
    else { const int r = it - I_IN, rb = r >> 5, kb = r & 31;
        t.ldw = DM; t.nvalid = 32; t.src = F.w_out + (size_t)l * DM * DM + (size_t)(kb * 64) * DM + rb * 32;
        t.dst = (bf16*)(F.ws + WS_WOUT + l * WOUT_STRIDE) + (size_t)rb * 32 * 2048 + kb * 64; }
    return true;
}
__device__ __forceinline__ void weights_job(Ctx& F, int l, int gw, int ngw) {
    LAS float* scr = (LAS float*)(F.lds + F.wave * 16384);
    TrItem ta, tb; float wa[32], wb[32];
    int it = gw; bool ha = tr_item(F, l, it, ta), hb;
    if (ha) tr_load(ta, wa, F.lane);
    while (ha) {
        it += ngw; hb = tr_item(F, l, it, tb); if (hb) tr_load(tb, wb, F.lane);
        tr_store(ta, wa, scr, F.lane);
        if (!hb) break;
        it += ngw; ha = tr_item(F, l, it, ta); if (ha) tr_load(ta, wa, F.lane);
        tr_store(tb, wb, scr, F.lane);
    }
}
__device__ __forceinline__ void helper_of(const Ctx& F, int l, bool& is_h, int& hid, int& nh) { (void)l; if (F.G == 256) { is_h = F.bid >= 128; hid = F.bid - 128; nh = 128; } else { is_h = true; hid = F.bid; nh = F.G; } }
__device__ __forceinline__ void phase_prologue(Ctx& F) {
    const int gw = F.bid * NWAVES + F.wave, NGW = F.G * NWAVES;
    weights_job(F, 0, gw, NGW);
    for (int i = F.bid * NTHR + F.tid; i < 2 * WROWS; i += F.G * NTHR) { const int l = i / WROWS, r = i % WROWS; ((float*)(F.ws + WS_BIAS))[i] = F.b_in[l * IN_W + src_col_of_row(r)]; }
    for (int m = 2 * gw; m < M; m += 2 * NGW) ln_row2(F.x + (size_t)m * DM, F.x + (size_t)(m + 1) * DM, (float*)nullptr, (float*)nullptr, F.hby + (size_t)m * DM, F.hby + (size_t)(m + 1) * DM, F.stat + (size_t)m * 2, F.stat + (size_t)(m + 1) * 2, F.emb_g, F.emb_b, F.lane);
}

__device__ __forceinline__ void gates_job(Ctx& F, int l) {
    const bf16* Wg = (const bf16*)(F.ws + WS_WIN + l * WIN_STRIDE) + (size_t)8192 * 2048;
    const float* bg = (const float*)(F.ws + WS_BIAS) + l * WROWS + 8192;
    LAS f32x4* red = (LAS f32x4*)F.lds;
    const int w = F.wave, fr = F.lane & 15, fq = F.lane >> 4;
    bool is_h; int hid, nh; helper_of(F, l, is_h, hid, nh); if (!is_h) return;
    for (int rb = hid; rb < M / 64; rb += nh) {
        const bf16* bp = Wg + (size_t)fr * 2048 + w * 256 + 8 * fq;
        f32x4 acc[4];
#pragma unroll
        for (int tt = 0; tt < 4; ++tt) acc[tt] = (f32x4){0.f, 0.f, 0.f, 0.f};
        bf16x8 bfr[8], afr[4][8];
#pragma unroll
        for (int i = 0; i < 8; ++i) bfr[i] = *(const bf16x8*)(bp + 32 * i);
#pragma unroll
        for (int tt = 0; tt < 4; ++tt)
#pragma unroll
            for (int i = 0; i < 8; ++i) afr[tt][i] = *(const bf16x8*)(F.hby + (size_t)(rb * 64 + tt * 16 + fr) * DM + w * 256 + 8 * fq + 32 * i);
#pragma unroll
        for (int i = 0; i < 8; ++i)
#pragma unroll
            for (int tt = 0; tt < 4; ++tt) acc[tt] = __builtin_amdgcn_mfma_f32_16x16x32_bf16(afr[tt][i], bfr[i], acc[tt], 0, 0, 0);
#pragma unroll
        for (int tt = 0; tt < 4; ++tt) red[(w * 4 + tt) * 64 + F.lane] = acc[tt];
        __syncthreads();
        if (w < 4) { f32x4 o = red[w * 64 + F.lane];
#pragma unroll
            for (int ww = 1; ww < 8; ++ww) o = o + red[(ww * 4 + w) * 64 + F.lane];
            const float bb = bg[fr];
#pragma unroll
            for (int j = 0; j < 4; ++j) F.gate[(size_t)(rb * 64 + w * 16 + 4 * fq + j) * 16 + fr] = o[j] + bb; }
        __syncthreads();
    }
}

constexpr int WA_K = 0, WA_V = 65536, WA_VSTR = 1032, WA_TB = WA_V + 64 * WA_VSTR  , WA_TBS = 320, WA_END = WA_TB + 3 * WA_TBS * 4;
static_assert(WA_END <= MISC_OFF, "WA LDS map");
__device__ __forceinline__ void wattn_item(Ctx& F, int item, int l) {
    const int b = item >> 6, kvh = (item >> 4) & 3, p = item & 15;
    const int tokb = b * SEQ, kpos0 = 256 * p - 128;
    LAS unsigned char* lds = F.lds;
    {
        u32x4 kr[8], vr[8];
        const int kc0 = F.tid >> 3, c = F.tid & 7;
#pragma unroll
        for (int j = 0; j < 8; ++j) { const int kk = kc0 + 64 * j; int pos = kpos0 + kk; pos = pos < 0 ? 0 : (pos > SEQ - 1 ? SEQ - 1 : pos);
            kr[j] = *(const u32x4*)(F.unat + (size_t)(tokb + pos) * LDN + N_AK + kvh * 64 + c * 8); }
        const int d0 = F.tid >> 6, cc = F.tid & 63;
        int vpos = kpos0 + cc * 8; vpos = vpos < 0 ? 0 : (vpos > SEQ - 8 ? SEQ - 8 : vpos);
#pragma unroll
        for (int j = 0; j < 8; ++j) vr[j] = *(const u32x4*)(F.ut + (size_t)(T_AV + kvh * 64 + d0 + 8 * j) * M + tokb + vpos);
#pragma unroll
        for (int j = 0; j < 8; ++j) { const int kk = kc0 + 64 * j; *(LAS u32x4*)(lds + WA_K + kk * 128 + ((c ^ ((kk >> 1) & 7)) << 4)) = kr[j]; }
#pragma unroll
        for (int j = 0; j < 8; ++j) { LAS unsigned char* dst = lds + WA_V + (d0 + 8 * j) * WA_VSTR + cc * 16;
            *(LAS u32x2*)dst = (u32x2){vr[j].x, vr[j].y}; *(LAS u32x2*)(dst + 8) = (u32x2){vr[j].z, vr[j].w}; }
    }
    LAS float* tbw = (LAS float*)(lds + WA_TB);
    for (int i = F.tid; i < 3 * WA_TBS; i += NTHR) { const int g = i / WA_TBS, idx = i % WA_TBS - 31; tbw[i] = (idx >= 0 && idx <= 256) ? F.t5[t5_bucket(idx - 128) * 12 + kvh * 3 + g] * LOG2E : -INFINITY; }
    const int qt = F.wave, r = F.lane & 31, h = F.lane >> 5, ql = 32 * qt + r;
    const int tokq = tokb + 256 * p + ql;
    unsigned bad[16];
#pragma unroll
    for (int i = 0; i < 16; ++i) bad[i] = (unsigned)(WA_TB + (crow(i, h) - r + 31) * 4);
    bf16x8 qf[4];
#pragma unroll
    for (int s = 0; s < 4; ++s) qf[s] = *(const bf16x8*)(F.unat + fm_off<3>(tokq, N_AQ, (kvh * 3) * 64 + 16 * s + 8 * h));
    __syncthreads();
    const int dlo = (p == 0) ? ((4 - qt) > 0 ? (4 - qt) : 0) : 0;
    const int dhi = (p == 15) ? ((12 - qt) < 9 ? (12 - qt) : 9) : 9;
#pragma unroll 1
    for (int g = 0; g < 3; ++g) {
        const int head = kvh * 3 + g;
        bf16x8 qn[4];
        if (g < 2) {
#pragma unroll
            for (int s = 0; s < 4; ++s) qn[s] = *(const bf16x8*)(F.unat + fm_off<3>(tokq, N_AQ, (head + 1) * 64 + 16 * s + 8 * h));
        } else {
#pragma unroll
            for (int s = 0; s < 4; ++s) qn[s] = qf[s];
        }
        u32x2 zz[8];
#pragma unroll
        for (int p = 0; p < 4; ++p) { const u32x4 q_ = *(const u32x4*)(F.unat + fm_off<3>(tokq, N_AZ, head * 64 + 16 * p + 8 * h)); zz[2 * p] = (u32x2){q_.x, q_.y}; zz[2 * p + 1] = (u32x2){q_.z, q_.w}; }
        float m = F.sink[l * 12 + head] * LOG2E, lsum = h ? 0.f : 1.f;
        f32x16 O0 = zero16(), O1 = zero16();
        const unsigned goff = (unsigned)(g * WA_TBS * 4);
#pragma unroll
        for (int dt_ = 0; dt_ < 9; ++dt_) {
            if (dt_ >= dlo && dt_ < dhi) {
                const int kt = qt + dt_;
                f32x16 S = zero16();
                const int krow_ = kt * 32 + r;
#pragma unroll
                for (int s = 0; s < 4; ++s) { const bf16x8 kf = *(const LAS bf16x8*)(lds + WA_K + krow_ * 128 + (((2 * s + h) ^ ((krow_ >> 1) & 7)) << 4)); S = MFMA32(kf, qf[s], S); }
                float bs[16];
#pragma unroll
                for (int i = 0; i < 16; ++i) bs[i] = *(const LAS float*)(lds + (bad[i] + goff) + dt_ * 128);
                float mx = -INFINITY;
#pragma unroll
                for (int i = 0; i < 16; ++i) { const float sv = fmaf(S[i], C2A, bs[i]); S[i] = sv; mx = fmaxf(mx, sv); }
                if (__builtin_amdgcn_ballot_w64(mx > m + 6.f) != 0ull) {
                    mx = fmaxf(mx, shx(mx, 32, F.lane));
                    const float mn = fmaxf(m, mx), al = ex2(m - mn); m = mn; lsum *= al;
#pragma unroll
                    for (int i = 0; i < 16; ++i) { O0[i] *= al; O1[i] *= al; }
                }
#pragma unroll
                for (int i = 0; i < 16; ++i) { const float pv = ex2(S[i] - m); S[i] = pv; lsum += pv; }
                const bf16x8 pb0 = pack8(S, 0), pb1 = pack8(S, 1);
#pragma unroll
                for (int s2 = 0; s2 < 2; ++s2) {
                    const int kof = (kt * 32 + 16 * s2 + 4 * h) * 2;
                    const s16x4 a0 = *(const LAS s16x4*)(lds + WA_V + r * WA_VSTR + kof), a1 = *(const LAS s16x4*)(lds + WA_V + r * WA_VSTR + kof + 16);
                    const s16x4 c0 = *(const LAS s16x4*)(lds + WA_V + (32 + r) * WA_VSTR + kof), c1 = *(const LAS s16x4*)(lds + WA_V + (32 + r) * WA_VSTR + kof + 16);
                    const bf16x8 v0 = __builtin_shufflevector(a0, a1, 0, 1, 2, 3, 4, 5, 6, 7), v1 = __builtin_shufflevector(c0, c1, 0, 1, 2, 3, 4, 5, 6, 7);
                    O0 = MFMA32(v0, s2 ? pb1 : pb0, O0); O1 = MFMA32(v1, s2 ? pb1 : pb0, O1);
                }
            }
        }
        lsum += shx(lsum, 32, F.lane);
        const float inv = frcp(lsum);
        bf16* yp = F.yb + (size_t)tokq * DM + head * 64 + 8 * h;
#pragma unroll
        for (int p = 0; p < 4; ++p) { const auto sx = __builtin_amdgcn_permlane32_swap(zz[2 * p].x, zz[2 * p + 1].x, false, false), sy = __builtin_amdgcn_permlane32_swap(zz[2 * p].y, zz[2 * p + 1].y, false, false);
            zz[2 * p] = (u32x2){sx[0], sy[0]}; zz[2 * p + 1] = (u32x2){sx[1], sy[1]}; }
#pragma unroll
        for (int dt = 0; dt < 2; ++dt) {
            u32x2 wy[4];
#pragma unroll
            for (int g4 = 0; g4 < 4; ++g4) { const u32x2 z2 = zz[dt * 4 + g4];
                const f32x16& O = dt ? O1 : O0;
                const float y0 = O[4 * g4] * inv * silu(bflo(z2.x)), y1 = O[4 * g4 + 1] * inv * silu(bfhi(z2.x)), y2 = O[4 * g4 + 2] * inv * silu(bflo(z2.y)), y3 = O[4 * g4 + 3] * inv * silu(bfhi(z2.y));
                wy[g4].x = cvt_pk_bf16(y0, y1); wy[g4].y = cvt_pk_bf16(y2, y3); }
#pragma unroll
            for (int p = 0; p < 2; ++p) { const auto sx = __builtin_amdgcn_permlane32_swap(wy[2 * p].x, wy[2 * p + 1].x, false, false), sy = __builtin_amdgcn_permlane32_swap(wy[2 * p].y, wy[2 * p + 1].y, false, false);
                u32x4 o; o.x = sx[0]; o.y = sy[0]; o.z = sx[1]; o.w = sy[1]; *(u32x4*)(yp + 32 * dt + 16 * p) = o; }
        }
#pragma unroll
        for (int s = 0; s < 4; ++s) qf[s] = qn[s];
    }
    __syncthreads();
}

constexpr int NA_K = 0, NA_V = 73728, NA_VSTR = 1160, NA_TB = NA_V + 64 * NA_VSTR  , NA_TI = NA_TB + 480 * 4  , NA_X = NA_TI + 2048, NA_XQ = 2560, NA_END = NA_X + 4 * NA_XQ;
static_assert(NA_END <= MISC_OFF, "NA LDS map");
struct NaRegs { u32x4 k[9]; u32x4 v[9]; };
__device__ __forceinline__ void na_decode(int item, int& b, int& head, int& r0, int& rs0) { b = item / 384; head = (item / 32) % 12; r0 = 2 * (item & 31); int t = r0 - 4; rs0 = t < 0 ? 0 : (t > 56 ? 56 : t); }
__device__ __forceinline__ void na_row_issue(Ctx& F, int b, int head, int gr, u32x4& kreg, u32x4& vreg) {
    const int kc = F.tid >> 3, c = F.tid & 7;
    kreg = *(const u32x4*)(F.unat + (size_t)(b * SEQ + gr * 64 + kc) * LDN + N_CK + head * 64 + c * 8);
    vreg = *(const u32x4*)(F.ut + (size_t)(T_CV + head * 64 + kc) * M + b * SEQ + gr * 64 + c * 8);
}
__device__ __forceinline__ void na_row_commit(Ctx& F, int gr, const u32x4& kreg, const u32x4& vreg) {
    const int kc = F.tid >> 3, c = F.tid & 7, slot = gr % 9, kk = slot * 64 + kc;
    *(LAS u32x4*)(F.lds + NA_K + kk * 128 + ((c ^ ((kk >> 1) & 7)) << 4)) = kreg;
    LAS unsigned char* dst = F.lds + NA_V + kc * NA_VSTR + (slot * 64 + c * 8) * 2;
    *(LAS u32x2*)dst = (u32x2){vreg.x, vreg.y}; *(LAS u32x2*)(dst + 8) = (u32x2){vreg.z, vreg.w};
}
#define SCHED_FENCE() __builtin_amdgcn_sched_barrier(0)
template <int CH>
__device__ __forceinline__ void na_tiles(LAS unsigned char* lds, const bf16x8 (&qf)[4], const unsigned (&badf)[16], const unsigned (&badc)[4], int rsj, int khalf, int r, int h,
                                         float& m, float& lsum, f32x16& O0, f32x16& O1) {
    bf16x8 kc[4];
    { const int kb0 = ((rsj + 4 * khalf) % 9) * 64, krow_ = kb0 + r;
#pragma unroll
      for (int s = 0; s < 4; ++s) kc[s] = *(const LAS bf16x8*)(lds + NA_K + krow_ * 128 + (((2 * s + h) ^ ((krow_ >> 1) & 7)) << 4)); }
#pragma unroll
    for (int it = 0; it < 8; ++it) {
        const int kri = it >> 1, kct = it & 1;
        const bool full = (kct == CH);
        const int kbase = ((rsj + 4 * khalf + kri) % 9) * 64 + kct * 32;
        s16x4 va[2][2], vc[2][2]; float bs[16];
#pragma unroll
        for (int s2 = 0; s2 < 2; ++s2) if (full || s2 == (kct ? 0 : 1)) {
            const int kof = (kbase + 16 * s2 + 4 * h) * 2;
            va[s2][0] = *(const LAS s16x4*)(lds + NA_V + r * NA_VSTR + kof); va[s2][1] = *(const LAS s16x4*)(lds + NA_V + r * NA_VSTR + kof + 16);
            vc[s2][0] = *(const LAS s16x4*)(lds + NA_V + (32 + r) * NA_VSTR + kof); vc[s2][1] = *(const LAS s16x4*)(lds + NA_V + (32 + r) * NA_VSTR + kof + 16);
        }
        if (full) {
#pragma unroll
            for (int i = 0; i < 16; ++i) bs[i] = *(const LAS float*)(lds + badf[i] + kri * 128);
        } else {
#pragma unroll
            for (int i = 0; i < 4; ++i) bs[i] = *(const LAS float*)(lds + badc[i] + kri * 128);
        }
        SCHED_FENCE();
        f32x16 S = zero16();
#pragma unroll
        for (int s = 0; s < 4; ++s) S = MFMA32(kc[s], qf[s], S);
        if (it < 7) { const int nb = ((rsj + 4 * khalf + ((it + 1) >> 1)) % 9) * 64 + ((it + 1) & 1) * 32, krow_ = nb + r;
#pragma unroll
            for (int s = 0; s < 4; ++s) kc[s] = *(const LAS bf16x8*)(lds + NA_K + krow_ * 128 + (((2 * s + h) ^ ((krow_ >> 1) & 7)) << 4)); }
        SCHED_FENCE();
        constexpr int NV = 16;
        const int i0 = full ? 0 : (kct ? 0 : 12), nv = full ? NV : 4;
        float mx = -INFINITY;
#pragma unroll
        for (int i = 0; i < NV; ++i) if (i < nv) { const float sv = fmaf(S[i0 + i], C2A, bs[i]); bs[i] = sv; mx = fmaxf(mx, sv); }
        { const auto sw = __builtin_amdgcn_permlane32_swap(__float_as_uint(mx), __float_as_uint(mx), false, false); mx = fmaxf(__uint_as_float(sw[0]), __uint_as_float(sw[1])); }
        const float mn = fmaxf(m, mx), al = ex2(m - mn); m = mn; lsum *= al;
#pragma unroll
        for (int i = 0; i < 16; ++i) { O0[i] *= al; O1[i] *= al; }
#pragma unroll
        for (int i = 0; i < NV; ++i) if (i < nv) { const float pv = ex2(bs[i] - mn); bs[i] = pv; lsum += pv; }
        if (full) {
            u32x4 p0, p1;
            p0.x = cvt_pk_bf16(bs[0], bs[1]); p0.y = cvt_pk_bf16(bs[2], bs[3]); p0.z = cvt_pk_bf16(bs[4], bs[5]); p0.w = cvt_pk_bf16(bs[6], bs[7]);
            p1.x = cvt_pk_bf16(bs[8], bs[9]); p1.y = cvt_pk_bf16(bs[10], bs[11]); p1.z = cvt_pk_bf16(bs[12], bs[13]); p1.w = cvt_pk_bf16(bs[14], bs[15]);
            const bf16x8 pb0 = __builtin_bit_cast(bf16x8, p0), pb1 = __builtin_bit_cast(bf16x8, p1);
            O0 = MFMA32(__builtin_shufflevector(va[0][0], va[0][1], 0, 1, 2, 3, 4, 5, 6, 7), pb0, O0); O1 = MFMA32(__builtin_shufflevector(vc[0][0], vc[0][1], 0, 1, 2, 3, 4, 5, 6, 7), pb0, O1);
            O0 = MFMA32(__builtin_shufflevector(va[1][0], va[1][1], 0, 1, 2, 3, 4, 5, 6, 7), pb1, O0); O1 = MFMA32(__builtin_shufflevector(vc[1][0], vc[1][1], 0, 1, 2, 3, 4, 5, 6, 7), pb1, O1);
        } else {
            u32x4 pw; const unsigned p01 = cvt_pk_bf16(bs[0], bs[1]), p23 = cvt_pk_bf16(bs[2], bs[3]);
            if (kct) { pw.x = p01; pw.y = p23; pw.z = 0u; pw.w = 0u; } else { pw.x = 0u; pw.y = 0u; pw.z = p01; pw.w = p23; }
            const bf16x8 pbx = __builtin_bit_cast(bf16x8, pw);
            const int s2 = kct ? 0 : 1;
            O0 = MFMA32(__builtin_shufflevector(va[s2][0], va[s2][1], 0, 1, 2, 3, 4, 5, 6, 7), pbx, O0); O1 = MFMA32(__builtin_shufflevector(vc[s2][0], vc[s2][1], 0, 1, 2, 3, 4, 5, 6, 7), pbx, O1);
        }
    }
}

__device__ __forceinline__ void nattn_all(Ctx& F, int l) {
    LAS unsigned char* lds = F.lds;
    const int vb = (F.G == 256) ? ((F.bid & 7) * 32 + (F.bid >> 3)) : F.bid;
    const int per = (1536 + F.G - 1) / F.G, it0 = vb * per, it1 = (it0 + per) < 1536 ? (it0 + per) : 1536;
    if (F.wave >= 4) __builtin_amdgcn_s_setprio(1);
    const int qt = F.wave & 3, khalf = F.wave >> 2, j = qt >> 1, ch = qt & 1, r = F.lane & 31, h = F.lane >> 5;
    const int qc = 32 * ch + r; int cs = qc - 8; cs = cs < 0 ? 0 : (cs > 48 ? 48 : cs);
    unsigned badf[16], badc[4];
#pragma unroll
    for (int i = 0; i < 16; ++i) { const int kc = ch * 32 + crow(i, h); const bool ok = (kc >= cs) && (kc < cs + 16); int dc = kc - qc; dc = dc < -15 ? -15 : (dc > 15 ? 15 : dc);
        badf[i] = (unsigned)(NA_TI + ((j * 8 + khalf * 4) * 32 + (ok ? dc + 15 : 31)) * 4); }
#pragma unroll
    for (int i = 0; i < 4; ++i) { const int kct = 1 - ch, ii = (kct ? 0 : 12) + i; const int kc = kct * 32 + crow(ii, h); const bool ok = (kc >= cs) && (kc < cs + 16); int dc = kc - qc; dc = dc < -15 ? -15 : (dc > 15 ? 15 : dc);
        badc[i] = (unsigned)(NA_TI + ((j * 8 + khalf * 4) * 32 + (ok ? dc + 15 : 31)) * 4); }
    int have_bh = -1, have_hi = -1, pf_lo = 0, pf_n = 0, tb_bh = -1;
    u32x4 pk0, pv0, pk1, pv1; bf16x8 qn[4]; bool have_qn = false;
    pk0 = pv0 = pk1 = pv1 = (u32x4){0u, 0u, 0u, 0u};
#pragma unroll
    for (int s = 0; s < 4; ++s) qn[s] = (bf16x8){0, 0, 0, 0, 0, 0, 0, 0};
#pragma unroll 1
    for (int item = it0; item < it1; ++item) {
        int b, head, r0, rs0; na_decode(item, b, head, r0, rs0);
        const int bh = b * 12 + head, need_hi = (rs0 + 8) < 63 ? (rs0 + 8) : 63, tokb = b * SEQ;
        if (bh != have_bh) {
            NaRegs R;
#pragma unroll
            for (int jj = 0; jj < 9; ++jj) { const int gr = (rs0 + jj) < 63 ? (rs0 + jj) : 63; na_row_issue(F, b, head, gr, R.k[jj], R.v[jj]); }
#pragma unroll
            for (int jj = 0; jj < 9; ++jj) { if (rs0 + jj <= 63) na_row_commit(F, rs0 + jj, R.k[jj], R.v[jj]); }
            LAS float* tbw = (LAS float*)(lds + NA_TB);
            for (int i = F.tid; i < 465; i += NTHR) tbw[i] = F.rpb[(size_t)(l * 12 + head) * 465 + i] * LOG2E;
            have_bh = bh;
        } else {
            if (pf_n > 0) na_row_commit(F, pf_lo, pk0, pv0);
            if (pf_n > 1) na_row_commit(F, pf_lo + 1, pk1, pv1);
        }
        have_hi = need_hi;
        if (bh != tb_bh) { LDS_BARRIER(); tb_bh = bh; }
        { const LAS float* tb = (const LAS float*)(lds + NA_TB); const int jj = F.tid >> 8, kidx = (F.tid >> 5) & 7, dci = F.tid & 31;
          int rsq = r0 + jj - 4; rsq = rsq < 0 ? 0 : (rsq > 56 ? 56 : rsq); const int dr = rsq + kidx - (r0 + jj) + 7;
          ((LAS float*)(lds + NA_TI))[F.tid] = dci < 31 ? tb[dr * 31 + dci] : -INFINITY; }
        const int qrow = r0 + j; int rsj = qrow - 4; rsj = rsj < 0 ? 0 : (rsj > 56 ? 56 : rsj);
        const int tokq = tokb + qrow * 64 + qc;
        bf16x8 qf[4];
        if (have_qn) {
#pragma unroll
            for (int s = 0; s < 4; ++s) qf[s] = qn[s];
        } else {
#pragma unroll
            for (int s = 0; s < 4; ++s) qf[s] = *(const bf16x8*)(F.unat + fm_off<3>(tokq, N_CQ, head * 64 + 16 * s + 8 * h));
        }
        u32x2 zz[4];
#pragma unroll
        for (int p = 0; p < 2; ++p) { const u32x4 q_ = *(const u32x4*)(F.unat + fm_off<3>(tokq, N_CZ, head * 64 + 32 * khalf + 16 * p + 8 * h)); zz[2 * p] = (u32x2){q_.x, q_.y}; zz[2 * p + 1] = (u32x2){q_.z, q_.w}; }
        LDS_BARRIER();
        pf_n = 0; have_qn = false;
        if (item + 1 < it1) {
            int nb, nhead, nr0, nrs0; na_decode(item + 1, nb, nhead, nr0, nrs0);
            if (nb * 12 + nhead == bh) {
                const int nhi = (nrs0 + 8) < 63 ? (nrs0 + 8) : 63;
                pf_lo = have_hi + 1; pf_n = nhi - have_hi;
                if (pf_n > 0) na_row_issue(F, b, head, pf_lo, pk0, pv0);
                if (pf_n > 1) na_row_issue(F, b, head, pf_lo + 1, pk1, pv1);
            }
            const int ntokq = nb * SEQ + (nr0 + j) * 64 + qc;
#pragma unroll
            for (int s = 0; s < 4; ++s) qn[s] = *(const bf16x8*)(F.unat + fm_off<3>(ntokq, N_CQ, nhead * 64 + 16 * s + 8 * h));
            have_qn = true;
        }
        float m = -1e30f, lsum = 0.f;
        f32x16 O0 = zero16(), O1 = zero16();
        if (ch == 0) na_tiles<0>(lds, qf, badf, badc, rsj, khalf, r, h, m, lsum, O0, O1); else na_tiles<1>(lds, qf, badf, badc, rsj, khalf, r, h, m, lsum, O0, O1);
        lsum += shx(lsum, 32, F.lane);
        LAS unsigned* xq = (LAS unsigned*)(lds + NA_X + qt * NA_XQ);
        LAS float* xf = (LAS float*)(lds + NA_X + qt * NA_XQ + 2048);
        bf16* yp = F.yb + (size_t)tokq * DM + 1280 + head * 64 + 32 * khalf + 8 * h;
        if (khalf == 1) {
#pragma unroll
            for (int i = 0; i < 8; ++i) xq[i * 64 + F.lane] = cvt_pk_bf16(O0[2 * i], O0[2 * i + 1]);
            xf[F.lane] = m; xf[64 + F.lane] = lsum;
        }
        LDS_BARRIER();
        float m2 = 0.f, l2 = 0.f; unsigned ox[8];
        if (khalf == 0) {
            m2 = xf[F.lane]; l2 = xf[64 + F.lane];
#pragma unroll
            for (int i = 0; i < 8; ++i) ox[i] = xq[i * 64 + F.lane];
        }
        LDS_BARRIER();
        if (khalf == 0) {
#pragma unroll
            for (int i = 0; i < 8; ++i) xq[i * 64 + F.lane] = cvt_pk_bf16(O1[2 * i], O1[2 * i + 1]);
            xf[F.lane] = m; xf[64 + F.lane] = lsum;
        }
        LDS_BARRIER();
        if (khalf == 1) {
            m2 = xf[F.lane]; l2 = xf[64 + F.lane];
#pragma unroll
            for (int i = 0; i < 8; ++i) ox[i] = xq[i * 64 + F.lane];
        }
        {
            const float mn = fmaxf(m, m2), a1 = ex2(m - mn), a2 = ex2(m2 - mn);
            const float inv = frcp(lsum * a1 + l2 * a2);
#pragma unroll
            for (int p = 0; p < 2; ++p) { const auto sx = __builtin_amdgcn_permlane32_swap(zz[2 * p].x, zz[2 * p + 1].x, false, false), sy = __builtin_amdgcn_permlane32_swap(zz[2 * p].y, zz[2 * p + 1].y, false, false);
                zz[2 * p] = (u32x2){sx[0], sy[0]}; zz[2 * p + 1] = (u32x2){sx[1], sy[1]}; }
            u32x2 wy[4];
#pragma unroll
            for (int g4 = 0; g4 < 4; ++g4) {
                float o[4];
#pragma unroll
                for (int e = 0; e < 4; ++e) { const float mine = khalf ? O1[4 * g4 + e] : O0[4 * g4 + e]; const unsigned pw = ox[2 * g4 + (e >> 1)]; const float oth = (e & 1) ? bfhi(pw) : bflo(pw);
                    o[e] = (mine * a1 + oth * a2) * inv; }
                const u32x2 z2 = zz[g4];
                const float y0 = o[0] * silu(bflo(z2.x)), y1 = o[1] * silu(bfhi(z2.x)), y2 = o[2] * silu(bflo(z2.y)), y3 = o[3] * silu(bfhi(z2.y));
                wy[g4].x = cvt_pk_bf16(y0, y1); wy[g4].y = cvt_pk_bf16(y2, y3); }
#pragma unroll
            for (int p = 0; p < 2; ++p) { const auto sx = __builtin_amdgcn_permlane32_swap(wy[2 * p].x, wy[2 * p + 1].x, false, false), sy = __builtin_amdgcn_permlane32_swap(wy[2 * p].y, wy[2 * p + 1].y, false, false);
                u32x4 o4; o4.x = sx[0]; o4.y = sy[0]; o4.z = sx[1]; o4.w = sy[1]; *(u32x4*)(yp + 16 * p) = o4; }
        }
    }
    __builtin_amdgcn_s_setprio(0);
    LDS_BARRIER();
}

__device__ __forceinline__ size_t cst_chunk(int cid, int c, int dt, int k, int r) { const int L = ((dt * 16 + k) * 32 + r) * 8; return ((size_t)((cid * 8 + (L >> 11)) * 64 + c)) * 2048 + (size_t)(L & 2047); }
__device__ __forceinline__ void m1_wave(Ctx& F, int wi, int l) {
    const int b = wi >> 9, head = (wi >> 7) & 3, c = (wi >> 1) & 63, dir = wi & 1;
    const int tok0 = b * SEQ + c * 64;
    const int lane = F.lane, r = lane & 31, h = lane >> 5;
    LAS float* wtab = (LAS float*)(F.lds + F.wave * 256);
    const float ig = F.gate[(size_t)(tok0 + lane) * 16 + (2 * dir) * 4 + head];
    const float fg = F.gate[(size_t)(tok0 + lane) * 16 + (2 * dir + 1) * 4 + head] + F.fbias[l * 8 + dir * 4 + head];
    const float lf = logsigmoid(fg);
    const float cs = dir == 0 ? scan_sum_up(lf, lane) : scan_sum_down(lf, lane);
    const float g = shi(cs, dir == 0 ? 63 : 0);
    const float a = g - cs + ig;
    const float mloc = wave_max(a, lane);
    const float w = fexp(a - mloc);
    wtab[lane] = w;
    LDS_WAIT();
    const int cid = dir * 16 + b * 4 + head;
    if (lane == 0) { F.gs[cid * 64 + c] = g; F.ml[cid * 64 + c] = mloc; }
    f32x4 wv[8];
#pragma unroll
    for (int s = 0; s < 4; ++s) { wv[2 * s] = *(const LAS f32x4*)(wtab + 16 * s + 4 * h); wv[2 * s + 1] = *(const LAS f32x4*)(wtab + 16 * s + 8 + 4 * h); }
    bf16x8 af[4][4];
    {
        bf16x8 kn[2][8];
#pragma unroll
        for (int T = 0; T < 2; ++T)
#pragma unroll
            for (int j = 0; j < 8; ++j) kn[T][j] = *(const bf16x8*)(F.unat + bqk_off(tok0 + 32 * T + r, 512 + head * 128 + 16 * j + 8 * h));
        u32x4 i0, i1;
        { const unsigned one_lo = 0x3F80u, one_hi = 0x3F800000u; const int d0 = r - 8 * h, d1 = r - 16 - 8 * h;
          i0.x = d0 == 0 ? one_lo : d0 == 1 ? one_hi : 0u; i0.y = d0 == 2 ? one_lo : d0 == 3 ? one_hi : 0u; i0.z = d0 == 4 ? one_lo : d0 == 5 ? one_hi : 0u; i0.w = d0 == 6 ? one_lo : d0 == 7 ? one_hi : 0u;
          i1.x = d1 == 0 ? one_lo : d1 == 1 ? one_hi : 0u; i1.y = d1 == 2 ? one_lo : d1 == 3 ? one_hi : 0u; i1.z = d1 == 4 ? one_lo : d1 == 5 ? one_hi : 0u; i1.w = d1 == 6 ? one_lo : d1 == 7 ? one_hi : 0u; }
        const bf16x8 I0 = __builtin_bit_cast(bf16x8, i0), I1 = __builtin_bit_cast(bf16x8, i1);
#pragma unroll
        for (int et = 0; et < 4; ++et)
#pragma unroll
            for (int T = 0; T < 2; ++T) {
                f32x16 d = zero16();
                d = MFMA32(kn[T][2 * et], I0, d); d = MFMA32(kn[T][2 * et + 1], I1, d);
                af[et][2 * T] = pack8(d, 0); af[et][2 * T + 1] = pack8(d, 1);
            }
    }
#pragma unroll
    for (int et = 0; et < 4; ++et) { float ns = 0.f;
#pragma unroll
        for (int s = 0; s < 4; ++s) { const u32x4 raw = __builtin_bit_cast(u32x4, af[et][s]); const f32x4 w0 = wv[2 * s], w1 = wv[2 * s + 1];
            ns += bflo(raw.x) * w0[0] + bfhi(raw.x) * w0[1] + bflo(raw.y) * w0[2] + bfhi(raw.y) * w0[3] + bflo(raw.z) * w1[0] + bfhi(raw.z) * w1[1] + bflo(raw.w) * w1[2] + bfhi(raw.w) * w1[3]; }
        ns += shx(ns, 32, lane);
        if (h == 0) F.nst[(size_t)(cid * 64 + c) * 128 + 32 * et + r] = ns; }
#pragma unroll 1
    for (int dt = 0; dt < 4; ++dt) {
        bf16x8 bfr[4];
#pragma unroll
        for (int s = 0; s < 4; ++s) {
            const u32x4 q = *(const u32x4*)(F.ut + (size_t)(T_BV + head * 128 + 32 * dt + r) * M + tok0 + 16 * s + 8 * h);
            const auto sx = __builtin_amdgcn_permlane32_swap(q.x, q.z, false, false), sy = __builtin_amdgcn_permlane32_swap(q.y, q.w, false, false);
            u32x4 raw; raw.x = sx[0]; raw.y = sy[0]; raw.z = sx[1]; raw.w = sy[1];
            const f32x4 w0 = wv[2 * s], w1 = wv[2 * s + 1];
            u32x4 o; o.x = cvt_pk_bf16(bflo(raw.x) * w0[0], bfhi(raw.x) * w0[1]); o.y = cvt_pk_bf16(bflo(raw.y) * w0[2], bfhi(raw.y) * w0[3]);
            o.z = cvt_pk_bf16(bflo(raw.z) * w1[0], bfhi(raw.z) * w1[1]); o.w = cvt_pk_bf16(bflo(raw.w) * w1[2], bfhi(raw.w) * w1[3]);
            bfr[s] = __builtin_bit_cast(bf16x8, o);
        }
#pragma unroll
        for (int et = 0; et < 4; ++et) {
            f32x16 acc = zero16();
#pragma unroll
            for (int s = 0; s < 4; ++s) acc = MFMA32(af[et][s], bfr[s], acc);
#pragma unroll
            for (int p = 0; p < 2; ++p) {
                const unsigned a0 = cvt_pk_bf16(acc[8 * p], acc[8 * p + 1]), a1 = cvt_pk_bf16(acc[8 * p + 2], acc[8 * p + 3]);
                const unsigned b0 = cvt_pk_bf16(acc[8 * p + 4], acc[8 * p + 5]), b1 = cvt_pk_bf16(acc[8 * p + 6], acc[8 * p + 7]);
                const auto s0 = __builtin_amdgcn_permlane32_swap(a0, b0, false, false), s1 = __builtin_amdgcn_permlane32_swap(a1, b1, false, false);
                u32x4 o; o.x = s0[0]; o.y = s1[0]; o.z = s0[1]; o.w = s1[1];
                *(u32x4*)(F.cst + cst_chunk(cid, c, dt, 4 * et + 2 * p + h, r)) = o; }
        }
    }
    LDS_WAIT();
}

__device__ __forceinline__ void m2_scan(Ctx& F) {
    LAS float* sps = (LAS float*)F.lds; LAS float* sls = sps + 64;
    for (int blk = F.bid; blk < 256; blk += F.G) {
        const int cid = blk >> 3, dir = cid >> 4, e4 = (blk & 7) * 512 + F.tid;
        if (F.wave == 0) {
            const int sidx = F.lane, c = dir ? 63 - sidx : sidx;
            const float g = F.gs[cid * 64 + c], mloc = F.ml[cid * 64 + c];
            const float Gs = scan_sum_up(g, sidx);
            const float ma = Gs + fmaxf(0.f, scan_max_up(mloc - Gs, sidx));
            const float mb0 = shi(ma, sidx - 1); const float mb = sidx == 0 ? 0.f : mb0;
            sps[sidx] = fexp(g + mb - ma); sls[sidx] = fexp(mloc - ma); F.mprev[cid * 64 + c] = mb;
        }
        __syncthreads();
        float C0 = 0.f, C1 = 0.f, C2 = 0.f, C3 = 0.f;
        f32x4 nn = {0.f, 0.f, 0.f, 0.f};
        const bool do_n = e4 < 32;
        bf16* cb = F.cst + (size_t)(cid * 8 + (blk & 7)) * 64 * 2048 + F.tid * 4;
        float* nb = F.nst + (size_t)cid * 64 * 128 + (e4 & 31) * 4;
#pragma unroll 1
        for (int s0 = 0; s0 < 64; s0 += 16) {
            u32x2 cl[16]; f32x4 nl[16];
#pragma unroll
            for (int j = 0; j < 16; ++j) { const int c = dir ? 63 - (s0 + j) : (s0 + j); cl[j] = *(const u32x2*)(cb + (size_t)c * 2048); }
            if (do_n) {
#pragma unroll
                for (int j = 0; j < 16; ++j) { const int c = dir ? 63 - (s0 + j) : (s0 + j); nl[j] = *(const f32x4*)(nb + (size_t)c * 128); }
            }
#pragma unroll
            for (int j = 0; j < 16; ++j) {
                const int c = dir ? 63 - (s0 + j) : (s0 + j);
                u32x2 o; o.x = cvt_pk_bf16(C0, C1); o.y = cvt_pk_bf16(C2, C3); *(u32x2*)(cb + (size_t)c * 2048) = o;
                const float sp = sps[s0 + j], sl = sls[s0 + j];
                C0 = sp * C0 + sl * bflo(cl[j].x); C1 = sp * C1 + sl * bfhi(cl[j].x); C2 = sp * C2 + sl * bflo(cl[j].y); C3 = sp * C3 + sl * bfhi(cl[j].y);
                if (do_n) { *(f32x4*)(nb + (size_t)c * 128) = nn; nn = nn * sp + nl[j] * sl; }
            }
        }
        __syncthreads();
    }
}

constexpr int M3_TABW = 2560, M3_HB = 8 * M3_TABW  , M3_HW = 16384;
static_assert(M3_HB + 8 * M3_HW <= MISC_OFF, "M3 LDS map");
__device__ __forceinline__ void m3_wave(Ctx& F, int wi, int l) {
    const int b = wi >> 9, head = (wi >> 7) & 3, c = (wi >> 1) & 63, tt = wi & 1;
    const int tok0 = b * SEQ + c * 64;
    int lane_ = 0; asm volatile("" : "+v"(lane_)); lane_ = (int)__builtin_amdgcn_mbcnt_hi(~0u, __builtin_amdgcn_mbcnt_lo(~0u, (unsigned)lane_));
    const int lane = lane_, r = lane & 31, h = lane >> 5;
    LAS float* tab = (LAS float*)(F.lds + F.wave * M3_TABW);
    LAS float* hb = (LAS float*)(F.lds + M3_HB + F.wave * M3_HW);
    const int cidf = b * 4 + head, cidb = 16 + b * 4 + head;
    const int t = 32 * tt + r;
    const float* gp = F.gate + (size_t)(tok0 + lane) * 16;
    const float g_if = gp[head], g_ff = gp[4 + head], g_ib = gp[8 + head], g_fb = gp[12 + head];
    const float mpf = F.mprev[cidf * 64 + c], mpb = F.mprev[cidb * 64 + c];
    const float* nf = F.nst + (size_t)(cidf * 64 + c) * 128; const float* nbw = F.nst + (size_t)(cidb * 64 + c) * 128;
    const float n0_ = nf[lane], n1_ = nf[64 + lane], n2_ = nbw[lane], n3_ = nbw[64 + lane];
    bf16x8 qf[8], kf0[8];
#pragma unroll
    for (int s = 0; s < 8; ++s) qf[s] = *(const bf16x8*)(F.unat + bqk_off(tok0 + t, head * 128 + 16 * s + 8 * h));
#pragma unroll
    for (int s = 0; s < 8; ++s) kf0[s] = *(const bf16x8*)(F.unat + bqk_off(tok0 + r, 512 + head * 128 + 16 * s + 8 * h));
    SCHED_FENCE();
    {
        const float f_f = g_ff + F.fbias[l * 8 + head], f_b = g_fb + F.fbias[l * 8 + 4 + head];
        const float bf_ = scan_sum_up(logsigmoid(f_f), lane), bb_ = scan_sum_down(logsigmoid(f_b), lane);
        const float uf = g_if - bf_, ub = g_ib - bb_;
        const float MF = fmaxf(mpf, scan_max_up(uf, lane)), MB = fmaxf(mpb, scan_max_down(ub, lane));
        tab[lane] = uf; tab[64 + lane] = ub; tab[128 + lane] = MF; tab[192 + lane] = MB; tab[256 + lane] = bf_; tab[320 + lane] = bb_;
        tab[384 + lane] = n0_; tab[448 + lane] = n1_; tab[512 + lane] = n2_; tab[576 + lane] = n3_;
        LDS_WAIT();
    }
    f32x16 S0 = zero16(), S1 = zero16();
    {
        bf16x8 kf1[8];
#pragma unroll
        for (int s = 0; s < 8; ++s) kf1[s] = *(const bf16x8*)(F.unat + bqk_off(tok0 + 32 + r, 512 + head * 128 + 16 * s + 8 * h));
        SCHED_FENCE();
#pragma unroll
        for (int s = 0; s < 8; ++s) S0 = MFMA32(kf0[s], qf[s], S0);
#pragma unroll
        for (int s = 0; s < 8; ++s) S1 = MFMA32(kf1[s], qf[s], S1);
    }
    bf16x8 pb[2][4]; float interw[2], inv[2];
#pragma unroll
    for (int dir = 0; dir < 2; ++dir) {
        const LAS float* U = tab + dir * 64;
        const float Mt = tab[128 + dir * 64 + t], Bt = tab[256 + dir * 64 + t], mp = dir ? mpb : mpf;
        const LAS float* np = tab + 384 + dir * 128 + 8 * h;
        float nq = 0.f;
#pragma unroll
        for (int s = 0; s < 8; ++s) { const f32x4 n0 = *(const LAS f32x4*)(np + 16 * s), n1 = *(const LAS f32x4*)(np + 16 * s + 4); const u32x4 qq = __builtin_bit_cast(u32x4, qf[s]);
            nq += n0[0] * bflo(qq.x) + n0[1] * bfhi(qq.x) + n0[2] * bflo(qq.y) + n0[3] * bfhi(qq.y) + n1[0] * bflo(qq.z) + n1[1] * bfhi(qq.z) + n1[2] * bflo(qq.w) + n1[3] * bfhi(qq.w); }
        nq += shx(nq, 32, lane);
        interw[dir] = fexp(mp - Mt) * QS;
        float den = 0.f;
#pragma unroll
        for (int st = 0; st < 2; ++st) {
            f32x16 P;
#pragma unroll
            for (int g4 = 0; g4 < 4; ++g4) { const f32x4 uu = *(const LAS f32x4*)(U + 32 * st + 8 * g4 + 4 * h);
#pragma unroll
                for (int e = 0; e < 4; ++e) { const int sp = 32 * st + 8 * g4 + 4 * h + e; const bool ok = dir ? (sp >= t) : (sp <= t);
                    const float wgt = ok ? fexp(uu[e] - Mt) : 0.f; const float pv = (st ? S1[4 * g4 + e] : S0[4 * g4 + e]) * QS * wgt; P[4 * g4 + e] = pv; den += pv; } }
            pb[dir][2 * st] = pack8(P, 0); pb[dir][2 * st + 1] = pack8(P, 1);
        }
        den += shx(den, 32, lane);
        den += nq * interw[dir];
        inv[dir] = frcp(fmaxf(fabsf(den), fexp(-(Bt + Mt))));
    }
    bf16x8 cfa[8], cfb[8]; s16x4 vv[8]; u32x2 og[4];
    int ro = r, ho = h; asm volatile("" : "+v"(ro), "+v"(ho));
    const int to = 32 * tt + ro;
#define M3_LOADC(dst, dir, dt) do { SCHED_FENCE(); { const bf16* cp = F.cst + cst_chunk((dir ? cidb : cidf), c, (dt), ho, ro); \
        _Pragma("unroll") for (int s = 0; s < 8; ++s) dst[s] = *(const bf16x8*)(cp + ((s & 3) * 2 * 256) + (s >> 2) * ((size_t)64 * 2048)); } SCHED_FENCE(); } while (0)
#define M3_LOADV(dt) do { SCHED_FENCE(); { const bf16* vp = F.ut + (size_t)(T_BV + head * 128 + 32 * (dt) + ro) * M + tok0 + 8 * ho; \
        _Pragma("unroll") for (int ks = 0; ks < 4; ++ks) { const u32x4 q_ = *(const u32x4*)(vp + 16 * ks); vv[2 * ks] = __builtin_bit_cast(s16x4, (u32x2){q_.x, q_.y}); vv[2 * ks + 1] = __builtin_bit_cast(s16x4, (u32x2){q_.z, q_.w}); } } \
        { _Pragma("unroll") for (int p = 0; p < 2; ++p) { const u32x4 q_ = *(const u32x4*)(F.unat + fm_off<2>(tok0 + to, N_BO, head * 128 + 32 * (dt) + 16 * p + 8 * ho)); og[2 * p] = (u32x2){q_.x, q_.y}; og[2 * p + 1] = (u32x2){q_.z, q_.w}; } } SCHED_FENCE(); } while (0)
    M3_LOADC(cfa, 0, 0); M3_LOADV(0);
    float s1 = 0.f, s2 = 0.f;
#pragma unroll 1
    for (int dt = 0; dt < 4; ++dt) {
        f32x16 H;
#pragma unroll
        for (int ks = 0; ks < 4; ++ks) {
            const u32x2 lo = __builtin_bit_cast(u32x2, vv[2 * ks]), hi = __builtin_bit_cast(u32x2, vv[2 * ks + 1]);
            const auto sx = __builtin_amdgcn_permlane32_swap(lo.x, hi.x, false, false), sy = __builtin_amdgcn_permlane32_swap(lo.y, hi.y, false, false);
            vv[2 * ks] = __builtin_bit_cast(s16x4, (u32x2){sx[0], sy[0]}); vv[2 * ks + 1] = __builtin_bit_cast(s16x4, (u32x2){sx[1], sy[1]}); }
        {
            f32x16 X = zero16();
#pragma unroll
            for (int s = 0; s < 8; ++s) X = MFMA32(cfa[s], qf[s], X);
            M3_LOADC(cfb, 1, dt);
            const float iw = interw[0];
#pragma unroll
            for (int i = 0; i < 16; ++i) X[i] *= iw;
#pragma unroll
            for (int ks = 0; ks < 4; ++ks) X = MFMA32(__builtin_shufflevector(vv[2 * ks], vv[2 * ks + 1], 0, 1, 2, 3, 4, 5, 6, 7), pb[0][ks], X);
            const float iv = inv[0];
#pragma unroll
            for (int i = 0; i < 16; ++i) H[i] = X[i] * iv;
        }
        {
            f32x16 X = zero16();
#pragma unroll
            for (int s = 0; s < 8; ++s) X = MFMA32(cfb[s], qf[s], X);
            if (dt < 3) M3_LOADC(cfa, 0, dt + 1);
            const float iw = interw[1];
#pragma unroll
            for (int i = 0; i < 16; ++i) X[i] *= iw;
#pragma unroll
            for (int ks = 0; ks < 4; ++ks) X = MFMA32(__builtin_shufflevector(vv[2 * ks], vv[2 * ks + 1], 0, 1, 2, 3, 4, 5, 6, 7), pb[1][ks], X);
            const float iv = inv[1];
#pragma unroll
            for (int i = 0; i < 16; ++i) H[i] += X[i] * iv;
        }
#pragma unroll
        for (int p = 0; p < 2; ++p) { const auto sx = __builtin_amdgcn_permlane32_swap(og[2 * p].x, og[2 * p + 1].x, false, false), sy = __builtin_amdgcn_permlane32_swap(og[2 * p].y, og[2 * p + 1].y, false, false);
            og[2 * p] = (u32x2){sx[0], sy[0]}; og[2 * p + 1] = (u32x2){sx[1], sy[1]}; }
#pragma unroll
        for (int g4 = 0; g4 < 4; ++g4) { const u32x2 oo = og[g4];
            H[4 * g4] *= sigm(bflo(oo.x)); H[4 * g4 + 1] *= sigm(bfhi(oo.x)); H[4 * g4 + 2] *= sigm(bflo(oo.y)); H[4 * g4 + 3] *= sigm(bfhi(oo.y)); }
        if (dt < 3) M3_LOADV(dt + 1);
#pragma unroll
        for (int i = 0; i < 16; ++i) { s1 += H[i]; s2 += H[i] * H[i]; hb[(dt * 16 + i) * 64 + lane] = H[i]; }
    }
#undef M3_LOADC
#undef M3_LOADV
    s1 += shx(s1, 32, lane); s2 += shx(s2, 32, lane);
    const float mean = s1 * (1.f / 128.f), var = fmaxf(s2 * (1.f / 128.f) - mean * mean, 0.f), rstd = __builtin_amdgcn_rsqf(var + LN_EPS);
    LDS_WAIT();
    int rz = r, hz = h; asm volatile("" : "+v"(rz), "+v"(hz)); const int tz = 32 * tt + rz;
    bf16* yp = F.yb + (size_t)(tok0 + tz) * DM + 768 + head * 128 + 8 * hz;
    const float* ng = F.norm_g + l * 512 + head * 128 + 4 * hz;
#pragma unroll 1
    for (int half = 0; half < 2; ++half) {
        u32x4 zq[4]; u32x2 zz[8]; f32x4 gn[8];
#pragma unroll
        for (int p = 0; p < 4; ++p) zq[p] = *(const u32x4*)(F.unat + fm_off<2>(tok0 + tz, N_BZ, head * 128 + 16 * (4 * half + p) + 8 * hz));
#pragma unroll
        for (int i = 0; i < 8; ++i) gn[i] = *(const f32x4*)(ng + 8 * (8 * half + i));
#pragma unroll
        for (int p = 0; p < 4; ++p) { const auto sx = __builtin_amdgcn_permlane32_swap(zq[p].x, zq[p].z, false, false), sy = __builtin_amdgcn_permlane32_swap(zq[p].y, zq[p].w, false, false);
            zz[2 * p] = (u32x2){sx[0], sy[0]}; zz[2 * p + 1] = (u32x2){sx[1], sy[1]}; }
        u32x2 wy[8];
#pragma unroll
        for (int i = 0; i < 8; ++i) { const int ii = 8 * half + i;
            const float h0 = hb[(4 * ii) * 64 + lane], h1 = hb[(4 * ii + 1) * 64 + lane], h2 = hb[(4 * ii + 2) * 64 + lane], h3 = hb[(4 * ii + 3) * 64 + lane];
            const float y0 = (h0 - mean) * rstd * gn[i][0] * silu(bflo(zz[i].x)), y1 = (h1 - mean) * rstd * gn[i][1] * silu(bfhi(zz[i].x));
            const float y2 = (h2 - mean) * rstd * gn[i][2] * silu(bflo(zz[i].y)), y3 = (h3 - mean) * rstd * gn[i][3] * silu(bfhi(zz[i].y));
            wy[i].x = cvt_pk_bf16(y0, y1); wy[i].y = cvt_pk_bf16(y2, y3); }
#pragma unroll
        for (int p = 0; p < 4; ++p) { const auto sx = __builtin_amdgcn_permlane32_swap(wy[2 * p].x, wy[2 * p + 1].x, false, false), sy = __builtin_amdgcn_permlane32_swap(wy[2 * p].y, wy[2 * p + 1].y, false, false);
            u32x4 o; o.x = sx[0]; o.y = sy[0]; o.z = sx[1]; o.w = sy[1]; *(u32x4*)(yp + 16 * (4 * half + p)) = o; }
    }
    LDS_WAIT();
}

__global__ void __launch_bounds__(NTHR, 2) mega(Args args) {
    extern __shared__ __attribute__((aligned(16))) unsigned char lds_raw[];
    LAS unsigned char* const ldsb = (LAS unsigned char*)lds_raw;
    const int wave_s = __builtin_amdgcn_readfirstlane((int)threadIdx.x >> 6);
#define TID_NOW() ([&]() { unsigned z_ = 0u; asm volatile("" : "+v"(z_)); return wave_s * 64 + (int)__builtin_amdgcn_mbcnt_hi(~0u, __builtin_amdgcn_mbcnt_lo(~0u, z_)); }())
#define MAKE_CTX() MAKE_CTX_L(1)
#define MAKE_CTX_L(lyr) Ctx F; { const int l_ = (lyr); auto kp_ = __builtin_amdgcn_kernarg_segment_ptr(); asm volatile("" : "+s"(kp_)); \
    const __attribute__((address_space(4))) Args* ap_ = (const __attribute__((address_space(4))) Args*)kp_; \
    F.lds = ldsb; { int tid_ = TID_NOW(); asm volatile("" : "+v"(tid_)); F.tid = tid_; } F.lane = F.tid & 63; F.wave = wave_s; F.G = gridDim.x; F.bid = blockIdx.x; \
    F.x = ap_->in[0]; F.emb_g = ap_->in[1]; F.emb_b = ap_->in[2]; F.w_in = ap_->in[3]; F.b_in = ap_->in[4]; F.w_out = ap_->in[5]; F.b_out = ap_->in[6]; \
    F.ln_g = ap_->in[7]; F.ln_b = ap_->in[8]; F.t5 = ap_->in[9]; F.sink = ap_->in[10]; F.fbias = ap_->in[11]; F.norm_g = ap_->in[12]; F.rpb = ap_->in[13]; \
    F.out = ap_->out; F.ws = ap_->ws; \
    F.hby = (bf16*)(F.ws + WS_HBY); F.yb = l_ == 0 ? (bf16*)F.out : F.hby; F.unat = (bf16*)(F.ws + WS_UNAT); F.ut = (bf16*)(F.ws + WS_UT); F.cst = (bf16*)(F.ws + WS_CST); F.nst = (float*)(F.ws + WS_NST); \
    F.gs = (float*)(F.ws + WS_SCAL); F.ml = F.gs + 2048; F.mprev = F.gs + 4096; F.gate = (float*)(F.ws + WS_GATE); F.stat = (float*)(F.ws + WS_SCAL + 65536); }
    volatile LAS unsigned* MISC = (volatile LAS unsigned*)(ldsb + MISC_OFF);
    if (threadIdx.x < 32) MISC[threadIdx.x] = 0u;
    __syncthreads();
    XcdBarrier bar; bar.bar = (unsigned*)(args.ws + WS_CTL) + CW_BAR; bar.x = 0; bar.st = nullptr;
    if (!MK_PER_PHASE) bar = xcd_barrier_post((unsigned*)(args.ws + WS_CTL) + CW_BAR, MISC + 8, (int)threadIdx.x);
    const int lo = args.ph_lo, hi = args.ph_hi;
#define IN(k) (lo <= (k) && (k) < hi)
#define SEAM(k) do { if (IN(k) && IN((k) + 1)) { for (int rb_ = 0; rb_ < REP_BAR; ++rb_) xcd_barrier(bar, TID_NOW()); } } while (0)
    #ifndef NO_P0
    if (IN(0)) { MAKE_CTX(); for (int rep_ = 0, nrep_ = opaque_int(REP_P0); rep_ < nrep_; ++rep_) phase_prologue(F); }
#endif
    SEAM(0);
#pragma unroll 1
    for (int l = 0; l < 2; ++l) {
        const int pb = 1 + 6 * l;
        if (IN(pb)) {
#ifndef NO_G1
            {   MAKE_CTX_L(l);
                pg8::Sched1 S{(const char*)F.hby, (const char*)(F.ws + WS_WIN + l * WIN_STRIDE), F.G, F.bid};
                pg8::Epi1 E{F.unat, F.ut, (const float*)(F.ws + WS_BIAS) + l * WROWS};
                pg8::gemm_phase<pg8::Epi1, pg8::Sched1, true, true>(F.lds, S, E, F.tid); }
#endif
#ifndef NO_GATES
            {   MAKE_CTX_L(l);
                if (l == 0) { bool is_h; int hid, nh; helper_of(F, 0, is_h, hid, nh); if (is_h) { weights_job(F, 1, hid * NWAVES + F.wave, nh * NWAVES); } __syncthreads(); }
                gates_job(F, l); }
#endif
        }
        SEAM(pb);
        if (IN(pb + 1)) {
            MAKE_CTX_L(l);
#ifndef NO_M1
            for (int rep_ = 0, nrep_ = opaque_int(REP_M1); rep_ < nrep_; ++rep_) for (int wi = F.bid * NWAVES + F.wave; wi < 2048; wi += F.G * NWAVES) m1_wave(F, wi, l);
#endif
            __syncthreads();
#ifndef NO_WA
            for (int rep_ = 0, nrep_ = opaque_int(REP_WA); rep_ < nrep_; ++rep_) for (int it0 = F.bid; it0 < 256; it0 += F.G) wattn_item(F, (F.G == 256) ? ((it0 & 7) * 32 + (it0 >> 3)) : it0, l);
#endif
        }
        SEAM(pb + 1);
        if (IN(pb + 2)) {
            MAKE_CTX_L(l);
#ifndef NO_M2
            m2_scan(F);
#endif
#ifndef NO_NA
            for (int rep_ = 0, nrep_ = opaque_int(REP_NA); rep_ < nrep_; ++rep_) nattn_all(F, l);
#endif
        }
        SEAM(pb + 2);
        if (IN(pb + 3)) {
            MAKE_CTX_L(l);
#ifndef NO_M3
            for (int rep_ = 0, nrep_ = opaque_int(REP_M3); rep_ < nrep_; ++rep_) for (int wi = F.bid * NWAVES + F.wave; wi < 2048; wi += F.G * NWAVES) m3_wave(F, wi, l);
#endif
        }
        SEAM(pb + 3);
        if (IN(pb + 4)) {
            MAKE_CTX_L(l);
            pg8::Sched2 S{(const char*)F.yb, (const char*)(F.ws + WS_WOUT + l * WOUT_STRIDE), F.G, F.bid};
#ifndef NO_G2
            if (l == 0) { pg8::Epi2<0> E{(float*)nullptr, (bf16*)(F.ws + WS_WIN), F.b_out, F.x, (const bf16*)F.hby, F.stat, F.emb_g, F.emb_b, (bf16*)(F.ws + WS_T1B)};
                pg8::gemm_phase<pg8::Epi2<0>, pg8::Sched2, true, true>(F.lds, S, E, F.tid); }
            else { pg8::Epi2<1> E{(float*)nullptr, (bf16*)(F.ws + WS_UNAT), F.b_out + DM, (const float*)nullptr, (const bf16*)nullptr, (const float*)nullptr, (const float*)nullptr, (const float*)nullptr, (bf16*)nullptr};
                pg8::gemm_phase<pg8::Epi2<1>, pg8::Sched2, true, true>(F.lds, S, E, F.tid); }
#endif
        }
        SEAM(pb + 4);
        if (IN(pb + 5)) {
            MAKE_CTX_L(l);
            const int gw = F.bid * NWAVES + F.wave, NGW = F.G * NWAVES;
            if (l == 0) { for (int m = 2 * gw; m < M; m += 2 * NGW) ln_row2_b(t1_row(F.ws, m), t1_row(F.ws, m + 1), F.hby + (size_t)m * DM, F.hby + (size_t)(m + 1) * DM, F.stat + (size_t)(M + m) * 2, F.stat + (size_t)(M + m + 1) * 2, F.ln_g, F.ln_b, F.lane); }
            else { const bf16* O2 = (const bf16*)(F.ws + WS_UNAT);
                   for (int m = 2 * gw; m < M; m += 2 * NGW) fin_row2(t1_row(F.ws, m), O2 + (size_t)m * DM, F.stat + (size_t)(M + m) * 2, F.ln_g, F.ln_b, F.ln_g + DM, F.ln_b + DM, F.out + (size_t)m * DM, F.lane); }
        }
        if (l == 0) SEAM(pb + 5);
    }
#undef IN
#undef SEAM
}

extern "C" void kernel_launch(void* const* d_in, const int* in_sizes, int n_in, void* d_out, int out_size, void* d_ws, size_t ws_size, hipStream_t stream) {
    static int grid = 0;
    if (grid == 0) {
        if (n_in != 14 || out_size != M * DM || ws_size < WS_END) { fprintf(stderr, "kernel_launch: unexpected shapes (n_in %d out %d ws %zu)\n", n_in, out_size, ws_size); grid = -1; return; }
        int dev = 0, cus = 0, per_cu = 0;
        if (hipGetDevice(&dev) != hipSuccess || hipDeviceGetAttribute(&cus, hipDeviceAttributeMultiprocessorCount, dev) != hipSuccess) { grid = -1; return; }
        if (hipFuncSetAttribute((const void*)mega, hipFuncAttributeMaxDynamicSharedMemorySize, LDS_BYTES) != hipSuccess) { fprintf(stderr, "kernel_launch: hipFuncSetAttribute failed\n"); grid = -1; return; }
        if (hipOccupancyMaxActiveBlocksPerMultiprocessor(&per_cu, (const void*)mega, NTHR, LDS_BYTES) != hipSuccess || per_cu < 1) fprintf(stderr, "kernel_launch: occupancy query says %d\n", per_cu);
        (void)hipGetLastError();
        grid = cus;
    }
    if (grid < 0) return;
    (void)hipMemsetAsync((char*)d_ws + WS_CTL, 0, CTL_BYTES, stream);
    Args a{};
    for (int i = 0; i < 14; ++i) a.in[i] = (const float*)d_in[i];
    a.out = (float*)d_out; a.ws = (unsigned char*)d_ws;
#if MK_PER_PHASE
    for (int p = 0; p < 13; ++p) { a.ph_lo = p; a.ph_hi = p + 1; hipLaunchKernelGGL(mega, dim3(grid), dim3(NTHR), LDS_BYTES, stream, a); }
#else
    a.ph_lo = 0; a.ph_hi = 13;
    hipLaunchKernelGGL(mega, dim3(grid), dim3(NTHR), LDS_BYTES, stream, a);
#endif
}
```

```cpp
#include <hip/hip_runtime.h>
#include <cstdio>
#include <cstdint>

#ifndef REP_P0
#define REP_P0 1
#endif
#ifndef REP_G1
#define REP_G1 1
#endif
#ifndef REP_M1
#define REP_M1 1
#endif
#ifndef REP_WA
#define REP_WA 1
#endif
#ifndef REP_NA
#define REP_NA 1
#endif
#ifndef REP_M3
#define REP_M3 1
#endif
#ifndef REP_GATES
#define REP_GATES 1
#endif
#ifndef REP_BAR
#define REP_BAR 1
#endif
#ifndef MK_PER_PHASE
#define MK_PER_PHASE 0
#endif

#define LAS __attribute__((address_space(3)))
#define GAS __attribute__((address_space(1)))
typedef unsigned short bf16;
typedef short bf16x8 __attribute__((ext_vector_type(8)));
typedef short s16x4 __attribute__((ext_vector_type(4)));
typedef float f32x4 __attribute__((ext_vector_type(4)));
typedef float f32x16 __attribute__((ext_vector_type(16)));
typedef unsigned u32x4 __attribute__((ext_vector_type(4)));
typedef unsigned u32x2 __attribute__((ext_vector_type(2)));
typedef GAS unsigned gu32;

constexpr int M = 16384, DM = 2048, SEQ = 4096, IN_W = 7696, NWAVES = 8, NTHR = 512;
constexpr int LDN = 6144;
constexpr int N_AQ = 0, N_AK = 768, N_AZ = 1024, N_BQ = 1792, N_BK = 2304, N_BO = 2816, N_BZ = 3328, N_CQ = 3840, N_CK = 4608, N_CZ = 5376;
constexpr int T_AV = 0, T_BK = 256, T_BV = 768, T_CV = 1280;
constexpr int WROWS = 8192 + 16;
constexpr float LN_EPS = 1e-5f, LOG2E = 1.4426950408889634f, ALPHA = 1.4142135623730951f;
constexpr float C2A = 0.125f * LOG2E;
constexpr float QS = 0.08838834764831845f;

constexpr size_t MiB = 1u << 20;
constexpr size_t WS_CTL = 0, CTL_BYTES = 1 * MiB;
constexpr size_t WS_WIN = 2 * MiB, WIN_STRIDE = 33 * MiB;
constexpr size_t WS_WOUT = 68 * MiB, WOUT_STRIDE = 8 * MiB;
constexpr size_t WS_BIAS = 84 * MiB;
constexpr size_t WS_GATE = 85 * MiB;
constexpr size_t WS_HBY = 86 * MiB;
constexpr size_t WS_UNAT = 150 * MiB;
constexpr size_t WS_UT = 342 * MiB;
constexpr size_t WS_CST = 406 * MiB;
constexpr size_t WS_NST = 470 * MiB;
constexpr size_t WS_SCAL = 471 * MiB;
constexpr size_t WS_T1B = 472 * MiB;
constexpr size_t WS_END = 504 * MiB;
constexpr int CW_BAR = 4096;

constexpr int LDS_BYTES = 163840, MISC_OFF = LDS_BYTES - 128;

__device__ __forceinline__ int opaque_int(int v) { asm volatile("" : "+s"(v)); return v; }
#define LDS_WAIT() asm volatile("s_waitcnt lgkmcnt(0)" ::: "memory")
#define LDS_BARRIER() do { asm volatile("s_waitcnt lgkmcnt(0)" ::: "memory"); __builtin_amdgcn_s_barrier(); asm volatile("" ::: "memory"); } while (0)
#define VM_WAIT() asm volatile("s_waitcnt vmcnt(0)" ::: "memory")
__device__ __forceinline__ float bf2f(unsigned v) { return __uint_as_float(v << 16); }
__device__ __forceinline__ float bflo(unsigned v) { return __uint_as_float(v << 16); }
__device__ __forceinline__ float bfhi(unsigned v) { return __uint_as_float(v & 0xffff0000u); }
typedef float f32x2_t __attribute__((ext_vector_type(2)));
typedef __bf16 bf16x2_t __attribute__((ext_vector_type(2)));
__device__ __forceinline__ unsigned cvt_pk_bf16(float lo, float hi) { const f32x2_t v = {lo, hi}; const bf16x2_t b = __builtin_convertvector(v, bf16x2_t); return __builtin_bit_cast(unsigned, b); }
__device__ __forceinline__ float ex2(float x) { return __builtin_amdgcn_exp2f(x); }
__device__ __forceinline__ float fexp(float x) { return __builtin_amdgcn_exp2f(x * LOG2E); }
__device__ __forceinline__ float frcp(float x) { return __builtin_amdgcn_rcpf(x); }
__device__ __forceinline__ float silu(float x) { return x * frcp(1.f + fexp(-x)); }
__device__ __forceinline__ float sigm(float x) { return frcp(1.f + fexp(-x)); }
__device__ __forceinline__ float logsigmoid(float x) { return fminf(x, 0.f) - log1pf(expf(-fabsf(x))); }
__device__ __forceinline__ int crow(int reg, int h) { return (reg & 3) + 8 * (reg >> 2) + 4 * h; }
__device__ __forceinline__ float shx(float v, int mask, int lane) { return __int_as_float(__builtin_amdgcn_ds_bpermute((lane ^ mask) << 2, __float_as_int(v))); }
__device__ __forceinline__ float shi(float v, int src) { return __int_as_float(__builtin_amdgcn_ds_bpermute(src << 2, __float_as_int(v))); }
__device__ __forceinline__ float wave_sum(float v, int lane) {
#pragma unroll
    for (int o = 1; o < 64; o <<= 1) v += shx(v, o, lane);
    return v;
}
__device__ __forceinline__ float wave_max(float v, int lane) {
#pragma unroll
    for (int o = 1; o < 64; o <<= 1) v = fmaxf(v, shx(v, o, lane));
    return v;
}
__device__ __forceinline__ float scan_sum_up(float v, int lane) {
#pragma unroll
    for (int o = 1; o < 64; o <<= 1) { const float t = shi(v, lane - o); if (lane >= o) v += t; }
    return v;
}
__device__ __forceinline__ float scan_sum_down(float v, int lane) {
#pragma unroll
    for (int o = 1; o < 64; o <<= 1) { const float t = shi(v, lane + o); if (lane + o < 64) v += t; }
    return v;
}
__device__ __forceinline__ float scan_max_up(float v, int lane) {
#pragma unroll
    for (int o = 1; o < 64; o <<= 1) { const float t = shi(v, lane - o); if (lane >= o) v = fmaxf(v, t); }
    return v;
}
__device__ __forceinline__ float scan_max_down(float v, int lane) {
#pragma unroll
    for (int o = 1; o < 64; o <<= 1) { const float t = shi(v, lane + o); if (lane + o < 64) v = fmaxf(v, t); }
    return v;
}
__device__ __forceinline__ int t5_bucket(int rel) {
    const int n = rel < 0 ? -rel : rel; const int ret = rel > 0 ? 16 : 0;
    const int large = 8 + (n >= 12) + (n >= 16) + (n >= 23) + (n >= 32) + (n >= 46) + (n >= 64) + (n >= 91);
    return ret + (n < 8 ? n : large);
}
#define PIN16(a) asm volatile("" : "+v"(a[0]), "+v"(a[1]), "+v"(a[2]), "+v"(a[3]), "+v"(a[4]), "+v"(a[5]), "+v"(a[6]), "+v"(a[7]), "+v"(a[8]), "+v"(a[9]), "+v"(a[10]), "+v"(a[11]), "+v"(a[12]), "+v"(a[13]), "+v"(a[14]), "+v"(a[15]))
#define MFMA32(a, b, c) __builtin_amdgcn_mfma_f32_32x32x16_bf16((a), (b), (c), 0, 0, 0)
__device__ __forceinline__ bf16x8 pack8(const f32x16& x, int s) {
    u32x4 p; p.x = cvt_pk_bf16(x[8 * s], x[8 * s + 1]); p.y = cvt_pk_bf16(x[8 * s + 2], x[8 * s + 3]); p.z = cvt_pk_bf16(x[8 * s + 4], x[8 * s + 5]); p.w = cvt_pk_bf16(x[8 * s + 6], x[8 * s + 7]);
    return __builtin_bit_cast(bf16x8, p);
}
__device__ __forceinline__ f32x16 zero16() { f32x16 z;
#pragma unroll
    for (int i = 0; i < 16; ++i) z[i] = 0.f; return z; }

template <int RPR> __device__ __forceinline__ size_t fm_off(int tok, int base, int col) { const int rho = col >> 3; return (size_t)((tok & ~31) + rho / RPR) * 6144 + base + (rho % RPR) * 256 + (tok & 31) * 8; }
__device__ __forceinline__ size_t bqk_off(int tok, int col) { return fm_off<4>(tok, 1792, col); }
namespace pg8 {
constexpr int BM = 256, BK = 64, HALF = 128, HTB = HALF * BK * 2, STAGE_BYTES = 8 * HTB, NXCD = 8, WGM = 4;
__device__ __forceinline__ int lds_byte(int r, int c) { const int st = (r >> 4) * 2 + (c >> 5), rr = r & 15, cc = c & 31, ob = rr * 64 + cc * 2; return st * 1024 + (ob ^ (((ob >> 9) & 1) << 5)); }
__device__ __forceinline__ void stage_rc(int b, int& R, int& C) { const int st = b / 1024, sb = b % 1024, swz = sb ^ (((sb >> 9) & 1) << 5); R = (st >> 1) * 16 + swz / 64; C = (st & 1) * 32 + (swz % 64) / 2; }
__device__ __forceinline__ int perm32(int rho) { const int n = rho >> 4, i = rho & 15; return 8 * (i >> 2) + 4 * n + (i & 3); }

struct Unit { const char* a; const char* b; int pm, pn, kind; };

__device__ __forceinline__ bool tile_of(int i, int G, int c, int nM, int nN, int& pm, int& pn) {
    const int nwg = nM * nN; const long L = (long)i * G + c; if (L >= nwg) return false;
    int wgid = (int)L; { const int q = nwg / NXCD, r = nwg % NXCD, xcd = wgid % NXCD, off = wgid / NXCD; wgid = (xcd < r ? xcd * (q + 1) : r * (q + 1) + (xcd - r) * q) + off; }
    const int nig = WGM * nN, gid = wgid / nig, fm = gid * WGM, gsz = (nM - fm) < WGM ? (nM - fm) : WGM;
    pm = fm + ((wgid % nig) % gsz); pn = (wgid % nig) / gsz; return true;
}
constexpr size_t TSTEP = (size_t)256 * 2048 * 2;
struct Sched1 {
    const char* X; const char* W; int G, c;
    __device__ __forceinline__ bool next(int i, Unit& u) const {
        int pm, pn;
        if (G == 256) {
            if (i >= 8) return false;
            const int x = c & 7, k = c >> 3, j = i;
            if (i == 7) { if (c >= 128) return false; pm = 8 * x + (k & 7); pn = 28 + (k >> 3); }
            else if (j < 4) { pm = 16 * j + 4 * (x & 3) + (k & 3); pn = 8 * (x >> 2) + (k >> 2); }
            else if (j < 6) { pm = 32 * (j - 4) + 8 * (x & 3) + (k & 7); pn = 16 + 4 * (x >> 2) + (k >> 3); }
            else { pm = 8 * x + (k & 7); pn = 24 + (k >> 3); }
            if (pn >= 25) pn += 2;
        } else if (!tile_of(i, G, c, 64, 32, pm, pn)) return false;
        u.pm = pm; u.pn = pn;
        if (pn < 24) { u.kind = 0; u.a = X + (size_t)pm * TSTEP; u.b = W + (size_t)pn * TSTEP; }
        else { u.kind = 1; u.a = W + (size_t)pn * TSTEP; u.b = X + (size_t)pm * TSTEP; }
        return true;
    }
};
struct Sched2 {
    const char* Y; const char* W; int G, c;
    __device__ __forceinline__ bool next(int i, Unit& u) const {
        int pm, pn; if (!tile_of(i, G, c, 64, 8, pm, pn)) return false;
        u.pm = pm; u.pn = pn; u.kind = 2; u.a = Y + (size_t)pm * TSTEP; u.b = W + (size_t)pn * TSTEP; return true;
    }
};

struct Epi1 {
    static constexpr bool PERM = true;
    bf16* Unat; bf16* Ut; const float* bias;
    __device__ __forceinline__ void operator()(const f32x4 (&acc)[2][2][4][2], const Unit& u, int wr, int wc, int fr, int fq) const {
        if (u.kind == 0) {
            const bool fmaj = u.pn != 3 && !(u.pn >= 18 && u.pn <= 20);
            int fbase, frpr;
            if (u.pn < 3) { fbase = N_AQ; frpr = 3; } else if (u.pn < 7) { fbase = N_AZ; frpr = 3; } else if (u.pn < 11) { fbase = N_BQ; frpr = 4; } else if (u.pn < 13) { fbase = N_BO; frpr = 2; }
            else if (u.pn < 15) { fbase = N_BZ; frpr = 2; } else if (u.pn < 18) { fbase = N_CQ; frpr = 3; } else { fbase = N_CZ; frpr = 3; }
            const int row0 = u.pm * BM + wr * 64 + fr, col0 = u.pn * BM + wc * 32 + 8 * fq;
            f32x4 bv[2][2];
#pragma unroll
            for (int bj = 0; bj < 2; ++bj)
#pragma unroll
                for (int n = 0; n < 2; ++n) bv[bj][n] = *(const f32x4*)(bias + col0 + bj * HALF + 4 * n);
#pragma unroll
            for (int ai = 0; ai < 2; ++ai)
#pragma unroll
                for (int m = 0; m < 4; ++m) { const int row = row0 + ai * HALF + m * 16; bf16* rowp = Unat + (size_t)row * LDN + col0;
#pragma unroll
                    for (int bj = 0; bj < 2; ++bj) { const f32x4 v0 = acc[ai][bj][m][0] + bv[bj][0], v1 = acc[ai][bj][m][1] + bv[bj][1];
                        u32x4 w; w.x = cvt_pk_bf16(v0[0], v0[1]); w.y = cvt_pk_bf16(v0[2], v0[3]); w.z = cvt_pk_bf16(v1[0], v1[1]); w.w = cvt_pk_bf16(v1[2], v1[3]);
                        const int fc = col0 + bj * HALF - fbase;
                        bf16* dst = !fmaj ? rowp + bj * HALF : Unat + (frpr == 3 ? fm_off<3>(row, fbase, fc) : frpr == 4 ? fm_off<4>(row, fbase, fc) : fm_off<2>(row, fbase, fc));
                        *(u32x4*)dst = w; } }
        } else {
            const int nrow0 = (u.pn - 24) * BM + wr * 64 + fr, tok0 = u.pm * BM + wc * 32 + 8 * fq;
#pragma unroll
            for (int ai = 0; ai < 2; ++ai)
#pragma unroll
                for (int m = 0; m < 4; ++m) { const int nr = nrow0 + ai * HALF + m * 16; const float bs = bias[6144 + nr]; bf16* rowp = Ut + (size_t)nr * M + tok0;
#pragma unroll
                    for (int bj = 0; bj < 2; ++bj) { const f32x4 v0 = acc[ai][bj][m][0] + bs, v1 = acc[ai][bj][m][1] + bs;
                        u32x4 w; w.x = cvt_pk_bf16(v0[0], v0[1]); w.y = cvt_pk_bf16(v0[2], v0[3]); w.z = cvt_pk_bf16(v1[0], v1[1]); w.w = cvt_pk_bf16(v1[2], v1[3]);
                        *(u32x4*)(rowp + bj * HALF) = w; } }
        }
    }
};
template <int L> struct Epi2 {
    static constexpr bool PERM = true;
    float* Tf; bf16* Tb; const float* bias; const float* srcf; const bf16* srcb; const float* stat; const float* gam; const float* bet; bf16* Tb_hi;
    __device__ __forceinline__ void operator()(const f32x4 (&acc)[2][2][4][2], const Unit& u, int wr, int wc, int fr, int fq) const {
        const int row0 = u.pm * BM + wr * 64 + fr, col0 = u.pn * BM + wc * 32 + 8 * fq;
        bf16* const Tbu = (Tb_hi && u.pm >= 32) ? Tb_hi - (size_t)8192 * DM : Tb;
        float mean[2][4], rs[2][4];
#pragma unroll
        for (int ai = 0; ai < 2; ++ai)
#pragma unroll
            for (int m = 0; m < 4; ++m) { mean[ai][m] = 0.f; rs[ai][m] = 0.f; }
#pragma unroll
        for (int bj = 0; bj < 2; ++bj) { const int c = col0 + bj * HALF;
            f32x4 g0 = {0.f, 0.f, 0.f, 0.f}, g1 = g0, b0 = *(const f32x4*)(bias + c), b1 = *(const f32x4*)(bias + c + 4);
#pragma unroll
            for (int ai = 0; ai < 2; ++ai)
#pragma unroll
                for (int m = 0; m < 4; ++m) { const size_t off = (size_t)(row0 + ai * HALF + m * 16) * DM + c;
                    f32x4 t0, t1;
                    if (L == 0) { const u32x4 hv = *(const u32x4*)(srcb + off);
                        const f32x4 o0 = {bflo(hv.x), bfhi(hv.x), bflo(hv.y), bfhi(hv.y)}, o1 = {bflo(hv.z), bfhi(hv.z), bflo(hv.w), bfhi(hv.w)};
                        t0 = o0 * ALPHA + b0 + acc[ai][bj][m][0]; t1 = o1 * ALPHA + b1 + acc[ai][bj][m][1]; }
                    else { t0 = acc[ai][bj][m][0] + b0; t1 = acc[ai][bj][m][1] + b1; }
                    u32x4 w; w.x = cvt_pk_bf16(t0[0], t0[1]); w.y = cvt_pk_bf16(t0[2], t0[3]); w.z = cvt_pk_bf16(t1[0], t1[1]); w.w = cvt_pk_bf16(t1[2], t1[3]); *(u32x4*)(Tbu + off) = w; } }
    }
};

template <class Epi, class Sched, bool ALIGN_EPI, bool SP2>
__device__ __forceinline__ void gemm_phase(LAS unsigned char* lds, const Sched& S, const Epi& E, const int tid) {
    const int wid = __builtin_amdgcn_readfirstlane(tid >> 6), lane = tid & 63, wr = wid >> 2, wc = wid & 3, fr = lane & 15, fq = lane >> 4;
    constexpr int K = 2048, nt = K / BK;
    unsigned voffA[2], voffB[2];
#pragma unroll
    for (int i = 0; i < 2; ++i) { int R, C; stage_rc(tid * 16 + i * 8192, R, C); const int Rb = Epi::PERM ? ((R & ~31) + perm32(R & 31)) : R;
        voffA[i] = (unsigned)(R * K + C) * 2u; voffB[i] = (unsigned)(Rb * K + C) * 2u; }
    const size_t kstep = (size_t)(BK * 2);
    const size_t hstep = (size_t)HALF * K * 2;
    const unsigned ldsw = (unsigned)wid * 1024u;
    const int aoff = lds_byte(wr * 64 + fr, fq * 8), boff = lds_byte(wc * 32 + fr, fq * 8);
#define PG8_SA(b, h) (((b) * 2 + (h)) * HTB)
#define PG8_SB(b, h) ((4 + (b) * 2 + (h)) * HTB)
#define PG8_STAGE(bufoff, gbase, voff) do { _Pragma("unroll") for (int _i = 0; _i < 2; ++_i) \
        __builtin_amdgcn_global_load_lds((const unsigned*)((const char*)(gbase) + (voff)[_i]), (LAS unsigned*)(lds + (bufoff) + ldsw + _i * 8192), 16, 0, 0); } while (0)
#define PG8_LDA(dst, b, h) do { _Pragma("unroll") for (int m = 0; m < 4; ++m) _Pragma("unroll") for (int k = 0; k < 2; ++k) dst[m][k] = *(const LAS bf16x8*)(lds + PG8_SA(b, h) + aoff + m * 2048 + k * 1024); } while (0)
#define PG8_LDB(dst, b, h) do { _Pragma("unroll") for (int n = 0; n < 2; ++n) _Pragma("unroll") for (int k = 0; k < 2; ++k) dst[n][k] = *(const LAS bf16x8*)(lds + PG8_SB(b, h) + boff + n * 2048 + k * 1024); } while (0)
#define PG8_MMA(ai, bj, At, Bt) do { __builtin_amdgcn_s_setprio(1); _Pragma("unroll") for (int m = 0; m < 4; ++m) _Pragma("unroll") for (int n = 0; n < 2; ++n) _Pragma("unroll") for (int k = 0; k < 2; ++k) \
        acc[ai][bj][m][n] = __builtin_amdgcn_mfma_f32_16x16x32_bf16(Bt[n][k], At[m][k], acc[ai][bj][m][n], 0, 0, 0); __builtin_amdgcn_s_setprio(0); } while (0)
#define PG8_WAIT_V(n) asm volatile("s_waitcnt vmcnt(" #n ")" ::: "memory")
#define PG8_WAIT_L(n) asm volatile("s_waitcnt lgkmcnt(" #n ")" ::: "memory")
#define PG8_BAR __builtin_amdgcn_s_barrier()
#define PG8_SCHED __builtin_amdgcn_sched_barrier(0)
    Unit cur, nxt; int ui = 0;
    if (!S.next(0, cur)) return;
    f32x4 acc[2][2][4][2];
#pragma unroll
    for (int a = 0; a < 2; ++a)
#pragma unroll
        for (int b = 0; b < 2; ++b)
#pragma unroll
            for (int m = 0; m < 4; ++m)
#pragma unroll
                for (int n = 0; n < 2; ++n) acc[a][b][m][n] = (f32x4){0.f, 0.f, 0.f, 0.f};
    bf16x8 At[4][2], B0[2][2], B1[2][2];
    const char* cA = cur.a; const char* cB = cur.b;
    if constexpr (SP2) {
        PG8_STAGE(PG8_SB(0, 0), cB, voffB); PG8_STAGE(PG8_SB(0, 1), cB + hstep, voffB); PG8_STAGE(PG8_SA(0, 0), cA, voffA); PG8_STAGE(PG8_SA(0, 1), cA + hstep, voffA);
        if (wr == 1) PG8_BAR;
        PG8_WAIT_V(2); PG8_BAR;
        PG8_STAGE(PG8_SB(1, 0), cB + kstep, voffB); PG8_STAGE(PG8_SA(1, 0), cA + kstep, voffA); PG8_STAGE(PG8_SB(1, 1), cB + hstep + kstep, voffB);
        PG8_WAIT_V(6); PG8_BAR;
    } else {
        PG8_STAGE(PG8_SB(0, 0), cB, voffB); PG8_STAGE(PG8_SA(0, 0), cA, voffA); PG8_STAGE(PG8_SB(0, 1), cB + hstep, voffB); PG8_STAGE(PG8_SA(0, 1), cA + hstep, voffA);
        if (wr == 1) PG8_BAR;
        PG8_WAIT_V(4); PG8_BAR;
        PG8_STAGE(PG8_SB(1, 0), cB + kstep, voffB); PG8_STAGE(PG8_SA(1, 0), cA + kstep, voffA); PG8_STAGE(PG8_SB(1, 1), cB + hstep + kstep, voffB);
        PG8_WAIT_V(6); PG8_BAR;
    }
    for (;;) {
        const bool has_next = S.next(ui + 1, nxt);
        const char* nA = has_next ? nxt.a : cA; const char* nB = has_next ? nxt.b : cB;
        for (int t = 0; t < nt; t += 2) {
            const bool last = (t == nt - 2);
            const char* a1 = cA + (size_t)(t + 1) * kstep;
            const char* a2 = last ? nA : cA + (size_t)(t + 2) * kstep; const char* b2 = last ? nB : cB + (size_t)(t + 2) * kstep;
            const char* a3 = a2 + kstep; const char* b3 = b2 + kstep;
            if constexpr (SP2) {
            PG8_LDB(B0, 0, 0); PG8_LDB(B1, 0, 1); PG8_SCHED; PG8_LDA(At, 0, 0); PG8_STAGE(PG8_SA(1, 1), a1 + hstep, voffA);
            PG8_WAIT_V(8); PG8_WAIT_L(0); PG8_BAR; PG8_MMA(0, 0, At, B0); PG8_MMA(0, 1, At, B1); PG8_BAR; PG8_SCHED;
            PG8_LDA(At, 0, 1); PG8_STAGE(PG8_SB(0, 0), b2, voffB); PG8_STAGE(PG8_SB(0, 1), b2 + hstep, voffB); PG8_STAGE(PG8_SA(0, 0), a2, voffA);
            PG8_WAIT_V(8); PG8_WAIT_L(0); PG8_BAR; PG8_MMA(1, 0, At, B0); PG8_MMA(1, 1, At, B1); PG8_BAR; PG8_SCHED;
            PG8_LDB(B0, 1, 0); PG8_LDB(B1, 1, 1); PG8_SCHED; PG8_LDA(At, 1, 0); PG8_STAGE(PG8_SA(0, 1), a2 + hstep, voffA);
            PG8_WAIT_V(8); PG8_WAIT_L(0); PG8_BAR; PG8_MMA(0, 0, At, B0); PG8_MMA(0, 1, At, B1); PG8_BAR; PG8_SCHED;
            PG8_LDA(At, 1, 1); PG8_STAGE(PG8_SB(1, 0), b3, voffB); PG8_STAGE(PG8_SB(1, 1), b3 + hstep, voffB); PG8_STAGE(PG8_SA(1, 0), a3, voffA);
            PG8_WAIT_V(8); PG8_WAIT_L(0); PG8_BAR; PG8_MMA(1, 0, At, B0); PG8_MMA(1, 1, At, B1); PG8_BAR; PG8_SCHED;
            } else {
            PG8_LDB(B0, 0, 0); PG8_SCHED; PG8_LDA(At, 0, 0); PG8_STAGE(PG8_SA(1, 1), a1 + hstep, voffA);
            PG8_WAIT_L(8); PG8_BAR; PG8_WAIT_L(0); PG8_MMA(0, 0, At, B0); PG8_BAR; PG8_SCHED;
            PG8_LDB(B1, 0, 1); PG8_STAGE(PG8_SB(0, 0), b2, voffB);
            PG8_BAR; PG8_WAIT_L(0); PG8_MMA(0, 1, At, B1); PG8_BAR;
            PG8_LDA(At, 0, 1); PG8_STAGE(PG8_SA(0, 0), a2, voffA);
            PG8_BAR; PG8_WAIT_L(0); PG8_MMA(1, 0, At, B0); PG8_BAR; PG8_SCHED;
            PG8_STAGE(PG8_SB(0, 1), b2 + hstep, voffB);
            PG8_WAIT_V(6); PG8_BAR; PG8_MMA(1, 1, At, B1); PG8_BAR;
            PG8_LDB(B0, 1, 0); PG8_SCHED; PG8_LDA(At, 1, 0); PG8_STAGE(PG8_SA(0, 1), a2 + hstep, voffA);
            PG8_WAIT_L(8); PG8_BAR; PG8_WAIT_L(0); PG8_MMA(0, 0, At, B0); PG8_BAR; PG8_SCHED;
            PG8_LDB(B1, 1, 1); PG8_STAGE(PG8_SB(1, 0), b3, voffB);
            PG8_BAR; PG8_WAIT_L(0); PG8_MMA(0, 1, At, B1); PG8_BAR;
            PG8_LDA(At, 1, 1); PG8_STAGE(PG8_SA(1, 0), a3, voffA);
            PG8_BAR; PG8_WAIT_L(0); PG8_MMA(1, 0, At, B0); PG8_BAR; PG8_SCHED;
            PG8_STAGE(PG8_SB(1, 1), b3 + hstep, voffB);
            PG8_WAIT_V(6); PG8_BAR; PG8_MMA(1, 1, At, B1); PG8_BAR;
            }
        }
        if constexpr (ALIGN_EPI) { if (wr == 0) PG8_BAR; }
        int fr_ = fr, fq_ = fq; asm volatile("" : "+v"(fr_), "+v"(fq_));
        E(acc, cur, wr, wc, fr_, fq_);
        if (!has_next) break;
#pragma unroll
        for (int a = 0; a < 2; ++a)
#pragma unroll
            for (int b = 0; b < 2; ++b)
#pragma unroll
                for (int m = 0; m < 4; ++m)
#pragma unroll
                    for (int n = 0; n < 2; ++n) acc[a][b][m][n] = (f32x4){0.f, 0.f, 0.f, 0.f};
        cur = nxt; cA = nA; cB = nB; ++ui;
        if constexpr (ALIGN_EPI) { if (wr == 1) PG8_BAR; }
    }
    PG8_WAIT_V(0);
    if constexpr (!ALIGN_EPI) { if (wr == 0) PG8_BAR; }
    PG8_BAR;
#undef PG8_SA
#undef PG8_SB
#undef PG8_STAGE
#undef PG8_LDA
#undef PG8_LDB
#undef PG8_MMA
#undef PG8_WAIT_V
#undef PG8_WAIT_L
#undef PG8_BAR
#undef PG8_SCHED
}
}

#define XB_TMO      128
#define XB_XCNT(j)  (256  + 64 * (j))
#define XB_XSUB(j)  (1280 + 64 * (j))
#define XB_XGEN(j)  (2304 + 64 * (j))
#define XB_TOP      3328
#define XB_TOPGEN   3392
#define XCD_BAR_WORDS 3456
#define XB_SPIN_CAP (1u << 22)
__device__ __forceinline__ unsigned xb_ld(unsigned* p)              { return __hip_atomic_load(p, __ATOMIC_RELAXED, __HIP_MEMORY_SCOPE_AGENT); }
__device__ __forceinline__ unsigned xb_add(unsigned* p, unsigned v) { return __hip_atomic_fetch_add(p, v, __ATOMIC_RELAXED, __HIP_MEMORY_SCOPE_AGENT); }
__device__ __forceinline__ unsigned xb_xcc_id() { return (unsigned)__builtin_amdgcn_s_getreg((3 << 11) | 20) & 0xFu; }
#define XB_SPIN(cond, bar) do { unsigned _sp = 0; while (cond) { __builtin_amdgcn_s_sleep(1); \
    if ((++_sp & 255u) == 0u) { if (xb_ld(&(bar)[XB_TMO])) break; if (_sp > XB_SPIN_CAP) { atomicAdd(&(bar)[XB_TMO], 1u); break; } } } } while (0)
struct XcdBarrier { unsigned* bar; unsigned x; volatile LAS unsigned* st; };
__device__ __forceinline__ XcdBarrier xcd_barrier_post(unsigned* bar, volatile LAS unsigned* st, int tid) {
    XcdBarrier b; b.bar = bar; b.x = xb_xcc_id(); b.st = st;
    if (tid == 0) (void)xb_add(&bar[XB_XCNT(b.x)], 1u);
    return b;
}
__device__ __forceinline__ void xcd_barrier_complete(unsigned* bar, unsigned x, unsigned& nloc, unsigned& nx) {
    const unsigned G = gridDim.x * gridDim.y * gridDim.z;
    unsigned sum, cnt, mine, sp = 0u;
    for (;;) {
        sum = 0u; cnt = 0u; mine = 0u;
#pragma unroll
        for (unsigned j = 0; j < 16; ++j) { const unsigned c = xb_ld(&bar[XB_XCNT(j)]); sum += c; cnt += (c > 0u) ? 1u : 0u; mine = (j == x) ? c : mine; }
        if (sum == G) break;
        __builtin_amdgcn_s_sleep(1);
        if ((++sp & 255u) == 0u) { if (xb_ld(&bar[XB_TMO])) break; if (sp > XB_SPIN_CAP) { atomicAdd(&bar[XB_TMO], 1u); break; } }
    }
    nloc = mine > 0u ? mine : 1u; nx = cnt > 0u ? cnt : 1u;
}
__device__ __forceinline__ void xcd_barrier(const XcdBarrier& b, int tid) {
    asm volatile("s_waitcnt vmcnt(0)" ::: "memory");
    __syncthreads();
    if (tid == 0) {
        unsigned* bar = b.bar; asm volatile("" : "+s"(bar));
        __builtin_amdgcn_s_waitcnt(0);
        unsigned nloc = b.st[0], nx = b.st[1];
        if (nloc == 0u) { xcd_barrier_complete(bar, b.x, nloc, nx); b.st[0] = nloc; b.st[1] = nx; }
        const unsigned old = xb_add(&bar[XB_XSUB(b.x)], 1u);
        const unsigned gen = old / nloc;
        if (old + 1u == (gen + 1u) * nloc) {
            __builtin_amdgcn_fence(__ATOMIC_RELEASE, "agent");
            asm volatile("s_waitcnt vmcnt(0)" ::: "memory");
            const unsigned og = xb_add(&bar[XB_TOP], 1u);
            const unsigned tg = og / nx;
            if (og + 1u == (tg + 1u) * nx) xb_add(&bar[XB_TOPGEN], 1u);
            else XB_SPIN(xb_ld(&bar[XB_TOPGEN]) == tg, bar);
            __builtin_amdgcn_fence(__ATOMIC_ACQUIRE, "agent");
            xb_add(&bar[XB_XGEN(b.x)], 1u);
            asm volatile("s_waitcnt vmcnt(0)" ::: "memory");
        } else {
            XB_SPIN(xb_ld(&bar[XB_XGEN(b.x)]) == gen, bar);
            __builtin_amdgcn_fence(__ATOMIC_ACQUIRE, "agent");
            asm volatile("s_waitcnt vmcnt(0)" ::: "memory");
        }
    }
    __syncthreads();
}

struct Args { const float* in[14]; float* out; unsigned char* ws; int ph_lo, ph_hi; };

struct Ctx {
    LAS unsigned char* lds; int tid, lane, wave, G, bid;
    const float *x, *emb_g, *emb_b, *w_in, *b_in, *w_out, *b_out, *ln_g, *ln_b, *t5, *sink, *fbias, *norm_g, *rpb;
    float* out; unsigned char* ws;
    bf16* hby; bf16* yb; bf16* unat; bf16* ut; bf16* cst; float* nst; float* gs; float* ml; float* mprev; float* gate; float* stat;
};

__device__ __forceinline__ int src_col_of_row(int r) {
    if (r < 768) return r;
    if (r < 1024) return r - 768 + 768;
    if (r < 1792) return r - 1024 + 1280;
    if (r < 2304) return r - 1792 + 2048;
    if (r < 2816) return r - 2304 + 2560;
    if (r < 3328) return r - 2816 + 3584;
    if (r < 3840) return r - 3328 + 4096;
    if (r < 4608) return r - 3840 + 4624;
    if (r < 5376) return r - 4608 + 5392;
    if (r < 6144) return r - 5376 + 6928;
    if (r < 6400) return r - 6144 + 1024;
    if (r < 6912) return r - 6400 + 2560;
    if (r < 7424) return r - 6912 + 3072;
    if (r < 8192) return r - 7424 + 6160;
    return r - 8192 + 4608;
}
__device__ __forceinline__ void ln_row(const float* xrow, float* orow, bf16* brow, float* stat, const float* g, const float* b, int lane) {
    f32x4 v[8]; float s = 0.f;
#pragma unroll
    for (int j = 0; j < 8; ++j) { v[j] = *(const f32x4*)(xrow + 4 * (lane + 64 * j)); s += (v[j][0] + v[j][1]) + (v[j][2] + v[j][3]); }
    const float mean = wave_sum(s, lane) * (1.f / DM); float q = 0.f;
#pragma unroll
    for (int j = 0; j < 8; ++j) { v[j] = v[j] - mean; q += (v[j][0] * v[j][0] + v[j][1] * v[j][1]) + (v[j][2] * v[j][2] + v[j][3] * v[j][3]); }
    const float rstd = 1.f / sqrtf(wave_sum(q, lane) * (1.f / DM) + LN_EPS);
    if (stat && lane == 0) { stat[0] = mean; stat[1] = rstd; }
#pragma unroll
    for (int j = 0; j < 8; ++j) { const int c = 4 * (lane + 64 * j); const f32x4 gg = *(const f32x4*)(g + c), bb = *(const f32x4*)(b + c);
        const f32x4 o = v[j] * rstd * gg + bb;
        if (orow) *(f32x4*)(orow + c) = o;
        if (brow) { u32x2 w; w.x = cvt_pk_bf16(o[0], o[1]); w.y = cvt_pk_bf16(o[2], o[3]); *(u32x2*)(brow + c) = w; } }
}

__device__ __forceinline__ void ln_row2(const float* x0, const float* x1, float* o0, float* o1, bf16* b0, bf16* b1, float* st0, float* st1, const float* g, const float* b, int lane) {
    f32x4 v[8], u[8]; float s = 0.f, s_ = 0.f;
#pragma unroll
    for (int j = 0; j < 8; ++j) { v[j] = *(const f32x4*)(x0 + 4 * (lane + 64 * j)); u[j] = *(const f32x4*)(x1 + 4 * (lane + 64 * j)); }
#pragma unroll
    for (int j = 0; j < 8; ++j) { s += (v[j][0] + v[j][1]) + (v[j][2] + v[j][3]); s_ += (u[j][0] + u[j][1]) + (u[j][2] + u[j][3]); }
#pragma unroll
    for (int o = 1; o < 64; o <<= 1) { s += shx(s, o, lane); s_ += shx(s_, o, lane); }
    const float mean = s * (1.f / DM), mean_ = s_ * (1.f / DM); float q = 0.f, q_ = 0.f;
#pragma unroll
    for (int j = 0; j < 8; ++j) { v[j] = v[j] - mean; u[j] = u[j] - mean_; q += (v[j][0] * v[j][0] + v[j][1] * v[j][1]) + (v[j][2] * v[j][2] + v[j][3] * v[j][3]); q_ += (u[j][0] * u[j][0] + u[j][1] * u[j][1]) + (u[j][2] * u[j][2] + u[j][3] * u[j][3]); }
#pragma unroll
    for (int o = 1; o < 64; o <<= 1) { q += shx(q, o, lane); q_ += shx(q_, o, lane); }
    const float rstd = 1.f / sqrtf(q * (1.f / DM) + LN_EPS), rstd_ = 1.f / sqrtf(q_ * (1.f / DM) + LN_EPS);
    if (st0 && lane == 0) { st0[0] = mean; st0[1] = rstd; st1[0] = mean_; st1[1] = rstd_; }
#pragma unroll
    for (int j = 0; j < 8; ++j) { const int c = 4 * (lane + 64 * j); const f32x4 gg = *(const f32x4*)(g + c), bb = *(const f32x4*)(b + c);
        const f32x4 o = v[j] * rstd * gg + bb, p = u[j] * rstd_ * gg + bb;
        if (o0) { *(f32x4*)(o0 + c) = o; *(f32x4*)(o1 + c) = p; }
        if (b0) { u32x2 w; w.x = cvt_pk_bf16(o[0], o[1]); w.y = cvt_pk_bf16(o[2], o[3]); *(u32x2*)(b0 + c) = w; u32x2 w2; w2.x = cvt_pk_bf16(p[0], p[1]); w2.y = cvt_pk_bf16(p[2], p[3]); *(u32x2*)(b1 + c) = w2; } }
}

__device__ __forceinline__ void ln_row2_b(const bf16* x0, const bf16* x1, bf16* b0, bf16* b1, float* st0, float* st1, const float* g, const float* b, int lane) {
    f32x4 v[8], u[8]; float s = 0.f, s_ = 0.f;
#pragma unroll
    for (int j = 0; j < 4; ++j) { const u32x4 p = *(const u32x4*)(x0 + 8 * (lane + 64 * j)), q = *(const u32x4*)(x1 + 8 * (lane + 64 * j));
        v[2 * j] = (f32x4){bflo(p.x), bfhi(p.x), bflo(p.y), bfhi(p.y)}; v[2 * j + 1] = (f32x4){bflo(p.z), bfhi(p.z), bflo(p.w), bfhi(p.w)};
        u[2 * j] = (f32x4){bflo(q.x), bfhi(q.x), bflo(q.y), bfhi(q.y)}; u[2 * j + 1] = (f32x4){bflo(q.z), bfhi(q.z), bflo(q.w), bfhi(q.w)}; }
#pragma unroll
    for (int j = 0; j < 8; ++j) { s += (v[j][0] + v[j][1]) + (v[j][2] + v[j][3]); s_ += (u[j][0] + u[j][1]) + (u[j][2] + u[j][3]); }
#pragma unroll
    for (int o = 1; o < 64; o <<= 1) { s += shx(s, o, lane); s_ += shx(s_, o, lane); }
    const float mean = s * (1.f / DM), mean_ = s_ * (1.f / DM); float q = 0.f, q_ = 0.f;
#pragma unroll
    for (int j = 0; j < 8; ++j) { v[j] = v[j] - mean; u[j] = u[j] - mean_; q += (v[j][0] * v[j][0] + v[j][1] * v[j][1]) + (v[j][2] * v[j][2] + v[j][3] * v[j][3]); q_ += (u[j][0] * u[j][0] + u[j][1] * u[j][1]) + (u[j][2] * u[j][2] + u[j][3] * u[j][3]); }
#pragma unroll
    for (int o = 1; o < 64; o <<= 1) { q += shx(q, o, lane); q_ += shx(q_, o, lane); }
    const float rstd = 1.f / sqrtf(q * (1.f / DM) + LN_EPS), rstd_ = 1.f / sqrtf(q_ * (1.f / DM) + LN_EPS);
    if (lane == 0) { st0[0] = mean; st0[1] = rstd; st1[0] = mean_; st1[1] = rstd_; }
#pragma unroll
    for (int j = 0; j < 4; ++j) { const int c = 8 * (lane + 64 * j);
        const f32x4 g0 = *(const f32x4*)(g + c), g1 = *(const f32x4*)(g + c + 4), bb0 = *(const f32x4*)(b + c), bb1 = *(const f32x4*)(b + c + 4);
        const f32x4 o0 = v[2 * j] * rstd * g0 + bb0, o1 = v[2 * j + 1] * rstd * g1 + bb1, p0 = u[2 * j] * rstd_ * g0 + bb0, p1 = u[2 * j + 1] * rstd_ * g1 + bb1;
        u32x4 w; w.x = cvt_pk_bf16(o0[0], o0[1]); w.y = cvt_pk_bf16(o0[2], o0[3]); w.z = cvt_pk_bf16(o1[0], o1[1]); w.w = cvt_pk_bf16(o1[2], o1[3]); *(u32x4*)(b0 + c) = w;
        u32x4 w2; w2.x = cvt_pk_bf16(p0[0], p0[1]); w2.y = cvt_pk_bf16(p0[2], p0[3]); w2.z = cvt_pk_bf16(p1[0], p1[1]); w2.w = cvt_pk_bf16(p1[2], p1[3]); *(u32x4*)(b1 + c) = w2; }
}

__device__ __forceinline__ void fin_row2(const bf16* t1, const bf16* o2, const float* st, const float* g0, const float* b0, const float* g1, const float* b1, float* out, int lane) {
    f32x4 v[8], u[8]; float s = 0.f, s_ = 0.f;
    const float mA = st[0], rA = st[1] * ALPHA, mB = st[2], rB = st[3] * ALPHA;
#pragma unroll
    for (int j = 0; j < 4; ++j) { const int c = 8 * (lane + 64 * j);
        const u32x4 p = *(const u32x4*)(t1 + c), q = *(const u32x4*)(t1 + DM + c), x = *(const u32x4*)(o2 + c), y = *(const u32x4*)(o2 + DM + c);
        const f32x4 ga = *(const f32x4*)(g0 + c), gb = *(const f32x4*)(g0 + c + 4), ba = *(const f32x4*)(b0 + c) * ALPHA, bb = *(const f32x4*)(b0 + c + 4) * ALPHA;
        v[2 * j] = ((f32x4){bflo(p.x), bfhi(p.x), bflo(p.y), bfhi(p.y)} - mA) * rA * ga + ba + (f32x4){bflo(x.x), bfhi(x.x), bflo(x.y), bfhi(x.y)};
        v[2 * j + 1] = ((f32x4){bflo(p.z), bfhi(p.z), bflo(p.w), bfhi(p.w)} - mA) * rA * gb + bb + (f32x4){bflo(x.z), bfhi(x.z), bflo(x.w), bfhi(x.w)};
        u[2 * j] = ((f32x4){bflo(q.x), bfhi(q.x), bflo(q.y), bfhi(q.y)} - mB) * rB * ga + ba + (f32x4){bflo(y.x), bfhi(y.x), bflo(y.y), bfhi(y.y)};
        u[2 * j + 1] = ((f32x4){bflo(q.z), bfhi(q.z), bflo(q.w), bfhi(q.w)} - mB) * rB * gb + bb + (f32x4){bflo(y.z), bfhi(y.z), bflo(y.w), bfhi(y.w)}; }
#pragma unroll
    for (int j = 0; j < 8; ++j) { s += (v[j][0] + v[j][1]) + (v[j][2] + v[j][3]); s_ += (u[j][0] + u[j][1]) + (u[j][2] + u[j][3]); }
#pragma unroll
    for (int o = 1; o < 64; o <<= 1) { s += shx(s, o, lane); s_ += shx(s_, o, lane); }
    const float mean = s * (1.f / DM), mean_ = s_ * (1.f / DM); float q2 = 0.f, q2_ = 0.f;
#pragma unroll
    for (int j = 0; j < 8; ++j) { v[j] = v[j] - mean; u[j] = u[j] - mean_; q2 += (v[j][0] * v[j][0] + v[j][1] * v[j][1]) + (v[j][2] * v[j][2] + v[j][3] * v[j][3]); q2_ += (u[j][0] * u[j][0] + u[j][1] * u[j][1]) + (u[j][2] * u[j][2] + u[j][3] * u[j][3]); }
#pragma unroll
    for (int o = 1; o < 64; o <<= 1) { q2 += shx(q2, o, lane); q2_ += shx(q2_, o, lane); }
    const float rstd = 1.f / sqrtf(q2 * (1.f / DM) + LN_EPS), rstd_ = 1.f / sqrtf(q2_ * (1.f / DM) + LN_EPS);
#pragma unroll
    for (int j = 0; j < 4; ++j) { const int c = 8 * (lane + 64 * j);
        const f32x4 ga = *(const f32x4*)(g1 + c), gb = *(const f32x4*)(g1 + c + 4), ba = *(const f32x4*)(b1 + c), bb = *(const f32x4*)(b1 + c + 4);
        *(f32x4*)(out + c) = v[2 * j] * rstd * ga + ba; *(f32x4*)(out + c + 4) = v[2 * j + 1] * rstd * gb + bb;
        *(f32x4*)(out + DM + c) = u[2 * j] * rstd_ * ga + ba; *(f32x4*)(out + DM + c + 4) = u[2 * j + 1] * rstd_ * gb + bb; }
}

__device__ __forceinline__ bf16* t1_row(unsigned char* ws, int m) { return m < 8192 ? (bf16*)(ws + WS_WIN) + (size_t)m * DM : (bf16*)(ws + WS_T1B) + (size_t)(m - 8192) * DM; }
struct TrItem { const float* src; bf16* dst; int ldw, nvalid; };
__device__ __forceinline__ void tr_load(const TrItem& t, float (&wv)[32], int lane) {
#pragma unroll
    for (int i = 0; i < 8; ++i) { const int kk = 8 * i + (lane >> 3); const f32x4 v = *(const f32x4*)(t.src + (size_t)kk * t.ldw + 4 * (lane & 7));
        wv[4 * i] = v[0]; wv[4 * i + 1] = v[1]; wv[4 * i + 2] = v[2]; wv[4 * i + 3] = v[3]; }
}
__device__ __forceinline__ void tr_store(const TrItem& t, const float (&wv)[32], LAS float* scr, int lane) {
#pragma unroll
    for (int i = 0; i < 8; ++i) { const int kk = 8 * i + (lane >> 3); LAS float* d = scr + kk * 33 + 4 * (lane & 7); d[0] = wv[4 * i]; d[1] = wv[4 * i + 1]; d[2] = wv[4 * i + 2]; d[3] = wv[4 * i + 3]; }
    LDS_WAIT();
    const int c = lane & 7;
#pragma unroll
    for (int j = 0; j < 4; ++j) { const int n = (lane >> 3) + 8 * j; const LAS float* sp = scr + (8 * c) * 33 + n;
        u32x4 o; o.x = cvt_pk_bf16(sp[0 * 33], sp[1 * 33]); o.y = cvt_pk_bf16(sp[2 * 33], sp[3 * 33]); o.z = cvt_pk_bf16(sp[4 * 33], sp[5 * 33]); o.w = cvt_pk_bf16(sp[6 * 33], sp[7 * 33]);
        if (n < t.nvalid) *(u32x4*)(t.dst + (size_t)n * 2048 + 8 * c) = o; }
    LDS_WAIT();
}
__device__ __forceinline__ bool tr_item(const Ctx& F, int l, int it, TrItem& t) {
    constexpr int I_IN = 241 * 32, I_OUT = 64 * 32;
    if (it >= I_IN + I_OUT) return false;
    if (it < I_IN) { int rb = it >> 5; const int kb = it & 31; rb = rb < 200 ? rb : rb + 16;
        t.ldw = IN_W; t.nvalid = rb == 256 ? 16 : 32; t.src = F.w_in + (size_t)l * DM * IN_W + (size_t)(kb * 64) * IN_W + src_col_of_row(rb * 32);
        t.dst = (bf16*)(F.ws + WS_WIN + l * WIN_STRIDE) + (size_t)rb * 32 * 2048 + kb * 64; }
    else { const int r = it - I_IN, rb = r >> 5, kb = r & 31;
        t.ldw = DM; t.nvalid = 32; t.src = F.w_out + (size_t)l * DM * DM + (size_t)(kb * 64) * DM + rb * 32;
        t.dst = (bf16*)(F.ws + WS_WOUT + l * WOUT_STRIDE) + (size_t)rb * 32 * 2048 + kb * 64; }
    return true;
}
__device__ __forceinline__ void weights_job(Ctx& F, int l, int gw, int ngw) {
    LAS float* scr = (LAS float*)(F.lds + F.wave * 16384);
    TrItem ta, tb; float wa[32], wb[32];
    int it = gw; bool ha = tr_item(F, l, it, ta), hb;
    if (ha) tr_load(ta, wa, F.lane);
    while (ha) {
        it += ngw; hb = tr_item(F, l, it, tb); if (hb) tr_load(tb, wb, F.lane);
        tr_store(ta, wa, scr, F.lane);
        if (!hb) break;
        it += ngw; ha = tr_item(F, l, it, ta); if (ha) tr_load(ta, wa, F.lane);
        tr_store(tb, wb, scr, F.lane);
    }
}
__device__ __forceinline__ void helper_of(const Ctx& F, int l, bool& is_h, int& hid, int& nh) { (void)l; if (F.G == 256) { is_h = F.bid >= 128; hid = F.bid - 128; nh = 128; } else { is_h = true; hid = F.bid; nh = F.G; } }
__device__ __forceinline__ void phase_prologue(Ctx& F) {
    const int gw = F.bid * NWAVES + F.wave, NGW = F.G * NWAVES;
    weights_job(F, 0, gw, NGW);
    for (int i = F.bid * NTHR + F.tid; i < 2 * WROWS; i += F.G * NTHR) { const int l = i / WROWS, r = i % WROWS; ((float*)(F.ws + WS_BIAS))[i] = F.b_in[l * IN_W + src_col_of_row(r)]; }
    for (int m = 2 * gw; m < M; m += 2 * NGW) ln_row2(F.x + (size_t)m * DM, F.x + (size_t)(m + 1) * DM, (float*)nullptr, (float*)nullptr, F.hby + (size_t)m * DM, F.hby + (size_t)(m + 1) * DM, F.stat + (size_t)m * 2, F.stat + (size_t)(m + 1) * 2, F.emb_g, F.emb_b, F.lane);
}

__device__ __forceinline__ void gates_job(Ctx& F, int l) {
    const bf16* Wg = (const bf16*)(F.ws + WS_WIN + l * WIN_STRIDE) + (size_t)8192 * 2048;
    const float* bg = (const float*)(F.ws + WS_BIAS) + l * WROWS + 8192;
    LAS f32x4* red = (LAS f32x4*)F.lds;
    const int w = F.wave, fr = F.lane & 15, fq = F.lane >> 4;
    bool is_h; int hid, nh; helper_of(F, l, is_h, hid, nh); if (!is_h) return;
    for (int rb = hid; rb < M / 64; rb += nh) {
        const bf16* bp = Wg + (size_t)fr * 2048 + w * 256 + 8 * fq;
        f32x4 acc[4];
#pragma unroll
        for (int tt = 0; tt < 4; ++tt) acc[tt] = (f32x4){0.f, 0.f, 0.f, 0.f};
        bf16x8 bfr[8], afr[4][8];
#pragma unroll
        for (int i = 0; i < 8; ++i) bfr[i] = *(const bf16x8*)(bp + 32 * i);
#pragma unroll
        for (int tt = 0; tt < 4; ++tt)
#pragma unroll
            for (int i = 0; i < 8; ++i) afr[tt][i] = *(const bf16x8*)(F.hby + (size_t)(rb * 64 + tt * 16 + fr) * DM + w * 256 + 8 * fq + 32 * i);
#pragma unroll
        for (int i = 0; i < 8; ++i)
#pragma unroll
            for (int tt = 0; tt < 4; ++tt) acc[tt] = __builtin_amdgcn_mfma_f32_16x16x32_bf16(afr[tt][i], bfr[i], acc[tt], 0, 0, 0);
#pragma unroll
        for (int tt = 0; tt < 4; ++tt) red[(w * 4 + tt) * 64 + F.lane] = acc[tt];
        __syncthreads();
        if (w < 4) { f32x4 o = red[w * 64 + F.lane];
#pragma unroll
            for (int ww = 1; ww < 8; ++ww) o = o + red[(ww * 4 + w) * 64 + F.lane];
            const float bb = bg[fr];
#pragma unroll
            for (int j = 0; j < 4; ++j) F.gate[(size_t)fr * M + rb * 64 + w * 16 + 4 * fq + j] = o[j] + bb; }
        __syncthreads();
    }
}

constexpr int WA_K = 0, WA_V = 65536, WA_VSTR = 1032, WA_TB = WA_V + 64 * WA_VSTR  , WA_TBS = 320, WA_END = WA_TB + 3 * WA_TBS * 4;
static_assert(WA_END <= MISC_OFF, "WA LDS map");
__device__ __forceinline__ void wattn_item(Ctx& F, int item, int l) {
    const int b = item >> 6, kvh = (item >> 4) & 3, p = item & 15;
    const int tokb = b * SEQ, kpos0 = 256 * p - 128;
    LAS unsigned char* lds = F.lds;
    {
        u32x4 kr[8], vr[8];
        const int kc0 = F.tid >> 3, c = F.tid & 7;
#pragma unroll
        for (int j = 0; j < 8; ++j) { const int kk = kc0 + 64 * j; int pos = kpos0 + kk; pos = pos < 0 ? 0 : (pos > SEQ - 1 ? SEQ - 1 : pos);
            kr[j] = *(const u32x4*)(F.unat + (size_t)(tokb + pos) * LDN + N_AK + kvh * 64 + c * 8); }
        const int d0 = F.tid >> 6, cc = F.tid & 63;
        int vpos = kpos0 + cc * 8; vpos = vpos < 0 ? 0 : (vpos > SEQ - 8 ? SEQ - 8 : vpos);
#pragma unroll
        for (int j = 0; j < 8; ++j) vr[j] = *(const u32x4*)(F.ut + (size_t)(T_AV + kvh * 64 + d0 + 8 * j) * M + tokb + vpos);
#pragma unroll
        for (int j = 0; j < 8; ++j) { const int kk = kc0 + 64 * j; *(LAS u32x4*)(lds + WA_K + kk * 128 + ((c ^ ((kk >> 1) & 7)) << 4)) = kr[j]; }
#pragma unroll
        for (int j = 0; j < 8; ++j) { LAS unsigned char* dst = lds + WA_V + (d0 + 8 * j) * WA_VSTR + cc * 16;
            *(LAS u32x2*)dst = (u32x2){vr[j].x, vr[j].y}; *(LAS u32x2*)(dst + 8) = (u32x2){vr[j].z, vr[j].w}; }
    }
    LAS float* tbw = (LAS float*)(lds + WA_TB);
    for (int i = F.tid; i < 3 * WA_TBS; i += NTHR) { const int g = i / WA_TBS, idx = i % WA_TBS - 31; tbw[i] = (idx >= 0 && idx <= 256) ? F.t5[t5_bucket(idx - 128) * 12 + kvh * 3 + g] * LOG2E : -INFINITY; }
    const int qt = F.wave, r = F.lane & 31, h = F.lane >> 5, ql = 32 * qt + r;
    const int tokq = tokb + 256 * p + ql;
    unsigned bad[16];
#pragma unroll
    for (int i = 0; i < 16; ++i) bad[i] = (unsigned)(WA_TB + (crow(i, h) - r + 31) * 4);
    bf16x8 qf[4];
#pragma unroll
    for (int s = 0; s < 4; ++s) qf[s] = *(const bf16x8*)(F.unat + fm_off<3>(tokq, N_AQ, (kvh * 3) * 64 + 16 * s + 8 * h));
    __syncthreads();
    const int dlo = (p == 0) ? ((4 - qt) > 0 ? (4 - qt) : 0) : 0;
    const int dhi = (p == 15) ? ((12 - qt) < 9 ? (12 - qt) : 9) : 9;
#pragma unroll 1
    for (int g = 0; g < 3; ++g) {
        const int head = kvh * 3 + g;
        bf16x8 qn[4];
        if (g < 2) {
#pragma unroll
            for (int s = 0; s < 4; ++s) qn[s] = *(const bf16x8*)(F.unat + fm_off<3>(tokq, N_AQ, (head + 1) * 64 + 16 * s + 8 * h));
        } else {
#pragma unroll
            for (int s = 0; s < 4; ++s) qn[s] = qf[s];
        }
        u32x2 zz[8];
#pragma unroll
        for (int p = 0; p < 4; ++p) { const u32x4 q_ = *(const u32x4*)(F.unat + fm_off<3>(tokq, N_AZ, head * 64 + 16 * p + 8 * h)); zz[2 * p] = (u32x2){q_.x, q_.y}; zz[2 * p + 1] = (u32x2){q_.z, q_.w}; }
        float m = F.sink[l * 12 + head] * LOG2E, lsum = h ? 0.f : 1.f;
        f32x16 O0 = zero16(), O1 = zero16();
        const unsigned goff = (unsigned)(g * WA_TBS * 4);
#pragma unroll
        for (int dt_ = 0; dt_ < 9; ++dt_) {
            if (dt_ >= dlo && dt_ < dhi) {
                const int kt = qt + dt_;
                f32x16 S = zero16();
                const int krow_ = kt * 32 + r;
#pragma unroll
                for (int s = 0; s < 4; ++s) { const bf16x8 kf = *(const LAS bf16x8*)(lds + WA_K + krow_ * 128 + (((2 * s + h) ^ ((krow_ >> 1) & 7)) << 4)); S = MFMA32(kf, qf[s], S); }
                float bs[16];
#pragma unroll
                for (int i = 0; i < 16; ++i) bs[i] = *(const LAS float*)(lds + (bad[i] + goff) + dt_ * 128);
                float mx = -INFINITY;
#pragma unroll
                for (int i = 0; i < 16; ++i) { const float sv = fmaf(S[i], C2A, bs[i]); S[i] = sv; mx = fmaxf(mx, sv); }
                if (__builtin_amdgcn_ballot_w64(mx > m + 6.f) != 0ull) {
                    mx = fmaxf(mx, shx(mx, 32, F.lane));
                    const float mn = fmaxf(m, mx), al = ex2(m - mn); m = mn; lsum *= al;
#pragma unroll
                    for (int i = 0; i < 16; ++i) { O0[i] *= al; O1[i] *= al; }
                }
#pragma unroll
                for (int i = 0; i < 16; ++i) { const float pv = ex2(S[i] - m); S[i] = pv; lsum += pv; }
                const bf16x8 pb0 = pack8(S, 0), pb1 = pack8(S, 1);
#pragma unroll
                for (int s2 = 0; s2 < 2; ++s2) {
                    const int kof = (kt * 32 + 16 * s2 + 4 * h) * 2;
                    const s16x4 a0 = *(const LAS s16x4*)(lds + WA_V + r * WA_VSTR + kof), a1 = *(const LAS s16x4*)(lds + WA_V + r * WA_VSTR + kof + 16);
                    const s16x4 c0 = *(const LAS s16x4*)(lds + WA_V + (32 + r) * WA_VSTR + kof), c1 = *(const LAS s16x4*)(lds + WA_V + (32 + r) * WA_VSTR + kof + 16);
                    const bf16x8 v0 = __builtin_shufflevector(a0, a1, 0, 1, 2, 3, 4, 5, 6, 7), v1 = __builtin_shufflevector(c0, c1, 0, 1, 2, 3, 4, 5, 6, 7);
                    O0 = MFMA32(v0, s2 ? pb1 : pb0, O0); O1 = MFMA32(v1, s2 ? pb1 : pb0, O1);
                }
            }
        }
        lsum += shx(lsum, 32, F.lane);
        const float inv = frcp(lsum);
        bf16* yp = F.yb + (size_t)tokq * DM + head * 64 + 8 * h;
#pragma unroll
        for (int p = 0; p < 4; ++p) { const auto sx = __builtin_amdgcn_permlane32_swap(zz[2 * p].x, zz[2 * p + 1].x, false, false), sy = __builtin_amdgcn_permlane32_swap(zz[2 * p].y, zz[2 * p + 1].y, false, false);
            zz[2 * p] = (u32x2){sx[0], sy[0]}; zz[2 * p + 1] = (u32x2){sx[1], sy[1]}; }
#pragma unroll
        for (int dt = 0; dt < 2; ++dt) {
            u32x2 wy[4];
#pragma unroll
            for (int g4 = 0; g4 < 4; ++g4) { const u32x2 z2 = zz[dt * 4 + g4];
                const f32x16& O = dt ? O1 : O0;
                const float y0 = O[4 * g4] * inv * silu(bflo(z2.x)), y1 = O[4 * g4 + 1] * inv * silu(bfhi(z2.x)), y2 = O[4 * g4 + 2] * inv * silu(bflo(z2.y)), y3 = O[4 * g4 + 3] * inv * silu(bfhi(z2.y));
                wy[g4].x = cvt_pk_bf16(y0, y1); wy[g4].y = cvt_pk_bf16(y2, y3); }
#pragma unroll
            for (int p = 0; p < 2; ++p) { const auto sx = __builtin_amdgcn_permlane32_swap(wy[2 * p].x, wy[2 * p + 1].x, false, false), sy = __builtin_amdgcn_permlane32_swap(wy[2 * p].y, wy[2 * p + 1].y, false, false);
                u32x4 o; o.x = sx[0]; o.y = sy[0]; o.z = sx[1]; o.w = sy[1]; *(u32x4*)(yp + 32 * dt + 16 * p) = o; }
        }
#pragma unroll
        for (int s = 0; s < 4; ++s) qf[s] = qn[s];
    }
    __syncthreads();
}

constexpr int NA_K = 0, NA_V = 73728, NA_VSTR = 1160, NA_TB = NA_V + 64 * NA_VSTR  , NA_TI = NA_TB + 480 * 4  , NA_X = NA_TI + 2048, NA_XQ = 2560, NA_END = NA_X + 4 * NA_XQ;
static_assert(NA_END <= MISC_OFF, "NA LDS map");
struct NaRegs { u32x4 k[9]; u32x4 v[9]; };
__device__ __forceinline__ void na_decode(int item, int& b, int& head, int& r0, int& rs0) { b = item / 384; head = (item / 32) % 12; r0 = 2 * (item & 31); int t = r0 - 4; rs0 = t < 0 ? 0 : (t > 56 ? 56 : t); }
__device__ __forceinline__ void na_row_issue(Ctx& F, int b, int head, int gr, u32x4& kreg, u32x4& vreg) {
    const int kc = F.tid >> 3, c = F.tid & 7;
    kreg = *(const u32x4*)(F.unat + (size_t)(b * SEQ + gr * 64 + kc) * LDN + N_CK + head * 64 + c * 8);
    vreg = *(const u32x4*)(F.ut + (size_t)(T_CV + head * 64 + kc) * M + b * SEQ + gr * 64 + c * 8);
}
__device__ __forceinline__ void na_row_commit(Ctx& F, int gr, const u32x4& kreg, const u32x4& vreg) {
    const int kc = F.tid >> 3, c = F.tid & 7, slot = gr % 9, kk = slot * 64 + kc;
    *(LAS u32x4*)(F.lds + NA_K + kk * 128 + ((c ^ ((kk >> 1) & 7)) << 4)) = kreg;
    LAS unsigned char* dst = F.lds + NA_V + kc * NA_VSTR + (slot * 64 + c * 8) * 2;
    *(LAS u32x2*)dst = (u32x2){vreg.x, vreg.y}; *(LAS u32x2*)(dst + 8) = (u32x2){vreg.z, vreg.w};
}
#define SCHED_FENCE() __builtin_amdgcn_sched_barrier(0)
template <int CH>
__device__ __forceinline__ void na_tiles(LAS unsigned char* lds, const bf16x8 (&qf)[4], const unsigned (&badf)[16], const unsigned (&badc)[4], int rsj, int khalf, int r, int h,
                                         float& m, float& lsum, f32x16& O0, f32x16& O1) {
    bf16x8 kc[4];
    { const int kb0 = ((rsj + 4 * khalf) % 9) * 64, krow_ = kb0 + r;
#pragma unroll
      for (int s = 0; s < 4; ++s) kc[s] = *(const LAS bf16x8*)(lds + NA_K + krow_ * 128 + (((2 * s + h) ^ ((krow_ >> 1) & 7)) << 4)); }
#pragma unroll
    for (int it = 0; it < 8; ++it) {
        const int kri = it >> 1, kct = it & 1;
        const bool full = (kct == CH);
        const int kbase = ((rsj + 4 * khalf + kri) % 9) * 64 + kct * 32;
        s16x4 va[2][2], vc[2][2]; float bs[16];
#pragma unroll
        for (int s2 = 0; s2 < 2; ++s2) if (full || s2 == (kct ? 0 : 1)) {
            const int kof = (kbase + 16 * s2 + 4 * h) * 2;
            va[s2][0] = *(const LAS s16x4*)(lds + NA_V + r * NA_VSTR + kof); va[s2][1] = *(const LAS s16x4*)(lds + NA_V + r * NA_VSTR + kof + 16);
            vc[s2][0] = *(const LAS s16x4*)(lds + NA_V + (32 + r) * NA_VSTR + kof); vc[s2][1] = *(const LAS s16x4*)(lds + NA_V + (32 + r) * NA_VSTR + kof + 16);
        }
        if (full) {
#pragma unroll
            for (int i = 0; i < 16; ++i) bs[i] = *(const LAS float*)(lds + badf[i] + kri * 128);
        } else {
#pragma unroll
            for (int i = 0; i < 4; ++i) bs[i] = *(const LAS float*)(lds + badc[i] + kri * 128);
        }
        SCHED_FENCE();
        f32x16 S = zero16();
#pragma unroll
        for (int s = 0; s < 4; ++s) S = MFMA32(kc[s], qf[s], S);
        if (it < 7) { const int nb = ((rsj + 4 * khalf + ((it + 1) >> 1)) % 9) * 64 + ((it + 1) & 1) * 32, krow_ = nb + r;
#pragma unroll
            for (int s = 0; s < 4; ++s) kc[s] = *(const LAS bf16x8*)(lds + NA_K + krow_ * 128 + (((2 * s + h) ^ ((krow_ >> 1) & 7)) << 4)); }
        SCHED_FENCE();
        constexpr int NV = 16;
        const int i0 = full ? 0 : (kct ? 0 : 12), nv = full ? NV : 4;
        float mx = -INFINITY;
#pragma unroll
        for (int i = 0; i < NV; ++i) if (i < nv) { const float sv = fmaf(S[i0 + i], C2A, bs[i]); bs[i] = sv; mx = fmaxf(mx, sv); }
        { const auto sw = __builtin_amdgcn_permlane32_swap(__float_as_uint(mx), __float_as_uint(mx), false, false); mx = fmaxf(__uint_as_float(sw[0]), __uint_as_float(sw[1])); }
        const float mn = fmaxf(m, mx), al = ex2(m - mn); m = mn; lsum *= al;
#pragma unroll
        for (int i = 0; i < 16; ++i) { O0[i] *= al; O1[i] *= al; }
#pragma unroll
        for (int i = 0; i < NV; ++i) if (i < nv) { const float pv = ex2(bs[i] - mn); bs[i] = pv; lsum += pv; }
        if (full) {
            u32x4 p0, p1;
            p0.x = cvt_pk_bf16(bs[0], bs[1]); p0.y = cvt_pk_bf16(bs[2], bs[3]); p0.z = cvt_pk_bf16(bs[4], bs[5]); p0.w = cvt_pk_bf16(bs[6], bs[7]);
            p1.x = cvt_pk_bf16(bs[8], bs[9]); p1.y = cvt_pk_bf16(bs[10], bs[11]); p1.z = cvt_pk_bf16(bs[12], bs[13]); p1.w = cvt_pk_bf16(bs[14], bs[15]);
            const bf16x8 pb0 = __builtin_bit_cast(bf16x8, p0), pb1 = __builtin_bit_cast(bf16x8, p1);
            O0 = MFMA32(__builtin_shufflevector(va[0][0], va[0][1], 0, 1, 2, 3, 4, 5, 6, 7), pb0, O0); O1 = MFMA32(__builtin_shufflevector(vc[0][0], vc[0][1], 0, 1, 2, 3, 4, 5, 6, 7), pb0, O1);
            O0 = MFMA32(__builtin_shufflevector(va[1][0], va[1][1], 0, 1, 2, 3, 4, 5, 6, 7), pb1, O0); O1 = MFMA32(__builtin_shufflevector(vc[1][0], vc[1][1], 0, 1, 2, 3, 4, 5, 6, 7), pb1, O1);
        } else {
            u32x4 pw; const unsigned p01 = cvt_pk_bf16(bs[0], bs[1]), p23 = cvt_pk_bf16(bs[2], bs[3]);
            if (kct) { pw.x = p01; pw.y = p23; pw.z = 0u; pw.w = 0u; } else { pw.x = 0u; pw.y = 0u; pw.z = p01; pw.w = p23; }
            const bf16x8 pbx = __builtin_bit_cast(bf16x8, pw);
            const int s2 = kct ? 0 : 1;
            O0 = MFMA32(__builtin_shufflevector(va[s2][0], va[s2][1], 0, 1, 2, 3, 4, 5, 6, 7), pbx, O0); O1 = MFMA32(__builtin_shufflevector(vc[s2][0], vc[s2][1], 0, 1, 2, 3, 4, 5, 6, 7), pbx, O1);
        }
    }
}

__device__ __forceinline__ void nattn_all(Ctx& F, int l) {
    LAS unsigned char* lds = F.lds;
    const int vb = (F.G == 256) ? ((F.bid & 7) * 32 + (F.bid >> 3)) : F.bid;
    const int per = (1536 + F.G - 1) / F.G, it0 = vb * per, it1 = (it0 + per) < 1536 ? (it0 + per) : 1536;
    if (F.wave >= 4) __builtin_amdgcn_s_setprio(1);
    const int qt = F.wave & 3, khalf = F.wave >> 2, j = qt >> 1, ch = qt & 1, r = F.lane & 31, h = F.lane >> 5;
    const int qc = 32 * ch + r; int cs = qc - 8; cs = cs < 0 ? 0 : (cs > 48 ? 48 : cs);
    unsigned badf[16], badc[4];
#pragma unroll
    for (int i = 0; i < 16; ++i) { const int kc = ch * 32 + crow(i, h); const bool ok = (kc >= cs) && (kc < cs + 16); int dc = kc - qc; dc = dc < -15 ? -15 : (dc > 15 ? 15 : dc);
        badf[i] = (unsigned)(NA_TI + ((j * 8 + khalf * 4) * 32 + (ok ? dc + 15 : 31)) * 4); }
#pragma unroll
    for (int i = 0; i < 4; ++i) { const int kct = 1 - ch, ii = (kct ? 0 : 12) + i; const int kc = kct * 32 + crow(ii, h); const bool ok = (kc >= cs) && (kc < cs + 16); int dc = kc - qc; dc = dc < -15 ? -15 : (dc > 15 ? 15 : dc);
        badc[i] = (unsigned)(NA_TI + ((j * 8 + khalf * 4) * 32 + (ok ? dc + 15 : 31)) * 4); }
    int have_bh = -1, have_hi = -1, pf_lo = 0, pf_n = 0, tb_bh = -1;
    u32x4 pk0, pv0, pk1, pv1; bf16x8 qn[4]; bool have_qn = false;
    pk0 = pv0 = pk1 = pv1 = (u32x4){0u, 0u, 0u, 0u};
#pragma unroll
    for (int s = 0; s < 4; ++s) qn[s] = (bf16x8){0, 0, 0, 0, 0, 0, 0, 0};
#pragma unroll 1
    for (int item = it0; item < it1; ++item) {
        int b, head, r0, rs0; na_decode(item, b, head, r0, rs0);
        const int bh = b * 12 + head, need_hi = (rs0 + 8) < 63 ? (rs0 + 8) : 63, tokb = b * SEQ;
        if (bh != have_bh) {
            NaRegs R;
#pragma unroll
            for (int jj = 0; jj < 9; ++jj) { const int gr = (rs0 + jj) < 63 ? (rs0 + jj) : 63; na_row_issue(F, b, head, gr, R.k[jj], R.v[jj]); }
#pragma unroll
            for (int jj = 0; jj < 9; ++jj) { if (rs0 + jj <= 63) na_row_commit(F, rs0 + jj, R.k[jj], R.v[jj]); }
            LAS float* tbw = (LAS float*)(lds + NA_TB);
            for (int i = F.tid; i < 465; i += NTHR) tbw[i] = F.rpb[(size_t)(l * 12 + head) * 465 + i] * LOG2E;
            have_bh = bh;
        } else {
            if (pf_n > 0) na_row_commit(F, pf_lo, pk0, pv0);
            if (pf_n > 1) na_row_commit(F, pf_lo + 1, pk1, pv1);
        }
        have_hi = need_hi;
        if (bh != tb_bh) { LDS_BARRIER(); tb_bh = bh; }
        { const LAS float* tb = (const LAS float*)(lds + NA_TB); const int jj = F.tid >> 8, kidx = (F.tid >> 5) & 7, dci = F.tid & 31;
          int rsq = r0 + jj - 4; rsq = rsq < 0 ? 0 : (rsq > 56 ? 56 : rsq); const int dr = rsq + kidx - (r0 + jj) + 7;
          ((LAS float*)(lds + NA_TI))[F.tid] = dci < 31 ? tb[dr * 31 + dci] : -INFINITY; }
        const int qrow = r0 + j; int rsj = qrow - 4; rsj = rsj < 0 ? 0 : (rsj > 56 ? 56 : rsj);
        const int tokq = tokb + qrow * 64 + qc;
        bf16x8 qf[4];
        if (have_qn) {
#pragma unroll
            for (int s = 0; s < 4; ++s) qf[s] = qn[s];
        } else {
#pragma unroll
            for (int s = 0; s < 4; ++s) qf[s] = *(const bf16x8*)(F.unat + fm_off<3>(tokq, N_CQ, head * 64 + 16 * s + 8 * h));
        }
        u32x2 zz[4];
#pragma unroll
        for (int p = 0; p < 2; ++p) { const u32x4 q_ = *(const u32x4*)(F.unat + fm_off<3>(tokq, N_CZ, head * 64 + 32 * khalf + 16 * p + 8 * h)); zz[2 * p] = (u32x2){q_.x, q_.y}; zz[2 * p + 1] = (u32x2){q_.z, q_.w}; }
        LDS_BARRIER();
        pf_n = 0; have_qn = false;
        if (item + 1 < it1) {
            int nb, nhead, nr0, nrs0; na_decode(item + 1, nb, nhead, nr0, nrs0);
            if (nb * 12 + nhead == bh) {
                const int nhi = (nrs0 + 8) < 63 ? (nrs0 + 8) : 63;
                pf_lo = have_hi + 1; pf_n = nhi - have_hi;
                if (pf_n > 0) na_row_issue(F, b, head, pf_lo, pk0, pv0);
                if (pf_n > 1) na_row_issue(F, b, head, pf_lo + 1, pk1, pv1);
            }
            const int ntokq = nb * SEQ + (nr0 + j) * 64 + qc;
#pragma unroll
            for (int s = 0; s < 4; ++s) qn[s] = *(const bf16x8*)(F.unat + fm_off<3>(ntokq, N_CQ, nhead * 64 + 16 * s + 8 * h));
            have_qn = true;
        }
        float m = -1e30f, lsum = 0.f;
        f32x16 O0 = zero16(), O1 = zero16();
        if (ch == 0) na_tiles<0>(lds, qf, badf, badc, rsj, khalf, r, h, m, lsum, O0, O1); else na_tiles<1>(lds, qf, badf, badc, rsj, khalf, r, h, m, lsum, O0, O1);
        lsum += shx(lsum, 32, F.lane);
        LAS unsigned* xq = (LAS unsigned*)(lds + NA_X + qt * NA_XQ);
        LAS float* xf = (LAS float*)(lds + NA_X + qt * NA_XQ + 2048);
        bf16* yp = F.yb + (size_t)tokq * DM + 1280 + head * 64 + 32 * khalf + 8 * h;
        if (khalf == 1) {
#pragma unroll
            for (int i = 0; i < 8; ++i) xq[i * 64 + F.lane] = cvt_pk_bf16(O0[2 * i], O0[2 * i + 1]);
            xf[F.lane] = m; xf[64 + F.lane] = lsum;
        }
        LDS_BARRIER();
        float m2 = 0.f, l2 = 0.f; unsigned ox[8];
        if (khalf == 0) {
            m2 = xf[F.lane]; l2 = xf[64 + F.lane];
#pragma unroll
            for (int i = 0; i < 8; ++i) ox[i] = xq[i * 64 + F.lane];
        }
        LDS_BARRIER();
        if (khalf == 0) {
#pragma unroll
            for (int i = 0; i < 8; ++i) xq[i * 64 + F.lane] = cvt_pk_bf16(O1[2 * i], O1[2 * i + 1]);
            xf[F.lane] = m; xf[64 + F.lane] = lsum;
        }
        LDS_BARRIER();
        if (khalf == 1) {
            m2 = xf[F.lane]; l2 = xf[64 + F.lane];
#pragma unroll
            for (int i = 0; i < 8; ++i) ox[i] = xq[i * 64 + F.lane];
        }
        {
            const float mn = fmaxf(m, m2), a1 = ex2(m - mn), a2 = ex2(m2 - mn);
            const float inv = frcp(lsum * a1 + l2 * a2);
#pragma unroll
            for (int p = 0; p < 2; ++p) { const auto sx = __builtin_amdgcn_permlane32_swap(zz[2 * p].x, zz[2 * p + 1].x, false, false), sy = __builtin_amdgcn_permlane32_swap(zz[2 * p].y, zz[2 * p + 1].y, false, false);
                zz[2 * p] = (u32x2){sx[0], sy[0]}; zz[2 * p + 1] = (u32x2){sx[1], sy[1]}; }
            u32x2 wy[4];
#pragma unroll
            for (int g4 = 0; g4 < 4; ++g4) {
                float o[4];
#pragma unroll
                for (int e = 0; e < 4; ++e) { const float mine = khalf ? O1[4 * g4 + e] : O0[4 * g4 + e]; const unsigned pw = ox[2 * g4 + (e >> 1)]; const float oth = (e & 1) ? bfhi(pw) : bflo(pw);
                    o[e] = (mine * a1 + oth * a2) * inv; }
                const u32x2 z2 = zz[g4];
                const float y0 = o[0] * silu(bflo(z2.x)), y1 = o[1] * silu(bfhi(z2.x)), y2 = o[2] * silu(bflo(z2.y)), y3 = o[3] * silu(bfhi(z2.y));
                wy[g4].x = cvt_pk_bf16(y0, y1); wy[g4].y = cvt_pk_bf16(y2, y3); }
#pragma unroll
            for (int p = 0; p < 2; ++p) { const auto sx = __builtin_amdgcn_permlane32_swap(wy[2 * p].x, wy[2 * p + 1].x, false, false), sy = __builtin_amdgcn_permlane32_swap(wy[2 * p].y, wy[2 * p + 1].y, false, false);
                u32x4 o4; o4.x = sx[0]; o4.y = sy[0]; o4.z = sx[1]; o4.w = sy[1]; *(u32x4*)(yp + 16 * p) = o4; }
        }
    }
    __builtin_amdgcn_s_setprio(0);
    LDS_BARRIER();
}

__device__ __forceinline__ size_t cst_chunk(int cid, int c, int dt, int k, int r) { const int L = ((dt * 16 + k) * 32 + r) * 8; return ((size_t)((cid * 8 + (L >> 11)) * 64 + c)) * 2048 + (size_t)(L & 2047); }
__device__ __forceinline__ void m1_wave(Ctx& F, int wi, int l) {
    const int b = wi >> 9, head = (wi >> 7) & 3, c = (wi >> 1) & 63, dir = wi & 1;
    const int tok0 = b * SEQ + c * 64;
    const int lane = F.lane, r = lane & 31, h = lane >> 5;
    LAS float* wtab = (LAS float*)(F.lds + F.wave * 256);
    const float ig = F.gate[(size_t)((2 * dir) * 4 + head) * M + tok0 + lane];
    const float fg = F.gate[(size_t)((2 * dir + 1) * 4 + head) * M + tok0 + lane] + F.fbias[l * 8 + dir * 4 + head];
    const float lf = logsigmoid(fg);
    const float cs = dir == 0 ? scan_sum_up(lf, lane) : scan_sum_down(lf, lane);
    const float g = shi(cs, dir == 0 ? 63 : 0);
    const float a = g - cs + ig;
    const float mloc = wave_max(a, lane);
    const float w = fexp(a - mloc);
    wtab[lane] = w;
    LDS_WAIT();
    const int cid = dir * 16 + b * 4 + head;
    if (lane == 0) { F.gs[cid * 64 + c] = g; F.ml[cid * 64 + c] = mloc; }
    f32x4 wv[8];
#pragma unroll
    for (int s = 0; s < 4; ++s) { wv[2 * s] = *(const LAS f32x4*)(wtab + 16 * s + 4 * h); wv[2 * s + 1] = *(const LAS f32x4*)(wtab + 16 * s + 8 + 4 * h); }
    bf16x8 af[4][4];
    {
        bf16x8 kn[2][8];
#pragma unroll
        for (int T = 0; T < 2; ++T)
#pragma unroll
            for (int j = 0; j < 8; ++j) kn[T][j] = *(const bf16x8*)(F.unat + bqk_off(tok0 + 32 * T + r, 512 + head * 128 + 16 * j + 8 * h));
        u32x4 i0, i1;
        { const unsigned one_lo = 0x3F80u, one_hi = 0x3F800000u; const int d0 = r - 8 * h, d1 = r - 16 - 8 * h;
          i0.x = d0 == 0 ? one_lo : d0 == 1 ? one_hi : 0u; i0.y = d0 == 2 ? one_lo : d0 == 3 ? one_hi : 0u; i0.z = d0 == 4 ? one_lo : d0 == 5 ? one_hi : 0u; i0.w = d0 == 6 ? one_lo : d0 == 7 ? one_hi : 0u;
          i1.x = d1 == 0 ? one_lo : d1 == 1 ? one_hi : 0u; i1.y = d1 == 2 ? one_lo : d1 == 3 ? one_hi : 0u; i1.z = d1 == 4 ? one_lo : d1 == 5 ? one_hi : 0u; i1.w = d1 == 6 ? one_lo : d1 == 7 ? one_hi : 0u; }
        const bf16x8 I0 = __builtin_bit_cast(bf16x8, i0), I1 = __builtin_bit_cast(bf16x8, i1);
#pragma unroll
        for (int et = 0; et < 4; ++et)
#pragma unroll
            for (int T = 0; T < 2; ++T) {
                f32x16 d = zero16();
                d = MFMA32(kn[T][2 * et], I0, d); d = MFMA32(kn[T][2 * et + 1], I1, d);
                af[et][2 * T] = pack8(d, 0); af[et][2 * T + 1] = pack8(d, 1);
            }
    }
#pragma unroll
    for (int et = 0; et < 4; ++et) { float ns = 0.f;
#pragma unroll
        for (int s = 0; s < 4; ++s) { const u32x4 raw = __builtin_bit_cast(u32x4, af[et][s]); const f32x4 w0 = wv[2 * s], w1 = wv[2 * s + 1];
            ns += bflo(raw.x) * w0[0] + bfhi(raw.x) * w0[1] + bflo(raw.y) * w0[2] + bfhi(raw.y) * w0[3] + bflo(raw.z) * w1[0] + bfhi(raw.z) * w1[1] + bflo(raw.w) * w1[2] + bfhi(raw.w) * w1[3]; }
        ns += shx(ns, 32, lane);
        if (h == 0) F.nst[(size_t)(cid * 64 + c) * 128 + 32 * et + r] = ns; }
#pragma unroll 1
    for (int dt = 0; dt < 4; ++dt) {
        bf16x8 bfr[4];
#pragma unroll
        for (int s = 0; s < 4; ++s) {
            const u32x4 q = *(const u32x4*)(F.ut + (size_t)(T_BV + head * 128 + 32 * dt + r) * M + tok0 + 16 * s + 8 * h);
            const auto sx = __builtin_amdgcn_permlane32_swap(q.x, q.z, false, false), sy = __builtin_amdgcn_permlane32_swap(q.y, q.w, false, false);
            u32x4 raw; raw.x = sx[0]; raw.y = sy[0]; raw.z = sx[1]; raw.w = sy[1];
            const f32x4 w0 = wv[2 * s], w1 = wv[2 * s + 1];
            u32x4 o; o.x = cvt_pk_bf16(bflo(raw.x) * w0[0], bfhi(raw.x) * w0[1]); o.y = cvt_pk_bf16(bflo(raw.y) * w0[2], bfhi(raw.y) * w0[3]);
            o.z = cvt_pk_bf16(bflo(raw.z) * w1[0], bfhi(raw.z) * w1[1]); o.w = cvt_pk_bf16(bflo(raw.w) * w1[2], bfhi(raw.w) * w1[3]);
            bfr[s] = __builtin_bit_cast(bf16x8, o);
        }
#pragma unroll
        for (int et = 0; et < 4; ++et) {
            f32x16 acc = zero16();
#pragma unroll
            for (int s = 0; s < 4; ++s) acc = MFMA32(af[et][s], bfr[s], acc);
#pragma unroll
            for (int p = 0; p < 2; ++p) {
                const unsigned a0 = cvt_pk_bf16(acc[8 * p], acc[8 * p + 1]), a1 = cvt_pk_bf16(acc[8 * p + 2], acc[8 * p + 3]);
                const unsigned b0 = cvt_pk_bf16(acc[8 * p + 4], acc[8 * p + 5]), b1 = cvt_pk_bf16(acc[8 * p + 6], acc[8 * p + 7]);
                const auto s0 = __builtin_amdgcn_permlane32_swap(a0, b0, false, false), s1 = __builtin_amdgcn_permlane32_swap(a1, b1, false, false);
                u32x4 o; o.x = s0[0]; o.y = s1[0]; o.z = s0[1]; o.w = s1[1];
                *(u32x4*)(F.cst + cst_chunk(cid, c, dt, 4 * et + 2 * p + h, r)) = o; }
        }
    }
    LDS_WAIT();
}

__device__ __forceinline__ void m2_scan(Ctx& F) {
    LAS float* sps = (LAS float*)F.lds; LAS float* sls = sps + 64;
    for (int blk = F.bid; blk < 256; blk += F.G) {
        const int cid = blk >> 3, dir = cid >> 4, e4 = (blk & 7) * 512 + F.tid;
        if (F.wave == 0) {
            const int sidx = F.lane, c = dir ? 63 - sidx : sidx;
            const float g = F.gs[cid * 64 + c], mloc = F.ml[cid * 64 + c];
            const float Gs = scan_sum_up(g, sidx);
            const float ma = Gs + fmaxf(0.f, scan_max_up(mloc - Gs, sidx));
            const float mb0 = shi(ma, sidx - 1); const float mb = sidx == 0 ? 0.f : mb0;
            sps[sidx] = fexp(g + mb - ma); sls[sidx] = fexp(mloc - ma); F.mprev[cid * 64 + c] = mb;
        }
        __syncthreads();
        float C0 = 0.f, C1 = 0.f, C2 = 0.f, C3 = 0.f;
        f32x4 nn = {0.f, 0.f, 0.f, 0.f};
        const bool do_n = e4 < 32;
        bf16* cb = F.cst + (size_t)(cid * 8 + (blk & 7)) * 64 * 2048 + F.tid * 4;
        float* nb = F.nst + (size_t)cid * 64 * 128 + (e4 & 31) * 4;
#pragma unroll 1
        for (int s0 = 0; s0 < 64; s0 += 16) {
            u32x2 cl[16]; f32x4 nl[16];
#pragma unroll
            for (int j = 0; j < 16; ++j) { const int c = dir ? 63 - (s0 + j) : (s0 + j); cl[j] = *(const u32x2*)(cb + (size_t)c * 2048); }
            if (do_n) {
#pragma unroll
                for (int j = 0; j < 16; ++j) { const int c = dir ? 63 - (s0 + j) : (s0 + j); nl[j] = *(const f32x4*)(nb + (size_t)c * 128); }
            }
#pragma unroll
            for (int j = 0; j < 16; ++j) {
                const int c = dir ? 63 - (s0 + j) : (s0 + j);
                u32x2 o; o.x = cvt_pk_bf16(C0, C1); o.y = cvt_pk_bf16(C2, C3); *(u32x2*)(cb + (size_t)c * 2048) = o;
                const float sp = sps[s0 + j], sl = sls[s0 + j];
                C0 = sp * C0 + sl * bflo(cl[j].x); C1 = sp * C1 + sl * bfhi(cl[j].x); C2 = sp * C2 + sl * bflo(cl[j].y); C3 = sp * C3 + sl * bfhi(cl[j].y);
                if (do_n) { *(f32x4*)(nb + (size_t)c * 128) = nn; nn = nn * sp + nl[j] * sl; }
            }
        }
        __syncthreads();
    }
}

constexpr int M3_TABW = 2560, M3_HB = 8 * M3_TABW  , M3_HW = 16384;
static_assert(M3_HB + 8 * M3_HW <= MISC_OFF, "M3 LDS map");
__device__ __forceinline__ void m3_wave(Ctx& F, int wi, int l) {
    const int b = wi >> 9, head = (wi >> 7) & 3, c = (wi >> 1) & 63, tt = wi & 1;
    const int tok0 = b * SEQ + c * 64;
    int lane_ = 0; asm volatile("" : "+v"(lane_)); lane_ = (int)__builtin_amdgcn_mbcnt_hi(~0u, __builtin_amdgcn_mbcnt_lo(~0u, (unsigned)lane_));
    const int lane = lane_, r = lane & 31, h = lane >> 5;
    LAS float* tab = (LAS float*)(F.lds + F.wave * M3_TABW);
    LAS float* hb = (LAS float*)(F.lds + M3_HB + F.wave * M3_HW);
    const int cidf = b * 4 + head, cidb = 16 + b * 4 + head;
    const int t = 32 * tt + r;
    const float* gp = F.gate + (size_t)head * M + tok0 + lane;
    const float g_if = gp[0], g_ff = gp[(size_t)4 * M], g_ib = gp[(size_t)8 * M], g_fb = gp[(size_t)12 * M];
    const float mpf = F.mprev[cidf * 64 + c], mpb = F.mprev[cidb * 64 + c];
    const float* nf = F.nst + (size_t)(cidf * 64 + c) * 128; const float* nbw = F.nst + (size_t)(cidb * 64 + c) * 128;
    const float n0_ = nf[lane], n1_ = nf[64 + lane], n2_ = nbw[lane], n3_ = nbw[64 + lane];
    bf16x8 qf[8], kf0[8];
#pragma unroll
    for (int s = 0; s < 8; ++s) qf[s] = *(const bf16x8*)(F.unat + bqk_off(tok0 + t, head * 128 + 16 * s + 8 * h));
#pragma unroll
    for (int s = 0; s < 8; ++s) kf0[s] = *(const bf16x8*)(F.unat + bqk_off(tok0 + r, 512 + head * 128 + 16 * s + 8 * h));
    SCHED_FENCE();
    {
        const float f_f = g_ff + F.fbias[l * 8 + head], f_b = g_fb + F.fbias[l * 8 + 4 + head];
        const float bf_ = scan_sum_up(logsigmoid(f_f), lane), bb_ = scan_sum_down(logsigmoid(f_b), lane);
        const float uf = g_if - bf_, ub = g_ib - bb_;
        const float MF = fmaxf(mpf, scan_max_up(uf, lane)), MB = fmaxf(mpb, scan_max_down(ub, lane));
        tab[lane] = uf; tab[64 + lane] = ub; tab[128 + lane] = MF; tab[192 + lane] = MB; tab[256 + lane] = bf_; tab[320 + lane] = bb_;
        tab[384 + lane] = n0_; tab[448 + lane] = n1_; tab[512 + lane] = n2_; tab[576 + lane] = n3_;
        LDS_WAIT();
    }
    f32x16 S0 = zero16(), S1 = zero16();
    {
        bf16x8 kf1[8];
#pragma unroll
        for (int s = 0; s < 8; ++s) kf1[s] = *(const bf16x8*)(F.unat + bqk_off(tok0 + 32 + r, 512 + head * 128 + 16 * s + 8 * h));
        SCHED_FENCE();
#pragma unroll
        for (int s = 0; s < 8; ++s) S0 = MFMA32(kf0[s], qf[s], S0);
#pragma unroll
        for (int s = 0; s < 8; ++s) S1 = MFMA32(kf1[s], qf[s], S1);
    }
    bf16x8 pb[2][4]; float interw[2], inv[2];
#pragma unroll
    for (int dir = 0; dir < 2; ++dir) {
        const LAS float* U = tab + dir * 64;
        const float Mt = tab[128 + dir * 64 + t], Bt = tab[256 + dir * 64 + t], mp = dir ? mpb : mpf;
        const LAS float* np = tab + 384 + dir * 128 + 8 * h;
        float nq = 0.f;
#pragma unroll
        for (int s = 0; s < 8; ++s) { const f32x4 n0 = *(const LAS f32x4*)(np + 16 * s), n1 = *(const LAS f32x4*)(np + 16 * s + 4); const u32x4 qq = __builtin_bit_cast(u32x4, qf[s]);
            nq += n0[0] * bflo(qq.x) + n0[1] * bfhi(qq.x) + n0[2] * bflo(qq.y) + n0[3] * bfhi(qq.y) + n1[0] * bflo(qq.z) + n1[1] * bfhi(qq.z) + n1[2] * bflo(qq.w) + n1[3] * bfhi(qq.w); }
        nq += shx(nq, 32, lane);
        interw[dir] = fexp(mp - Mt) * QS;
        float den = 0.f;
#pragma unroll
        for (int st = 0; st < 2; ++st) {
            f32x16 P;
#pragma unroll
            for (int g4 = 0; g4 < 4; ++g4) { const f32x4 uu = *(const LAS f32x4*)(U + 32 * st + 8 * g4 + 4 * h);
#pragma unroll
                for (int e = 0; e < 4; ++e) { const int sp = 32 * st + 8 * g4 + 4 * h + e; const bool ok = dir ? (sp >= t) : (sp <= t);
                    const float wgt = ok ? fexp(uu[e] - Mt) : 0.f; const float pv = (st ? S1[4 * g4 + e] : S0[4 * g4 + e]) * QS * wgt; P[4 * g4 + e] = pv; den += pv; } }
            pb[dir][2 * st] = pack8(P, 0); pb[dir][2 * st + 1] = pack8(P, 1);
        }
        den += shx(den, 32, lane);
        den += nq * interw[dir];
        inv[dir] = frcp(fmaxf(fabsf(den), fexp(-(Bt + Mt))));
    }
    bf16x8 cfa[8], cfb[8]; s16x4 vv[8]; u32x2 og[4];
    int ro = r, ho = h; asm volatile("" : "+v"(ro), "+v"(ho));
    const int to = 32 * tt + ro;
#define M3_LOADC(dst, dir, dt) do { SCHED_FENCE(); { const bf16* cp = F.cst + cst_chunk((dir ? cidb : cidf), c, (dt), ho, ro); \
        _Pragma("unroll") for (int s = 0; s < 8; ++s) dst[s] = *(const bf16x8*)(cp + ((s & 3) * 2 * 256) + (s >> 2) * ((size_t)64 * 2048)); } SCHED_FENCE(); } while (0)
#define M3_LOADV(dt) do { SCHED_FENCE(); { const bf16* vp = F.ut + (size_t)(T_BV + head * 128 + 32 * (dt) + ro) * M + tok0 + 8 * ho; \
        _Pragma("unroll") for (int ks = 0; ks < 4; ++ks) { const u32x4 q_ = *(const u32x4*)(vp + 16 * ks); vv[2 * ks] = __builtin_bit_cast(s16x4, (u32x2){q_.x, q_.y}); vv[2 * ks + 1] = __builtin_bit_cast(s16x4, (u32x2){q_.z, q_.w}); } } \
        { _Pragma("unroll") for (int p = 0; p < 2; ++p) { const u32x4 q_ = *(const u32x4*)(F.unat + fm_off<2>(tok0 + to, N_BO, head * 128 + 32 * (dt) + 16 * p + 8 * ho)); og[2 * p] = (u32x2){q_.x, q_.y}; og[2 * p + 1] = (u32x2){q_.z, q_.w}; } } SCHED_FENCE(); } while (0)
    M3_LOADC(cfa, 0, 0); M3_LOADV(0);
    float s1 = 0.f, s2 = 0.f;
#pragma unroll 1
    for (int dt = 0; dt < 4; ++dt) {
        f32x16 H;
#pragma unroll
        for (int ks = 0; ks < 4; ++ks) {
            const u32x2 lo = __builtin_bit_cast(u32x2, vv[2 * ks]), hi = __builtin_bit_cast(u32x2, vv[2 * ks + 1]);
            const auto sx = __builtin_amdgcn_permlane32_swap(lo.x, hi.x, false, false), sy = __builtin_amdgcn_permlane32_swap(lo.y, hi.y, false, false);
            vv[2 * ks] = __builtin_bit_cast(s16x4, (u32x2){sx[0], sy[0]}); vv[2 * ks + 1] = __builtin_bit_cast(s16x4, (u32x2){sx[1], sy[1]}); }
        {
            f32x16 X = zero16();
#pragma unroll
            for (int s = 0; s < 8; ++s) X = MFMA32(cfa[s], qf[s], X);
            M3_LOADC(cfb, 1, dt);
            const float iw = interw[0];
#pragma unroll
            for (int i = 0; i < 16; ++i) X[i] *= iw;
#pragma unroll
            for (int ks = 0; ks < 4; ++ks) X = MFMA32(__builtin_shufflevector(vv[2 * ks], vv[2 * ks + 1], 0, 1, 2, 3, 4, 5, 6, 7), pb[0][ks], X);
            const float iv = inv[0];
#pragma unroll
            for (int i = 0; i < 16; ++i) H[i] = X[i] * iv;
        }
        {
            f32x16 X = zero16();
#pragma unroll
            for (int s = 0; s < 8; ++s) X = MFMA32(cfb[s], qf[s], X);
            if (dt < 3) M3_LOADC(cfa, 0, dt + 1);
            const float iw = interw[1];
#pragma unroll
            for (int i = 0; i < 16; ++i) X[i] *= iw;
#pragma unroll
            for (int ks = 0; ks < 4; ++ks) X = MFMA32(__builtin_shufflevector(vv[2 * ks], vv[2 * ks + 1], 0, 1, 2, 3, 4, 5, 6, 7), pb[1][ks], X);
            const float iv = inv[1];
#pragma unroll
            for (int i = 0; i < 16; ++i) H[i] += X[i] * iv;
        }
#pragma unroll
        for (int p = 0; p < 2; ++p) { const auto sx = __builtin_amdgcn_permlane32_swap(og[2 * p].x, og[2 * p + 1].x, false, false), sy = __builtin_amdgcn_permlane32_swap(og[2 * p].y, og[2 * p + 1].y, false, false);
            og[2 * p] = (u32x2){sx[0], sy[0]}; og[2 * p + 1] = (u32x2){sx[1], sy[1]}; }
#pragma unroll
        for (int g4 = 0; g4 < 4; ++g4) { const u32x2 oo = og[g4];
            H[4 * g4] *= sigm(bflo(oo.x)); H[4 * g4 + 1] *= sigm(bfhi(oo.x)); H[4 * g4 + 2] *= sigm(bflo(oo.y)); H[4 * g4 + 3] *= sigm(bfhi(oo.y)); }
        if (dt < 3) M3_LOADV(dt + 1);
#pragma unroll
        for (int i = 0; i < 16; ++i) { s1 += H[i]; s2 += H[i] * H[i]; hb[(dt * 16 + i) * 64 + lane] = H[i]; }
    }
#undef M3_LOADC
#undef M3_LOADV
    s1 += shx(s1, 32, lane); s2 += shx(s2, 32, lane);
    const float mean = s1 * (1.f / 128.f), var = fmaxf(s2 * (1.f / 128.f) - mean * mean, 0.f), rstd = __builtin_amdgcn_rsqf(var + LN_EPS);
    LDS_WAIT();
    int rz = r, hz = h; asm volatile("" : "+v"(rz), "+v"(hz)); const int tz = 32 * tt + rz;
    bf16* yp = F.yb + (size_t)(tok0 + tz) * DM + 768 + head * 128 + 8 * hz;
    const float* ng = F.norm_g + l * 512 + head * 128 + 4 * hz;
#pragma unroll 1
    for (int half = 0; half < 2; ++half) {
        u32x4 zq[4]; u32x2 zz[8]; f32x4 gn[8];
#pragma unroll
        for (int p = 0; p < 4; ++p) zq[p] = *(const u32x4*)(F.unat + fm_off<2>(tok0 + tz, N_BZ, head * 128 + 16 * (4 * half + p) + 8 * hz));
#pragma unroll
        for (int i = 0; i < 8; ++i) gn[i] = *(const f32x4*)(ng + 8 * (8 * half + i));
#pragma unroll
        for (int p = 0; p < 4; ++p) { const auto sx = __builtin_amdgcn_permlane32_swap(zq[p].x, zq[p].z, false, false), sy = __builtin_amdgcn_permlane32_swap(zq[p].y, zq[p].w, false, false);
            zz[2 * p] = (u32x2){sx[0], sy[0]}; zz[2 * p + 1] = (u32x2){sx[1], sy[1]}; }
        u32x2 wy[8];
#pragma unroll
        for (int i = 0; i < 8; ++i) { const int ii = 8 * half + i;
            const float h0 = hb[(4 * ii) * 64 + lane], h1 = hb[(4 * ii + 1) * 64 + lane], h2 = hb[(4 * ii + 2) * 64 + lane], h3 = hb[(4 * ii + 3) * 64 + lane];
            const float y0 = (h0 - mean) * rstd * gn[i][0] * silu(bflo(zz[i].x)), y1 = (h1 - mean) * rstd * gn[i][1] * silu(bfhi(zz[i].x));
            const float y2 = (h2 - mean) * rstd * gn[i][2] * silu(bflo(zz[i].y)), y3 = (h3 - mean) * rstd * gn[i][3] * silu(bfhi(zz[i].y));
            wy[i].x = cvt_pk_bf16(y0, y1); wy[i].y = cvt_pk_bf16(y2, y3); }
#pragma unroll
        for (int p = 0; p < 4; ++p) { const auto sx = __builtin_amdgcn_permlane32_swap(wy[2 * p].x, wy[2 * p + 1].x, false, false), sy = __builtin_amdgcn_permlane32_swap(wy[2 * p].y, wy[2 * p + 1].y, false, false);
            u32x4 o; o.x = sx[0]; o.y = sy[0]; o.z = sx[1]; o.w = sy[1]; *(u32x4*)(yp + 16 * (4 * half + p)) = o; }
    }
    LDS_WAIT();
}

__global__ void __launch_bounds__(NTHR, 2) mega(Args args) {
    extern __shared__ __attribute__((aligned(16))) unsigned char lds_raw[];
    LAS unsigned char* const ldsb = (LAS unsigned char*)lds_raw;
    const int wave_s = __builtin_amdgcn_readfirstlane((int)threadIdx.x >> 6);
#define TID_NOW() ([&]() { unsigned z_ = 0u; asm volatile("" : "+v"(z_)); return wave_s * 64 + (int)__builtin_amdgcn_mbcnt_hi(~0u, __builtin_amdgcn_mbcnt_lo(~0u, z_)); }())
#define MAKE_CTX() MAKE_CTX_L(1)
#define MAKE_CTX_L(lyr) Ctx F; { const int l_ = (lyr); auto kp_ = __builtin_amdgcn_kernarg_segment_ptr(); asm volatile("" : "+s"(kp_)); \
    const __attribute__((address_space(4))) Args* ap_ = (const __attribute__((address_space(4))) Args*)kp_; \
    F.lds = ldsb; { int tid_ = TID_NOW(); asm volatile("" : "+v"(tid_)); F.tid = tid_; } F.lane = F.tid & 63; F.wave = wave_s; F.G = gridDim.x; F.bid = blockIdx.x; \
    F.x = ap_->in[0]; F.emb_g = ap_->in[1]; F.emb_b = ap_->in[2]; F.w_in = ap_->in[3]; F.b_in = ap_->in[4]; F.w_out = ap_->in[5]; F.b_out = ap_->in[6]; \
    F.ln_g = ap_->in[7]; F.ln_b = ap_->in[8]; F.t5 = ap_->in[9]; F.sink = ap_->in[10]; F.fbias = ap_->in[11]; F.norm_g = ap_->in[12]; F.rpb = ap_->in[13]; \
    F.out = ap_->out; F.ws = ap_->ws; \
    F.hby = (bf16*)(F.ws + WS_HBY); F.yb = l_ == 0 ? (bf16*)F.out : F.hby; F.unat = (bf16*)(F.ws + WS_UNAT); F.ut = (bf16*)(F.ws + WS_UT); F.cst = (bf16*)(F.ws + WS_CST); F.nst = (float*)(F.ws + WS_NST); \
    F.gs = (float*)(F.ws + WS_SCAL); F.ml = F.gs + 2048; F.mprev = F.gs + 4096; F.gate = (float*)(F.ws + WS_GATE); F.stat = (float*)(F.ws + WS_SCAL + 65536); }
    volatile LAS unsigned* MISC = (volatile LAS unsigned*)(ldsb + MISC_OFF);
    if (threadIdx.x < 32) MISC[threadIdx.x] = 0u;
    __syncthreads();
    XcdBarrier bar; bar.bar = (unsigned*)(args.ws + WS_CTL) + CW_BAR; bar.x = 0; bar.st = nullptr;
    if (!MK_PER_PHASE) bar = xcd_barrier_post((unsigned*)(args.ws + WS_CTL) + CW_BAR, MISC + 8, (int)threadIdx.x);
    const int lo = args.ph_lo, hi = args.ph_hi;
#define IN(k) (lo <= (k) && (k) < hi)
#define SEAM(k) do { if (IN(k) && IN((k) + 1)) { for (int rb_ = 0; rb_ < REP_BAR; ++rb_) xcd_barrier(bar, TID_NOW()); } } while (0)
    #ifndef NO_P0
    if (IN(0)) { MAKE_CTX(); for (int rep_ = 0, nrep_ = opaque_int(REP_P0); rep_ < nrep_; ++rep_) phase_prologue(F); }
#endif
    SEAM(0);
#pragma unroll 1
    for (int l = 0; l < 2; ++l) {
        const int pb = 1 + 6 * l;
        if (IN(pb)) {
#ifndef NO_G1
            {   MAKE_CTX_L(l);
                pg8::Sched1 S{(const char*)F.hby, (const char*)(F.ws + WS_WIN + l * WIN_STRIDE), F.G, F.bid};
                pg8::Epi1 E{F.unat, F.ut, (const float*)(F.ws + WS_BIAS) + l * WROWS};
                pg8::gemm_phase<pg8::Epi1, pg8::Sched1, true, true>(F.lds, S, E, F.tid); }
#endif
#ifndef NO_GATES
            {   MAKE_CTX_L(l);
                if (l == 0) { bool is_h; int hid, nh; helper_of(F, 0, is_h, hid, nh); if (is_h) { weights_job(F, 1, hid * NWAVES + F.wave, nh * NWAVES); } __syncthreads(); }
                gates_job(F, l); }
#endif
        }
        SEAM(pb);
        if (IN(pb + 1)) {
            MAKE_CTX_L(l);
#ifndef NO_M1
            for (int rep_ = 0, nrep_ = opaque_int(REP_M1); rep_ < nrep_; ++rep_) for (int wi = F.bid * NWAVES + F.wave; wi < 2048; wi += F.G * NWAVES) m1_wave(F, wi, l);
#endif
            __syncthreads();
#ifndef NO_WA
            for (int rep_ = 0, nrep_ = opaque_int(REP_WA); rep_ < nrep_; ++rep_) for (int it0 = F.bid; it0 < 256; it0 += F.G) wattn_item(F, (F.G == 256) ? ((it0 & 7) * 32 + (it0 >> 3)) : it0, l);
#endif
        }
        SEAM(pb + 1);
        if (IN(pb + 2)) {
            MAKE_CTX_L(l);
#ifndef NO_M2
            m2_scan(F);
#endif
#ifndef NO_NA
            for (int rep_ = 0, nrep_ = opaque_int(REP_NA); rep_ < nrep_; ++rep_) nattn_all(F, l);
#endif
        }
        SEAM(pb + 2);
        if (IN(pb + 3)) {
            MAKE_CTX_L(l);
#ifndef NO_M3
            for (int rep_ = 0, nrep_ = opaque_int(REP_M3); rep_ < nrep_; ++rep_) for (int wi = F.bid * NWAVES + F.wave; wi < 2048; wi += F.G * NWAVES) m3_wave(F, wi, l);
#endif
        }
        SEAM(pb + 3);
        if (IN(pb + 4)) {
            MAKE_CTX_L(l);
            pg8::Sched2 S{(const char*)F.yb, (const char*)(F.ws + WS_WOUT + l * WOUT_STRIDE), F.G, F.bid};
#ifndef NO_G2
            if (l == 0) { pg8::Epi2<0> E{(float*)nullptr, (bf16*)(F.ws + WS_WIN), F.b_out, F.x, (const bf16*)F.hby, F.stat, F.emb_g, F.emb_b, (bf16*)(F.ws + WS_T1B)};
                pg8::gemm_phase<pg8::Epi2<0>, pg8::Sched2, true, true>(F.lds, S, E, F.tid); }
            else { pg8::Epi2<1> E{(float*)nullptr, (bf16*)(F.ws + WS_UNAT), F.b_out + DM, (const float*)nullptr, (const bf16*)nullptr, (const float*)nullptr, (const float*)nullptr, (const float*)nullptr, (bf16*)nullptr};
                pg8::gemm_phase<pg8::Epi2<1>, pg8::Sched2, true, true>(F.lds, S, E, F.tid); }
#endif
        }
        SEAM(pb + 4);
        if (IN(pb + 5)) {
            MAKE_CTX_L(l);
            const int gw = F.bid * NWAVES + F.wave, NGW = F.G * NWAVES;
            if (l == 0) { for (int m = 2 * gw; m < M; m += 2 * NGW) ln_row2_b(t1_row(F.ws, m), t1_row(F.ws, m + 1), F.hby + (size_t)m * DM, F.hby + (size_t)(m + 1) * DM, F.stat + (size_t)(M + m) * 2, F.stat + (size_t)(M + m + 1) * 2, F.ln_g, F.ln_b, F.lane); }
            else { const bf16* O2 = (const bf16*)(F.ws + WS_UNAT);
                   for (int m = 2 * gw; m < M; m += 2 * NGW) fin_row2(t1_row(F.ws, m), O2 + (size_t)m * DM, F.stat + (size_t)(M + m) * 2, F.ln_g, F.ln_b, F.ln_g + DM, F.ln_b + DM, F.out + (size_t)m * DM, F.lane); }
        }
        if (l == 0) SEAM(pb + 5);
    }
#undef IN
#undef SEAM
}

extern "C" void kernel_launch(void* const* d_in, const int* in_sizes, int n_in, void* d_out, int out_size, void* d_ws, size_t ws_size, hipStream_t stream) {
    static int grid = 0;
    if (grid == 0) {
        if (n_in != 14 || out_size != M * DM || ws_size < WS_END) { fprintf(stderr, "kernel_launch: unexpected shapes (n_in %d out %d ws %zu)\n", n_in, out_size, ws_size); grid = -1; return; }
        int dev = 0, cus = 0, per_cu = 0;
        if (hipGetDevice(&dev) != hipSuccess || hipDeviceGetAttribute(&cus, hipDeviceAttributeMultiprocessorCount, dev) != hipSuccess) { grid = -1; return; }
        if (hipFuncSetAttribute((const void*)mega, hipFuncAttributeMaxDynamicSharedMemorySize, LDS_BYTES) != hipSuccess) { fprintf(stderr, "kernel_launch: hipFuncSetAttribute failed\n"); grid = -1; return; }
        if (hipOccupancyMaxActiveBlocksPerMultiprocessor(&per_cu, (const void*)mega, NTHR, LDS_BYTES) != hipSuccess || per_cu < 1) fprintf(stderr, "kernel_launch: occupancy query says %d\n", per_cu);
        (void)hipGetLastError();
        grid = cus;
    }
    if (grid < 0) return;
    (void)hipMemsetAsync((char*)d_ws + WS_CTL, 0, CTL_BYTES, stream);
    Args a{};
    for (int i = 0; i < 14; ++i) a.in[i] = (const float*)d_in[i];
    a.out = (float*)d_out; a.ws = (unsigned char*)d_ws;
#if MK_PER_PHASE
    for (int p = 0; p < 13; ++p) { a.ph_lo = p; a.ph_hi = p + 1; hipLaunchKernelGGL(mega, dim3(grid), dim3(NTHR), LDS_BYTES, stream, a); }
#else
    a.ph_lo = 0; a.ph_hi = 13;
    hipLaunchKernelGGL(mega, dim3(grid), dim3(NTHR), LDS_BYTES, stream, a);
#endif
}
```
